# Optimizing an MI355X kernel written in HIP

```python
import jax, jax.numpy as jnp
from jax import lax
import numpy as np

D_MODEL = 1024
BATCH = 8
SEQ = 4096
DEPTH = 1

D_PLE = 256
D_FF = 2816
NH_M = 4
DV_M = D_MODEL // 8
DK_M = DV_M // 2
CHUNK_M = 64
CONV_W = 4
NH_F = 8
DH_F = D_MODEL // 16
Q_BLOCK = 128
D_MIX = NH_M * DV_M + NH_F * DH_F
IN_SIZES = (2 * NH_M * DK_M, NH_M * DV_M, NH_M * DV_M, 2 * NH_M,
            NH_F * DH_F, NH_F * DH_F, NH_F * DH_F, NH_F)
N_IN = sum(IN_SIZES)
EPS = 1e-6
MLSTM_F_BIAS = 3.0
FOX_F_BIAS = 2.0

kernel_name = "hymba_mlstm_fox_macaron"


def rmsnorm(x, g):
    xf = x.astype(jnp.float32)
    y = xf * lax.rsqrt(jnp.mean(xf * xf, axis=-1, keepdims=True) + EPS)
    return (y * g.astype(jnp.float32)).astype(x.dtype)


def swiglu(x, w_gate, w_up, w_down):
    return (jax.nn.silu(x @ w_gate) * (x @ w_up)) @ w_down


def causal_depthwise_conv(x, w):
    return lax.conv_general_dilated(
        x, w[:, None, :].astype(x.dtype), window_strides=(1,),
        padding=[(w.shape[0] - 1, 0)], dimension_numbers=("NWC", "WIO", "NWC"),
        feature_group_count=x.shape[-1])


def head_rmsnorm(t, g):
    B, S, NH, DH = t.shape
    return rmsnorm(t, g.reshape(NH, DH)).reshape(B, S, NH * DH)


def mlstm_chunkwise(q, k, v, i_pre, f_pre):
    B, NH, S, DK = q.shape
    DV = v.shape[-1]
    L = CHUNK_M
    NC = S // L
    q = q.reshape(B, NH, NC, L, DK) * DK ** -0.5
    k = k.reshape(B, NH, NC, L, DK)
    v = v.reshape(B, NH, NC, L, DV)
    log_i = i_pre.reshape(B, NH, NC, L)
    log_f = jax.nn.log_sigmoid(f_pre).reshape(B, NH, NC, L)
    b = jnp.cumsum(log_f, axis=-1)
    g = b[..., -1]
    a = g[..., None] - b + log_i

    def step(carry, xs):
        C, n, m = carry
        k_c, v_c, a_c, g_c = xs
        m_new = jnp.maximum(g_c + m, jnp.max(a_c, axis=-1))
        decay = jnp.exp(g_c + m - m_new)
        w = jnp.exp(a_c - m_new[..., None])
        C_new = decay[..., None, None] * C + jnp.einsum("bhl,bhld,bhle->bhde", w, k_c, v_c)
        n_new = decay[..., None] * n + jnp.einsum("bhl,bhld->bhd", w, k_c)
        return (C_new, n_new, m_new), (C, n, m)

    init = (jnp.zeros((B, NH, DK, DV), jnp.float32), jnp.zeros((B, NH, DK), jnp.float32),
            jnp.zeros((B, NH), jnp.float32))
    xs = (jnp.moveaxis(k, 2, 0), jnp.moveaxis(v, 2, 0), jnp.moveaxis(a, 2, 0), jnp.moveaxis(g, 2, 0))
    _, (C_prev, n_prev, m_prev) = lax.scan(step, init, xs)
    C_prev = jnp.moveaxis(C_prev, 0, 2)
    n_prev = jnp.moveaxis(n_prev, 0, 2)
    m_prev = jnp.moveaxis(m_prev, 0, 2)

    inter = b + m_prev[..., None]
    causal = jnp.tril(jnp.ones((L, L), dtype=bool))
    D = jnp.where(causal, b[..., :, None] - b[..., None, :] + log_i[..., None, :], -jnp.inf)
    m_t = jnp.maximum(inter, jnp.max(D, axis=-1))
    w_inter = jnp.exp(inter - m_t)
    P = jnp.exp(D - m_t[..., None]) * jnp.einsum("bhcld,bhcsd->bhcls", q, k)
    num = (w_inter[..., None] * jnp.einsum("bhcld,bhcde->bhcle", q, C_prev)
           + jnp.einsum("bhcls,bhcse->bhcle", P, v))
    den = w_inter * jnp.einsum("bhcld,bhcd->bhcl", q, n_prev) + jnp.sum(P, axis=-1)
    h = num / jnp.maximum(jnp.abs(den), jnp.exp(-m_t))[..., None]
    return h.reshape(B, NH, S, DV)


def forgetting_attention(q, k, v, f_pre):
    S = q.shape[2]
    scale = q.shape[-1] ** -0.5
    c = jnp.cumsum(jax.nn.log_sigmoid(f_pre.astype(jnp.float32)), axis=-1)
    outs = []
    for blk in range(S // Q_BLOCK):
        q0, q1 = blk * Q_BLOCK, (blk + 1) * Q_BLOCK
        logits = jnp.einsum("bhqd,bhkd->bhqk", q[:, :, q0:q1], k[:, :, :q1]).astype(jnp.float32) * scale
        logits = logits + c[:, :, q0:q1, None] - c[:, :, None, :q1]
        mask = (q0 + jnp.arange(Q_BLOCK))[:, None] >= jnp.arange(q1)[None, :]
        probs = jax.nn.softmax(jnp.where(mask, logits, -jnp.inf), axis=-1).astype(v.dtype)
        outs.append(jnp.einsum("bhqk,bhkd->bhqd", probs, v[:, :, :q1]))
    return jnp.concatenate(outs, axis=2)


def setup_inputs(seed: int = 0) -> dict:
    key = jax.random.key(seed)
    ks = jax.random.split(key, 24)
    f32 = jnp.float32

    def nrm(k, shape, fan_in):
        return jax.random.normal(k, shape, f32) * fan_in ** -0.5

    def gain(k, n):
        return 1.0 + 0.02 * jax.random.normal(k, (DEPTH, n), f32)

    b_gates = jnp.concatenate(
        [0.1 * jax.random.normal(ks[9], (DEPTH, NH_M), f32),
         MLSTM_F_BIAS + 0.1 * jax.random.normal(ks[10], (DEPTH, NH_M), f32)], axis=-1)
    return {
        "x": jax.random.normal(ks[0], (BATCH, SEQ, D_MODEL), f32),
        "p": jax.random.normal(ks[1], (DEPTH, BATCH, SEQ, D_PLE), f32),
        "ffn1_norm": gain(ks[2], D_MODEL),
        "ffn1_w_gate": nrm(ks[3], (DEPTH, D_MODEL, D_FF), D_MODEL),
        "ffn1_w_up": nrm(ks[4], (DEPTH, D_MODEL, D_FF), D_MODEL),
        "ffn1_w_down": nrm(ks[5], (DEPTH, D_FF, D_MODEL), D_FF),
        "mix_norm": gain(ks[6], D_MODEL),
        "w_in": nrm(ks[7], (DEPTH, D_MODEL, N_IN), D_MODEL),
        "conv_qk": nrm(ks[8], (DEPTH, CONV_W, 2 * NH_M * DK_M), CONV_W),
        "b_mlstm_gates": b_gates,
        "b_fox_f": FOX_F_BIAS + 0.1 * jax.random.normal(ks[11], (DEPTH, NH_F), f32),
        "mlstm_out_norm": gain(ks[12], NH_M * DV_M),
        "fox_out_norm": gain(ks[13], NH_F * DH_F),
        "w_out": nrm(ks[14], (DEPTH, D_MIX, D_MODEL), D_MIX),
        "ffn2_norm": gain(ks[15], D_MODEL),
        "ffn2_w_gate": nrm(ks[16], (DEPTH, D_MODEL, D_FF), D_MODEL),
        "ffn2_w_up": nrm(ks[17], (DEPTH, D_MODEL, D_FF), D_MODEL),
        "ffn2_w_down": nrm(ks[18], (DEPTH, D_FF, D_MODEL), D_FF),
        "ple_gate_norm": gain(ks[19], D_MODEL),
        "w_ple_gate": nrm(ks[20], (DEPTH, D_MODEL, D_MODEL), D_MODEL),
        "w_ple_proj": nrm(ks[21], (DEPTH, D_PLE, D_MODEL), D_PLE),
        "ple_proj_norm": gain(ks[22], D_MODEL),
        "final_norm": 1.0 + 0.02 * jax.random.normal(ks[23], (D_MODEL,), f32),
    }


def reference(x, p, ffn1_norm, ffn1_w_gate, ffn1_w_up, ffn1_w_down, mix_norm, w_in, conv_qk,
              b_mlstm_gates, b_fox_f, mlstm_out_norm, fox_out_norm, w_out, ffn2_norm,
              ffn2_w_gate, ffn2_w_up, ffn2_w_down, ple_gate_norm, w_ple_gate, w_ple_proj,
              ple_proj_norm, final_norm):
    B, S, _ = x.shape
    split_idx = [int(s) for s in np.cumsum(IN_SIZES)[:-1]]

    def heads(t, nh):
        return t.reshape(B, S, nh, -1).transpose(0, 2, 1, 3)

    h = x
    for i in range(DEPTH):
        h = h + 0.5 * swiglu(rmsnorm(h, ffn1_norm[i]), ffn1_w_gate[i], ffn1_w_up[i], ffn1_w_down[i])

        u = rmsnorm(h, mix_norm[i])
        z = u @ w_in[i]
        m_qk, m_v, m_o, m_if, f_q, f_k, f_v, f_f = jnp.split(z, split_idx, axis=-1)

        m_qk = jax.nn.silu(causal_depthwise_conv(m_qk, conv_qk[i]))
        m_q, m_k = jnp.split(m_qk, 2, axis=-1)
        gates = (m_if.astype(jnp.float32) + b_mlstm_gates[i].astype(jnp.float32)).transpose(0, 2, 1)
        h_m = mlstm_chunkwise(heads(m_q, NH_M).astype(jnp.float32), heads(m_k, NH_M).astype(jnp.float32),
                              heads(m_v, NH_M).astype(jnp.float32), gates[:, :NH_M], gates[:, NH_M:])
        h_m = h_m.astype(u.dtype).transpose(0, 2, 1, 3)
        y_m = head_rmsnorm(h_m, mlstm_out_norm[i]) * jax.nn.sigmoid(m_o)

        f_gate = (f_f + b_fox_f[i]).transpose(0, 2, 1)
        h_f = forgetting_attention(heads(f_q, NH_F), heads(f_k, NH_F), heads(f_v, NH_F), f_gate)
        y_f = head_rmsnorm(h_f.transpose(0, 2, 1, 3), fox_out_norm[i])

        h = h + jnp.concatenate([y_m, y_f], axis=-1) @ w_out[i]

        h = h + 0.5 * swiglu(rmsnorm(h, ffn2_norm[i]), ffn2_w_gate[i], ffn2_w_up[i], ffn2_w_down[i])

        gate = jax.nn.sigmoid(rmsnorm(h, ple_gate_norm[i]) @ w_ple_gate[i])
        h = h + gate * rmsnorm(p[i] @ w_ple_proj[i], ple_proj_norm[i])

    return rmsnorm(h, final_norm)
```

```cpp
#include <hip/hip_runtime.h>
#include <hip/hip_cooperative_groups.h>
#include <hip/hip_bf16.h>
#include <cstdio>
#include <cstdint>
#include <cmath>
namespace cg = cooperative_groups;
namespace pg8 {
#define PG8_LAS __attribute__((address_space(3)))
typedef unsigned short bf16_t;
typedef short bf16x8 __attribute__((ext_vector_type(8)));
typedef float f32x4 __attribute__((ext_vector_type(4)));
typedef unsigned u32x4 __attribute__((ext_vector_type(4)));
constexpr int BM = 256, BK = 64, HALF = 128, HTB = HALF * BK * 2  , STAGE_BYTES = 8 * HTB, NXCD = 8, WGM = 8;

__host__ __device__ __forceinline__ int lds_byte(int r, int c) { const int st = (r >> 4) * 2 + (c >> 5), rr = r & 15, cc = c & 31, ob = rr * 64 + cc * 2; return st * 1024 + (ob ^ (((ob >> 9) & 1) << 5)); }
__host__ __device__ __forceinline__ void stage_rc(int b, int& R, int& C) { const int st = b / 1024, sb = b % 1024, swz = sb ^ (((sb >> 9) & 1) << 5); R = (st >> 1) * 16 + swz / 64; C = (st & 1) * 32 + (swz % 64) / 2; }
__host__ __device__ __forceinline__ int perm32(int rho) { const int n = rho >> 4, i = rho & 15; return 8 * (i >> 2) + 4 * n + (i & 3); }

struct Unit { int pm, pn; };
struct Gemm { const bf16_t* A; const bf16_t* Bt; int M, N, K; };

struct StaticOrder {
    int nM, nN, nwg, G, c;
    __host__ __device__ void init(int M, int N, int G_, int c_) { nM = M / BM; nN = N / BM; nwg = nM * nN; G = G_; c = c_; }
    __host__ __device__ bool next(int i, Unit& u) const {
        const long L = (long)i * G + c; if (L >= nwg) return false;
        int wgid = (int)L; { const int q = nwg / NXCD, r = nwg % NXCD, xcd = wgid % NXCD, off = wgid / NXCD; wgid = (xcd < r ? xcd * (q + 1) : r * (q + 1) + (xcd - r) * q) + off; }
        const int nig = WGM * nN, gid = wgid / nig, fm = gid * WGM, gsz = (nM - fm) < WGM ? (nM - fm) : WGM;
        u.pm = fm + ((wgid % nig) % gsz); u.pn = (wgid % nig) / gsz; return true;
    }
    __device__ __forceinline__ void a_ready(const Unit&) const {}
    __device__ __forceinline__ void done(const Unit&) const {}
};

__device__ __forceinline__ unsigned cvt_pk_bf16(float lo, float hi) { unsigned r; asm volatile("v_cvt_pk_bf16_f32 %0, %1, %2" : "=v"(r) : "v"(lo), "v"(hi)); return r; }
typedef float f32x2 __attribute__((ext_vector_type(2)));
typedef unsigned u32x2 __attribute__((ext_vector_type(2)));
constexpr float RMS_EPS = 1e-6f;
__device__ __forceinline__ float row_rstd(const float* __restrict__ ss, int row) {
    const f32x4* p = (const f32x4*)(ss + (size_t)row * 16);
    const f32x4 a = p[0], b = p[1], c = p[2], d = p[3];
    const float s = (((a[0] + a[1]) + (a[2] + a[3])) + ((b[0] + b[1]) + (b[2] + b[3]))) + (((c[0] + c[1]) + (c[2] + c[3])) + ((d[0] + d[1]) + (d[2] + d[3])));
    return 1.0f / sqrtf(s * (1.0f / 1024.0f) + RMS_EPS);
}
__device__ __forceinline__ float sigmoid_f(float x) { return __builtin_amdgcn_rcpf(1.0f + __builtin_amdgcn_exp2f(-1.4426950408889634f * x)); }
__device__ __forceinline__ float silu_f(float x) { return x * sigmoid_f(x); }

struct EpiSwiGLU {
    static constexpr bool PERM = true, AFTER_DRAIN = false;
    bf16_t* O; const float* ss; int ldo;
    __device__ __forceinline__ void operator()(const f32x4 (&acc)[2][2][4][2], const Unit& u, int wr, int wc, int fr, int fq) const {
        const int row0 = u.pm * BM + wr * 64 + fr, col0 = u.pn * 128 + wc * 32 + 8 * fq;
#pragma unroll
        for (int ai = 0; ai < 2; ++ai)
#pragma unroll
            for (int m = 0; m < 4; ++m) { const int row = row0 + ai * HALF + m * 16; const float rs = row_rstd(ss, row);
                const f32x4 g0 = acc[ai][0][m][0] * rs, g1 = acc[ai][0][m][1] * rs, u0 = acc[ai][1][m][0] * rs, u1 = acc[ai][1][m][1] * rs;
                u32x4 w; w.x = cvt_pk_bf16(silu_f(g0[0]) * u0[0], silu_f(g0[1]) * u0[1]); w.y = cvt_pk_bf16(silu_f(g0[2]) * u0[2], silu_f(g0[3]) * u0[3]);
                w.z = cvt_pk_bf16(silu_f(g1[0]) * u1[0], silu_f(g1[1]) * u1[1]); w.w = cvt_pk_bf16(silu_f(g1[2]) * u1[2], silu_f(g1[3]) * u1[3]);
                *(u32x4*)(O + (size_t)row * ldo + col0) = w; }
    }
};
struct EpiResid {
    static constexpr bool PERM = false, AFTER_DRAIN = false;
    const float* base; float* out; bf16_t* xn; float* sso; float coef;
    __device__ __forceinline__ void operator()(const f32x4 (&acc)[2][2][4][2], const Unit& u, int wr, int wc, int fr, int fq) const {
        const int col0 = u.pn * BM + wc * 32 + 4 * fq;
#pragma unroll
        for (int ai = 0; ai < 2; ++ai)
#pragma unroll
            for (int m = 0; m < 4; ++m) { const int row = u.pm * BM + ai * HALF + wr * 64 + m * 16 + fr; const size_t off = (size_t)row * 1024 + col0; float q = 0.f;
#pragma unroll
                for (int bj = 0; bj < 2; ++bj)
#pragma unroll
                    for (int n = 0; n < 2; ++n) { const f32x4 bs = *(const f32x4*)(base + off + bj * HALF + n * 16); const f32x4 o = bs + acc[ai][bj][m][n] * coef;
                        *(f32x4*)(out + off + bj * HALF + n * 16) = o; q += (o[0] * o[0] + o[1] * o[1]) + (o[2] * o[2] + o[3] * o[3]);
                        u32x2 w; w.x = cvt_pk_bf16(o[0], o[1]); w.y = cvt_pk_bf16(o[2], o[3]); *(u32x2*)(xn + off + bj * HALF + n * 16) = w; }
                q += __shfl_xor(q, 16); q += __shfl_xor(q, 32);
                if (fq == 0) sso[(size_t)row * 16 + u.pn * 4 + wc] = q; }
    }
};
struct EpiZ {
    static constexpr bool PERM = true, AFTER_DRAIN = false;
    bf16_t* Z; float* gates; const float* ss; const float* bm; const float* bf; float qscale;
    __device__ __forceinline__ void operator()(const f32x4 (&acc)[2][2][4][2], const Unit& u, int wr, int wc, int fr, int fq) const {
        const int row0 = u.pm * BM + wr * 64 + fr;
        if (u.pn < 12) {
            const float sc = (u.pn == 6 || u.pn == 7) ? qscale : 1.0f; const int col0 = u.pn * BM + wc * 32 + 8 * fq;
#pragma unroll
            for (int ai = 0; ai < 2; ++ai)
#pragma unroll
                for (int m = 0; m < 4; ++m) { const int row = row0 + ai * HALF + m * 16; const float rs = row_rstd(ss, row) * sc;
#pragma unroll
                    for (int bj = 0; bj < 2; ++bj) { const f32x4 v0 = acc[ai][bj][m][0] * rs, v1 = acc[ai][bj][m][1] * rs;
                        u32x4 w; w.x = cvt_pk_bf16(v0[0], v0[1]); w.y = cvt_pk_bf16(v0[2], v0[3]); w.z = cvt_pk_bf16(v1[0], v1[1]); w.w = cvt_pk_bf16(v1[2], v1[3]);
                        *(u32x4*)(Z + (size_t)row * 3072 + col0 + bj * HALF) = w; } }
        } else if (wc == 0 && fq < 2) {
            const float* bp = fq == 0 ? bm : bf; const f32x4 b0 = *(const f32x4*)bp, b1 = *(const f32x4*)(bp + 4);
#pragma unroll
            for (int ai = 0; ai < 2; ++ai)
#pragma unroll
                for (int m = 0; m < 4; ++m) { const int row = row0 + ai * HALF + m * 16; const float rs = row_rstd(ss, row);
                    *(f32x4*)(gates + (size_t)row * 16 + 8 * fq) = acc[ai][0][m][0] * rs + b0; *(f32x4*)(gates + (size_t)row * 16 + 8 * fq + 4) = acc[ai][0][m][1] * rs + b1; }
        }
    }
};
struct EpiProj {
    static constexpr bool PERM = true, AFTER_DRAIN = false;
    bf16_t* O; float* sso;
    __device__ __forceinline__ void operator()(const f32x4 (&acc)[2][2][4][2], const Unit& u, int wr, int wc, int fr, int fq) const {
        const int row0 = u.pm * BM + wr * 64 + fr, col0 = u.pn * BM + wc * 32 + 8 * fq;
#pragma unroll
        for (int ai = 0; ai < 2; ++ai)
#pragma unroll
            for (int m = 0; m < 4; ++m) { const int row = row0 + ai * HALF + m * 16; float q = 0.f;
#pragma unroll
                for (int bj = 0; bj < 2; ++bj) { const f32x4 v0 = acc[ai][bj][m][0], v1 = acc[ai][bj][m][1];
                    q += ((v0[0] * v0[0] + v0[1] * v0[1]) + (v0[2] * v0[2] + v0[3] * v0[3])) + ((v1[0] * v1[0] + v1[1] * v1[1]) + (v1[2] * v1[2] + v1[3] * v1[3]));
                    u32x4 w; w.x = cvt_pk_bf16(v0[0], v0[1]); w.y = cvt_pk_bf16(v0[2], v0[3]); w.z = cvt_pk_bf16(v1[0], v1[1]); w.w = cvt_pk_bf16(v1[2], v1[3]);
                    *(u32x4*)(O + (size_t)row * 1024 + col0 + bj * HALF) = w; }
                q += __shfl_xor(q, 16); q += __shfl_xor(q, 32);
                if (fq == 0) sso[(size_t)row * 16 + u.pn * 4 + wc] = q; }
    }
};
struct EpiPle {
    static constexpr bool PERM = false, AFTER_DRAIN = false;
    float* H; const bf16_t* proj; const float* ss3; const float* ssp; const float* gp; float* sso;
    __device__ __forceinline__ void operator()(const f32x4 (&acc)[2][2][4][2], const Unit& u, int wr, int wc, int fr, int fq) const {
        const int col0 = u.pn * BM + wc * 32 + 4 * fq;
#pragma unroll
        for (int ai = 0; ai < 2; ++ai)
#pragma unroll
            for (int m = 0; m < 4; ++m) { const int row = u.pm * BM + ai * HALF + wr * 64 + m * 16 + fr; const size_t off = (size_t)row * 1024 + col0; float q = 0.f;
                const float rs3 = row_rstd(ss3, row), rsp = row_rstd(ssp, row);
#pragma unroll
                for (int bj = 0; bj < 2; ++bj)
#pragma unroll
                    for (int n = 0; n < 2; ++n) { const int co = bj * HALF + n * 16; const f32x4 hb = *(const f32x4*)(H + off + co); const u32x2 pw = *(const u32x2*)(proj + off + co);
                        const f32x4 g = *(const f32x4*)(gp + col0 + co); const f32x4 a = acc[ai][bj][m][n] * rs3;
                        f32x4 pr; pr[0] = __uint_as_float(pw.x << 16); pr[1] = __uint_as_float(pw.x & 0xffff0000u); pr[2] = __uint_as_float(pw.y << 16); pr[3] = __uint_as_float(pw.y & 0xffff0000u);
                        f32x4 o;
#pragma unroll
                        for (int i = 0; i < 4; ++i) o[i] = hb[i] + sigmoid_f(a[i]) * (pr[i] * rsp * g[i]);
                        *(f32x4*)(H + off + co) = o; q += (o[0] * o[0] + o[1] * o[1]) + (o[2] * o[2] + o[3] * o[3]); }
                q += __shfl_xor(q, 16); q += __shfl_xor(q, 32);
                if (fq == 0) sso[(size_t)row * 16 + u.pn * 4 + wc] = q; }
    }
};

template <class Epi, class Sched, bool ALIGN_EPI = false, bool SP2 = false>
__device__ __forceinline__ void gemm_phase(PG8_LAS unsigned char* lds, const Gemm g, const Sched& S, const Epi& E) {
    const int tid = threadIdx.x, wid = __builtin_amdgcn_readfirstlane(tid >> 6), lane = tid & 63, wr = wid >> 2, wc = wid & 3, fr = lane & 15, fq = lane >> 4;
    const int K = g.K, nt = K / BK;
    unsigned voffA[2], voffB[2];
#pragma unroll
    for (int i = 0; i < 2; ++i) { int R, C; stage_rc(tid * 16 + i * 8192, R, C); const int Rb = Epi::PERM ? ((R & ~31) + perm32(R & 31)) : R;
        voffA[i] = (unsigned)(R * K + C) * 2u; voffB[i] = (unsigned)(Rb * K + C) * 2u; }
    const size_t kstep = (size_t)(BK * 2);
    const size_t hstep = (size_t)HALF * K * 2;
    const size_t tstep = 2 * hstep;
    const unsigned ldsw = (unsigned)wid * 1024u;
    const int aoff = lds_byte(wr * 64 + fr, fq * 8), boff = lds_byte(wc * 32 + fr, fq * 8);
#define PG8_SA(b, h) (((b) * 2 + (h)) * HTB)
#define PG8_SB(b, h) ((4 + (b) * 2 + (h)) * HTB)
#define PG8_STAGE(bufoff, gbase, voff) do { _Pragma("unroll") for (int _i = 0; _i < 2; ++_i) \
        __builtin_amdgcn_global_load_lds((const unsigned*)((const char*)(gbase) + (voff)[_i]), (PG8_LAS unsigned*)(lds + (bufoff) + ldsw + _i * 8192), 16, 0, 0); } while (0)
#define PG8_LDA(dst, b, h) do { _Pragma("unroll") for (int m = 0; m < 4; ++m) _Pragma("unroll") for (int k = 0; k < 2; ++k) dst[m][k] = *(const PG8_LAS bf16x8*)(lds + PG8_SA(b, h) + aoff + m * 2048 + k * 1024); } while (0)
#define PG8_LDB(dst, b, h) do { _Pragma("unroll") for (int n = 0; n < 2; ++n) _Pragma("unroll") for (int k = 0; k < 2; ++k) dst[n][k] = *(const PG8_LAS bf16x8*)(lds + PG8_SB(b, h) + boff + n * 2048 + k * 1024); } while (0)
#define PG8_MMA(ai, bj, At, Bt) do { __builtin_amdgcn_s_setprio(1); _Pragma("unroll") for (int m = 0; m < 4; ++m) _Pragma("unroll") for (int n = 0; n < 2; ++n) _Pragma("unroll") for (int k = 0; k < 2; ++k) \
        acc[ai][bj][m][n] = __builtin_amdgcn_mfma_f32_16x16x32_bf16(Bt[n][k], At[m][k], acc[ai][bj][m][n], 0, 0, 0); __builtin_amdgcn_s_setprio(0); } while (0)
#define PG8_WAIT_V(n) asm volatile("s_waitcnt vmcnt(" #n ")" ::: "memory")
#define PG8_WAIT_L(n) asm volatile("s_waitcnt lgkmcnt(" #n ")" ::: "memory")
#define PG8_BAR __builtin_amdgcn_s_barrier()
#define PG8_SCHED __builtin_amdgcn_sched_barrier(0)
    Unit cur, nxt; int ui = 0;
    if (!S.next(0, cur)) return;
    f32x4 acc[2][2][4][2];
#pragma unroll
    for (int a = 0; a < 2; ++a)
#pragma unroll
        for (int b = 0; b < 2; ++b)
#pragma unroll
            for (int m = 0; m < 4; ++m)
#pragma unroll
                for (int n = 0; n < 2; ++n) acc[a][b][m][n] = (f32x4){0.f, 0.f, 0.f, 0.f};
    bf16x8 At[4][2], B0[2][2], B1[2][2];
    const char* cA = (const char*)g.A + (size_t)cur.pm * tstep; const char* cB = (const char*)g.Bt + (size_t)cur.pn * tstep;
    S.a_ready(cur);
    if constexpr (SP2) {
        PG8_STAGE(PG8_SB(0, 0), cB, voffB); PG8_STAGE(PG8_SB(0, 1), cB + hstep, voffB); PG8_STAGE(PG8_SA(0, 0), cA, voffA); PG8_STAGE(PG8_SA(0, 1), cA + hstep, voffA);
        if (wr == 1) PG8_BAR;
        PG8_WAIT_V(2); PG8_BAR;
        PG8_STAGE(PG8_SB(1, 0), cB + kstep, voffB); PG8_STAGE(PG8_SA(1, 0), cA + kstep, voffA); PG8_STAGE(PG8_SB(1, 1), cB + hstep + kstep, voffB);
        PG8_WAIT_V(6); PG8_BAR;
    } else {
        PG8_STAGE(PG8_SB(0, 0), cB, voffB); PG8_STAGE(PG8_SA(0, 0), cA, voffA); PG8_STAGE(PG8_SB(0, 1), cB + hstep, voffB); PG8_STAGE(PG8_SA(0, 1), cA + hstep, voffA);
        if (wr == 1) PG8_BAR;
        PG8_WAIT_V(4); PG8_BAR;
        PG8_STAGE(PG8_SB(1, 0), cB + kstep, voffB); PG8_STAGE(PG8_SA(1, 0), cA + kstep, voffA); PG8_STAGE(PG8_SB(1, 1), cB + hstep + kstep, voffB);
        PG8_WAIT_V(6); PG8_BAR;
    }
    for (;;) {
        const bool has_next = S.next(ui + 1, nxt);
        const char* nA = has_next ? (const char*)g.A + (size_t)nxt.pm * tstep : cA; const char* nB = has_next ? (const char*)g.Bt + (size_t)nxt.pn * tstep : cB;
        for (int t = 0; t < nt; t += 2) {
            const bool last = (t == nt - 2);
            const char* a1 = cA + (size_t)(t + 1) * kstep;
            const char* a2 = last ? nA : cA + (size_t)(t + 2) * kstep; const char* b2 = last ? nB : cB + (size_t)(t + 2) * kstep;
            const char* a3 = a2 + kstep; const char* b3 = b2 + kstep;
            if (last && has_next) S.a_ready(nxt);
            if constexpr (SP2) {
            PG8_LDB(B0, 0, 0); PG8_LDB(B1, 0, 1); PG8_SCHED; PG8_LDA(At, 0, 0); PG8_STAGE(PG8_SA(1, 1), a1 + hstep, voffA);
            PG8_WAIT_V(8); PG8_WAIT_L(0); PG8_BAR; PG8_MMA(0, 0, At, B0); PG8_MMA(0, 1, At, B1); PG8_BAR; PG8_SCHED;
            PG8_LDA(At, 0, 1); PG8_STAGE(PG8_SB(0, 0), b2, voffB); PG8_STAGE(PG8_SB(0, 1), b2 + hstep, voffB); PG8_STAGE(PG8_SA(0, 0), a2, voffA);
            PG8_WAIT_V(8); PG8_WAIT_L(0); PG8_BAR; PG8_MMA(1, 0, At, B0); PG8_MMA(1, 1, At, B1); PG8_BAR; PG8_SCHED;
            PG8_LDB(B0, 1, 0); PG8_LDB(B1, 1, 1); PG8_SCHED; PG8_LDA(At, 1, 0); PG8_STAGE(PG8_SA(0, 1), a2 + hstep, voffA);
            PG8_WAIT_V(8); PG8_WAIT_L(0); PG8_BAR; PG8_MMA(0, 0, At, B0); PG8_MMA(0, 1, At, B1); PG8_BAR; PG8_SCHED;
            PG8_LDA(At, 1, 1); PG8_STAGE(PG8_SB(1, 0), b3, voffB); PG8_STAGE(PG8_SB(1, 1), b3 + hstep, voffB); PG8_STAGE(PG8_SA(1, 0), a3, voffA);
            PG8_WAIT_V(8); PG8_WAIT_L(0); PG8_BAR; PG8_MMA(1, 0, At, B0); PG8_MMA(1, 1, At, B1); PG8_BAR; PG8_SCHED;
            } else {
            PG8_LDB(B0, 0, 0); PG8_SCHED; PG8_LDA(At, 0, 0); PG8_STAGE(PG8_SA(1, 1), a1 + hstep, voffA);
            PG8_WAIT_L(8); PG8_BAR; PG8_WAIT_L(0); PG8_MMA(0, 0, At, B0); PG8_BAR; PG8_SCHED;
            PG8_LDB(B1, 0, 1); PG8_STAGE(PG8_SB(0, 0), b2, voffB);
            PG8_BAR; PG8_WAIT_L(0); PG8_MMA(0, 1, At, B1); PG8_BAR;
            PG8_LDA(At, 0, 1); PG8_STAGE(PG8_SA(0, 0), a2, voffA);
            PG8_BAR; PG8_WAIT_L(0); PG8_MMA(1, 0, At, B0); PG8_BAR; PG8_SCHED;
            PG8_STAGE(PG8_SB(0, 1), b2 + hstep, voffB);
            PG8_WAIT_V(6); PG8_BAR; PG8_MMA(1, 1, At, B1); PG8_BAR;
            PG8_LDB(B0, 1, 0); PG8_SCHED; PG8_LDA(At, 1, 0); PG8_STAGE(PG8_SA(0, 1), a2 + hstep, voffA);
            PG8_WAIT_L(8); PG8_BAR; PG8_WAIT_L(0); PG8_MMA(0, 0, At, B0); PG8_BAR; PG8_SCHED;
            PG8_LDB(B1, 1, 1); PG8_STAGE(PG8_SB(1, 0), b3, voffB);
            PG8_BAR; PG8_WAIT_L(0); PG8_MMA(0, 1, At, B1); PG8_BAR;
            PG8_LDA(At, 1, 1); PG8_STAGE(PG8_SA(1, 0), a3, voffA);
            PG8_BAR; PG8_WAIT_L(0); PG8_MMA(1, 0, At, B0); PG8_BAR; PG8_SCHED;
            PG8_STAGE(PG8_SB(1, 1), b3 + hstep, voffB);
            PG8_WAIT_V(6); PG8_BAR; PG8_MMA(1, 1, At, B1); PG8_BAR;
            }
        }
        if constexpr (ALIGN_EPI) { if (wr == 0) PG8_BAR; }
        if constexpr (!Epi::AFTER_DRAIN) { E(acc, cur, wr, wc, fr, fq); S.done(cur); }
        if (!has_next) break;
#pragma unroll
        for (int a = 0; a < 2; ++a)
#pragma unroll
            for (int b = 0; b < 2; ++b)
#pragma unroll
                for (int m = 0; m < 4; ++m)
#pragma unroll
                    for (int n = 0; n < 2; ++n) acc[a][b][m][n] = (f32x4){0.f, 0.f, 0.f, 0.f};
        cur = nxt; cA = nA; cB = nB; ++ui;
        if constexpr (ALIGN_EPI) { if (wr == 1) PG8_BAR; }
    }
    PG8_WAIT_V(0);
    if constexpr (!ALIGN_EPI) { if (wr == 0) PG8_BAR; }
    PG8_BAR;
    if constexpr (Epi::AFTER_DRAIN) { E.fused(acc, cur, wr, wc, fr, fq, lds, wid, lane); S.done(cur); }
#undef PG8_SA
#undef PG8_SB
#undef PG8_STAGE
#undef PG8_LDA
#undef PG8_LDB
#undef PG8_MMA
#undef PG8_WAIT_V
#undef PG8_WAIT_L
#undef PG8_BAR
#undef PG8_SCHED
}
}

#ifndef PG8_SP2
#define PG8_SP2 true
#endif
#include <hip/hip_bf16.h>
#include <cmath>
namespace attn_body {
using bf16=__hip_bfloat16;
using bf16x8=__attribute__((ext_vector_type(8)))short;
using s16x4=__attribute__((ext_vector_type(4)))short;
using f32x16=__attribute__((ext_vector_type(16)))float;
using u32x4=__attribute__((ext_vector_type(4)))unsigned;
constexpr int BATCH=8,NHEAD=8,SEQ=4096,D=64,DM=3072,OPITCH=1024;
constexpr int NW=8,QBLK=32,QB=QBLK*NW,KVBLK=64,NQB=SEQ/QB;
constexpr int ATTN_PITCH=DM, ATTN_UNIT_ROWS=QB;
__device__ __forceinline__ int crow(int r,int hi){return (r&3)+8*(r>>2)+4*hi;}
#define SBAR() __builtin_amdgcn_sched_barrier(0)
__device__ __forceinline__ void cmask(f32x16&p0,f32x16&p1,int jb,int qrel,int hi){
  const float NEG=-INFINITY; int kb=64*jb+4*hi;
  #pragma unroll
  for(int r=0;r<16;++r){int kv=kb+(r&3)+8*(r>>2); if(kv>qrel)p0[r]=NEG; if(kv+32>qrel)p1[r]=NEG;}
}

constexpr int NSLOT=3, SLOTB=8192;
constexpr int LDS_K=0, LDS_V=NSLOT*SLOTB, LDS_WS=2*NSLOT*SLOTB, LDS_OST=LDS_WS+NW*64*4, LDS_BYTES=LDS_OST+NW*4096;
constexpr float C2=0.125f*1.4426950408889634f;
__device__ __forceinline__ void glds16(const void*gsrc,unsigned lds_dst){unsigned keep;
  asm volatile("s_mov_b32 %0, m0\n\ts_mov_b32 m0, %2\n\ts_nop 0\n\tglobal_load_lds_dwordx4 %1, off\n\ts_mov_b32 m0, %0":"=&s"(keep):"v"(gsrc),"s"(lds_dst):"memory");}
__device__ __forceinline__ float max3f(float a,float b,float c){float r;asm("v_max3_f32 %0, %1, %2, %3":"=v"(r):"v"(a),"v"(b),"v"(c));return r;}
__device__ __forceinline__ float max2f(float a,float b){float r;asm("v_max_f32_e32 %0, %1, %2":"=v"(r):"v"(a),"v"(b));return r;}
__device__ __forceinline__ float fadd_s(float a,float b){float r;asm("v_add_f32_e32 %0, %1, %2":"=v"(r):"v"(a),"v"(b));return r;}
__device__ __forceinline__ float fsub_s(float a,float b){float r;asm("v_sub_f32_e32 %0, %1, %2":"=v"(r):"v"(a),"v"(b));return r;}
typedef float f32x2_t __attribute__((ext_vector_type(2))); typedef float f32x4_t __attribute__((ext_vector_type(4))); typedef __bf16 bf16x2_t __attribute__((ext_vector_type(2)));
__device__ __forceinline__ unsigned cvtpk_s(float lo,float hi){f32x2_t v={lo,hi};bf16x2_t b=__builtin_convertvector(v,bf16x2_t);return __builtin_bit_cast(unsigned,b);}
#define WAIT_BAR(N) asm volatile("s_waitcnt vmcnt(" #N ") lgkmcnt(0)\n\ts_barrier":::"memory")

__device__ __forceinline__ void qkt(f32x16&p0,f32x16&p1,const char*Kslot,const bf16x8*qr,int r32,int hi){
  const char*kb=Kslot+hi*1024+r32*16;
  #pragma unroll
  for(int d0=0;d0<4;++d0){
    const bf16x8 b0=*reinterpret_cast<const bf16x8*>(kb+d0*2048);
    const bf16x8 b1=*reinterpret_cast<const bf16x8*>(kb+d0*2048+512);
    p0=__builtin_amdgcn_mfma_f32_32x32x16_bf16(b0,qr[d0],p0,0,0,0);p1=__builtin_amdgcn_mfma_f32_32x32x16_bf16(b1,qr[d0],p1,0,0,0);}
}
typedef __attribute__((address_space(3))) const char* lds_cptr;
typedef short v4i16_t __attribute__((ext_vector_type(4)));
__device__ __forceinline__ void kload8(bf16x8*kf,lds_cptr kp){
  kf[0]=*(const __attribute__((address_space(3))) bf16x8*)(kp);      kf[1]=*(const __attribute__((address_space(3))) bf16x8*)(kp+512);
  kf[2]=*(const __attribute__((address_space(3))) bf16x8*)(kp+2048); kf[3]=*(const __attribute__((address_space(3))) bf16x8*)(kp+2560);
  kf[4]=*(const __attribute__((address_space(3))) bf16x8*)(kp+4096); kf[5]=*(const __attribute__((address_space(3))) bf16x8*)(kp+4608);
  kf[6]=*(const __attribute__((address_space(3))) bf16x8*)(kp+6144); kf[7]=*(const __attribute__((address_space(3))) bf16x8*)(kp+6656);
}
__device__ __forceinline__ void kload2(bf16x8*kf,lds_cptr kp,int j){ kf[2*j]=*(const __attribute__((address_space(3))) bf16x8*)(kp+j*2048); kf[2*j+1]=*(const __attribute__((address_space(3))) bf16x8*)(kp+j*2048+512); }
__device__ __forceinline__ s16x4 vtr(lds_cptr p){ return __builtin_bit_cast(s16x4,__builtin_amdgcn_ds_read_tr16_b64_v4i16((__attribute__((address_space(3))) v4i16_t*)p)); }
__device__ __forceinline__ float rowmax(const f32x16&p0,const f32x16&p1){
  float a=max3f(p0[0],p0[1],p1[0]),b=max3f(p0[2],p0[3],p1[1]);a=max3f(a,p1[2],p1[3]);
  #pragma unroll
  for(int r=4;r<16;r+=4){a=max3f(a,p0[r],p0[r+1]);b=max3f(b,p0[r+2],p0[r+3]);a=max3f(a,p1[r],p1[r+1]);b=max3f(b,p1[r+2],p1[r+3]);}
  const float m=max2f(a,b);
  auto rr=__builtin_amdgcn_permlane32_swap(__float_as_uint(m),__float_as_uint(m),false,false);
  return max2f(__uint_as_float(rr[0]),__uint_as_float(rr[1]));
}
__device__ __forceinline__ void pv(f32x16*o,int vb,bf16x8 pa0,bf16x8 pa1,bf16x8 pa2,bf16x8 pa3){
  #pragma unroll
  for(int d0=0;d0<2;++d0){s16x4 lo[4],hi[4];
    #pragma unroll
    for(int ks=0;ks<4;++ks){
      asm volatile("ds_read_b64_tr_b16 %0,%1 offset:%c2":"=&v"(lo[ks]):"v"(vb),"i"(d0*4096+ks*1024):"memory");
      asm volatile("ds_read_b64_tr_b16 %0,%1 offset:%c2":"=&v"(hi[ks]):"v"(vb),"i"(d0*4096+ks*1024+512):"memory");}
    asm volatile("s_waitcnt lgkmcnt(0)":::"memory");SBAR();
    #define PK(k) (bf16x8){lo[k][0],lo[k][1],lo[k][2],lo[k][3],hi[k][0],hi[k][1],hi[k][2],hi[k][3]}
    o[d0]=__builtin_amdgcn_mfma_f32_32x32x16_bf16(pa0,PK(0),o[d0],0,0,0);
    o[d0]=__builtin_amdgcn_mfma_f32_32x32x16_bf16(pa1,PK(1),o[d0],0,0,0);
    o[d0]=__builtin_amdgcn_mfma_f32_32x32x16_bf16(pa2,PK(2),o[d0],0,0,0);
    o[d0]=__builtin_amdgcn_mfma_f32_32x32x16_bf16(pa3,PK(3),o[d0],0,0,0);
    #undef PK
  }
}

#ifndef ATTN_STORE16
#define ATTN_STORE16(p,v) (*(u32x4*)(p)=(v))
#endif
typedef __attribute__((address_space(3))) const float* lds_fptr; typedef __attribute__((address_space(3))) const f32x4_t* lds_f4ptr;
template<int THRL> __device__ __forceinline__ void attn_unit(int b,int h,int qb,const bf16*Q,const bf16*__restrict__ K,const bf16*__restrict__ V,bf16*O,char*shm,lds_fptr cl,const float*__restrict__ gain){
  const int tid=threadIdx.x,lane=tid&63,r32=lane&31,hi=lane>>5; const int wid=__builtin_amdgcn_readfirstlane(tid>>6);
  const long rowbase=(long)b*SEQ; const int q0=qb*QB;
  const bf16*Qw=Q+(rowbase+q0+wid*QBLK)*DM+h*D;
  const bf16*Kh=K+rowbase*DM+h*D,*Vh=V+rowbase*DM+h*D;
  const unsigned lds0=(unsigned)(uintptr_t)shm;
  float*wsf=(float*)(shm+LDS_WS)+wid*64;
  const bf16*ksrc=Kh+(long)lane*DM+wid*8;
  const bf16*vsrc=Vh+(long)(16*(wid&3)+(lane>>2))*DM+(wid>>2)*32+(lane&3)*8;
  const unsigned kdst=lds0+LDS_K+wid*1024, vdst=lds0+LDS_V+wid*1024;
  #define DMA_K(t,slot) glds16(ksrc+(long)(t)*KVBLK*DM,(unsigned)__builtin_amdgcn_readfirstlane(kdst+(slot)))
  #define DMA_V(t,slot) glds16(vsrc+(long)(t)*KVBLK*DM,(unsigned)__builtin_amdgcn_readfirstlane(vdst+(slot)))
  const int vb0=(int)(lds0+LDS_V)+((lane>>4)&1)*32+(lane&3)*8+(4*hi+((lane&15)>>2))*64;
  const char*Kbase=shm+LDS_K; bf16x8 kf[8];
  const lds_cptr shm3=(lds_cptr)shm; const lds_cptr kp0=shm3+LDS_K+hi*1024+r32*16; const lds_cptr vp0=shm3+LDS_V+((lane>>4)&1)*32+(lane&3)*8+(4*hi+((lane&15)>>2))*64;
  const int NT=(q0+QB)/KVBLK;
  DMA_K(0,0);DMA_V(0,0);DMA_K(1,SLOTB);
  bf16x8 qr[4];
  #pragma unroll
  for(int d0=0;d0<4;++d0)qr[d0]=*reinterpret_cast<const bf16x8*>(&Qw[(long)r32*DM+d0*16+hi*8]);
  float l_reg=0.f;f32x16 o[2];o[0]=f32x16{};o[1]=f32x16{};
  const int qrel=wid*QBLK+r32;
  float aq=cl[q0+qrel];
  #define CINIT(C0,C1,t) do{ const lds_f4ptr cp_=(lds_f4ptr)(cl+64*(t)+4*hi); _Pragma("unroll") for(int j_=0;j_<4;++j_){ const f32x4_t v0_=cp_[2*j_],v1_=cp_[8+2*j_]; _Pragma("unroll") for(int i_=0;i_<4;++i_){ C0[4*j_+i_]=aq-v0_[i_]; C1[4*j_+i_]=aq-v1_[i_]; } } }while(0)
  #define CMASK(P0,P1,t) do{int jb_=(t)-(NT-4); if(jb_>=0)cmask(P0,P1,jb_,qrel,hi);}while(0)
  bool resc=false;
  #define START(P0,P1) do{ const float rm=rowmax(P0,P1); resc=false; \
    { const float dl=rm; aq=fsub_s(aq,dl); \
      _Pragma("unroll") for(int r=0;r<16;++r){P0[r]=fsub_s(P0[r],dl);P1[r]=fsub_s(P1[r],dl);} } \
    _Pragma("unroll") for(int r=0;r<16;++r)P0[r]=__builtin_amdgcn_exp2f(P0[r]); }while(0)
  #define RESC() do{ if(resc){ asm volatile("s_waitcnt lgkmcnt(0)":::"memory"); \
      _Pragma("unroll") for(int d_=0;d_<2;++d_) _Pragma("unroll") for(int r=0;r<16;++r)o[d_][r]*=wsf[crow(r,hi)]; } }while(0)
  f32x16 pA0,pA1,pB0,pB1;
  int sl_prev=0,sl_cur=0,sl_next=SLOTB;
  #define ROT() do{sl_prev=sl_cur;sl_cur=sl_next;sl_next=(sl_next==(NSLOT-1)*SLOTB)?0:sl_next+SLOTB;}while(0)
  DMA_K(2,2*SLOTB);
  WAIT_BAR(3);
  CINIT(pA0,pA1,0);qkt(pA0,pA1,Kbase,qr,r32,hi);asm volatile("s_nop 15\n\ts_nop 7":"+v"(pA0),"+v"(pA1));CMASK(pA0,pA1,0);
  START(pA0,pA1);
  _Pragma("unroll") for(int r=0;r<16;++r)pA1[r]=__builtin_amdgcn_exp2f(pA1[r]);
  WAIT_BAR(0);
  DMA_K(3,0);DMA_V(1,SLOTB);
  ROT();
  kload8(kf,kp0+sl_cur);
  WAIT_BAR(2);
  s16x4 vlo[8],vhi[8]; u32x4 pw0,pw1,pw2,pw3;
  #define PKW(P,B) cvtpk_s(P[B],P[B+1])
  #define PAF(k) __builtin_bit_cast(bf16x8,pw##k)
  #define VFR(i) (bf16x8){vlo[i][0],vlo[i][1],vlo[i][2],vlo[i][3],vhi[i][0],vhi[i][1],vhi[i][2],vhi[i][3]}
  #define PIN(x) asm volatile("":"+v"(x))
  #define MX3(a,b,c) __builtin_fmaxf(__builtin_fmaxf((a),(b)),(c))
  #define GAPA(MF,A0,A1,A2,A3,W0,W1,PW) do{ MF; sacc+=A0; sacc+=A1; sacc+=A2; sacc+=A3; PIN(sacc); W0; W1; PIN(PW); SBAR(); }while(0)
  #define EX(v) __builtin_amdgcn_exp2f(v)
  #define GAPB(MF,X,B) do{ MF; X[B]=EX(X[B]); X[B+1]=EX(X[B+1]); X[B+2]=EX(X[B+2]); X[B+3]=EX(X[B+3]); PIN(X); SBAR(); }while(0)
  #define VRD(i) do{ vlo[i]=vtr(vp_+(((i)>>2)*4096+((i)&3)*1024)); vhi[i]=vtr(vp_+(((i)>>2)*4096+((i)&3)*1024+512)); }while(0)
  #define KRD(G,j) do{ if(G){ kload2(kf,kp0+sl_next,j); SBAR(); } }while(0)
  #define STEP(C0,C1,P0,P1,t,GK,GV,GL) do{ SBAR(); CINIT(C0,C1,t); SBAR(); \
    const lds_cptr vp_=vp0+sl_prev; \
    VRD(0); SBAR(); float sacc=(P0[0]+P0[1]); \
    GAPA(C0=__builtin_amdgcn_mfma_f32_32x32x16_bf16(kf[0],qr[0],C0,0,0,0), P0[2],P0[3],P0[4],P0[5],     pw0[0]=PKW(P0,0), pw0[1]=PKW(P0,2), pw0); \
    VRD(4); SBAR(); GAPA(C1=__builtin_amdgcn_mfma_f32_32x32x16_bf16(kf[1],qr[0],C1,0,0,0), P0[6],P0[7],P0[8],P0[9],     pw0[2]=PKW(P0,4), pw0[3]=PKW(P0,6), pw0); \
    VRD(1); SBAR(); GAPA(C0=__builtin_amdgcn_mfma_f32_32x32x16_bf16(kf[2],qr[1],C0,0,0,0),   P0[10],P0[11],P0[12],P0[13], pw1[0]=PKW(P0,8), pw1[1]=PKW(P0,10), pw1); \
    VRD(5); SBAR(); GAPA(C1=__builtin_amdgcn_mfma_f32_32x32x16_bf16(kf[3],qr[1],C1,0,0,0),   P0[14],P0[15],P1[0],P1[1],   pw1[2]=PKW(P0,12),pw1[3]=PKW(P0,14), pw1); \
    VRD(2); SBAR(); GAPA(C0=__builtin_amdgcn_mfma_f32_32x32x16_bf16(kf[4],qr[2],C0,0,0,0),   P1[2],P1[3],P1[4],P1[5],     pw2[0]=PKW(P1,0), pw2[1]=PKW(P1,2), pw2); \
    VRD(6); SBAR(); GAPA(C1=__builtin_amdgcn_mfma_f32_32x32x16_bf16(kf[5],qr[2],C1,0,0,0),   P1[6],P1[7],P1[8],P1[9],     pw2[2]=PKW(P1,4), pw2[3]=PKW(P1,6), pw2); \
    VRD(3); SBAR(); GAPA(C0=__builtin_amdgcn_mfma_f32_32x32x16_bf16(kf[6],qr[3],C0,0,0,0),   P1[10],P1[11],P1[12],P1[13], pw3[0]=PKW(P1,8), pw3[1]=PKW(P1,10), pw3); \
    VRD(7); SBAR(); GAPA(C1=__builtin_amdgcn_mfma_f32_32x32x16_bf16(kf[7],qr[3],C1,0,0,0),   P1[14],P1[15],0.f,0.f,       pw3[2]=PKW(P1,12),pw3[3]=PKW(P1,14), pw3); \
    l_reg+=sacc; \
    if(GK){DMA_K((t)+3,sl_cur);} if(GV){DMA_V((t)+1,sl_next);} \
    CMASK(C0,C1,t); \
    { float a=MX3(C0[0],C0[1],C1[0]),b=MX3(C0[2],C0[3],C1[1]); a=MX3(a,C1[2],C1[3]); \
      _Pragma("unroll") for(int r=4;r<16;r+=4){a=MX3(a,C0[r],C0[r+1]);b=MX3(b,C0[r+2],C0[r+3]);a=MX3(a,C1[r],C1[r+1]);b=MX3(b,C1[r+2],C1[r+3]);} \
      float rm=__builtin_fmaxf(a,b); { auto rr=__builtin_amdgcn_permlane32_swap(__float_as_uint(rm),__float_as_uint(rm),false,false); rm=__builtin_fmaxf(__uint_as_float(rr[0]),__uint_as_float(rr[1])); } \
      resc=false; \
      if(__builtin_expect(__any(rm>(float)THRL),0)){ const float dl=__builtin_fmaxf(rm,0.f); aq-=dl; \
        _Pragma("unroll") for(int r=0;r<16;++r){C0[r]-=dl;C1[r]-=dl;} \
        const float f=__builtin_amdgcn_exp2f(-dl); l_reg*=f; if(hi==0)wsf[r32]=f; resc=true; } } \
    SBAR(); \
    GAPB(o[0]=__builtin_amdgcn_mfma_f32_32x32x16_bf16(PAF(0),VFR(0),o[0],0,0,0), C0,0); \
    GAPB(o[1]=__builtin_amdgcn_mfma_f32_32x32x16_bf16(PAF(0),VFR(4),o[1],0,0,0), C0,4); \
    KRD(GL,0); GAPB(o[0]=__builtin_amdgcn_mfma_f32_32x32x16_bf16(PAF(1),VFR(1),o[0],0,0,0), C0,8); \
    KRD(GL,1); GAPB(o[1]=__builtin_amdgcn_mfma_f32_32x32x16_bf16(PAF(1),VFR(5),o[1],0,0,0), C0,12); \
    KRD(GL,2); GAPB(o[0]=__builtin_amdgcn_mfma_f32_32x32x16_bf16(PAF(2),VFR(2),o[0],0,0,0), C1,0); \
    KRD(GL,3); GAPB(o[1]=__builtin_amdgcn_mfma_f32_32x32x16_bf16(PAF(2),VFR(6),o[1],0,0,0), C1,4); \
    GAPB(o[0]=__builtin_amdgcn_mfma_f32_32x32x16_bf16(PAF(3),VFR(3),o[0],0,0,0), C1,8); \
    GAPB(o[1]=__builtin_amdgcn_mfma_f32_32x32x16_bf16(PAF(3),VFR(7),o[1],0,0,0), C1,12); \
    }while(0)
  int t=1;
  #undef CMASK
  #define CMASK(P0,P1,t) do{}while(0)
  for(;t+5<NT;t+=2){
    STEP(pB0,pB1,pA0,pA1,t,true,true,true);     WAIT_BAR(2); RESC(); ROT();
    STEP(pA0,pA1,pB0,pB1,t+1,true,true,true);   WAIT_BAR(2); RESC(); ROT();
  }
  #undef CMASK
  #define CMASK(P0,P1,t) do{int jb_=(t)-(NT-4); if(jb_>=0)cmask(P0,P1,jb_,qrel,hi);}while(0)
  #define ENDW(tt) do{ if((tt)+3<NT){WAIT_BAR(2);} else if((tt)+2<NT){WAIT_BAR(1);} else {WAIT_BAR(0);} }while(0)
  for(;t+1<NT;t+=2){
    STEP(pB0,pB1,pA0,pA1,t,(t+3<NT),(t+1<NT),(t+1<NT));       ENDW(t);   RESC(); ROT();
    STEP(pA0,pA1,pB0,pB1,t+1,(t+4<NT),(t+2<NT),(t+2<NT));     ENDW(t+1); RESC(); ROT();
  }
  STEP(pB0,pB1,pA0,pA1,NT-1,false,false,false); RESC();
  { float sacc=pB0[0]+pB0[1]; _Pragma("unroll") for(int r=2;r<16;++r)sacc+=pB0[r]; _Pragma("unroll") for(int r=0;r<16;++r)sacc+=pB1[r]; l_reg+=sacc;
    pw0=(u32x4){PKW(pB0,0),PKW(pB0,2),PKW(pB0,4),PKW(pB0,6)};pw1=(u32x4){PKW(pB0,8),PKW(pB0,10),PKW(pB0,12),PKW(pB0,14)};pw2=(u32x4){PKW(pB1,0),PKW(pB1,2),PKW(pB1,4),PKW(pB1,6)};pw3=(u32x4){PKW(pB1,8),PKW(pB1,10),PKW(pB1,12),PKW(pB1,14)};
    SBAR(); pv(o,vb0+sl_cur,PAF(0),PAF(1),PAF(2),PAF(3)); }
  #undef PKW
  #undef PAF
  #undef VFR
  #undef PIN
  #undef MX3
  #undef GAPA
  #undef GAPB
  #undef EX
  #undef VRD
  #undef KRD
  #undef STEP
  #undef ENDW
  {auto rr=__builtin_amdgcn_permlane32_swap(__float_as_uint(l_reg),__float_as_uint(l_reg),false,false);l_reg=__uint_as_float(rr[0])+__uint_as_float(rr[1]);}
  if(hi==0)wsf[32+r32]=l_reg;asm volatile("s_waitcnt lgkmcnt(0)":::"memory");
  float rli[16];
  #pragma unroll
  for(int r=0;r<16;++r)rli[r]=__builtin_amdgcn_rcpf(wsf[32+crow(r,hi)]);
  bf16*Ow=O+(rowbase+q0+wid*QBLK)*OPITCH+h*D;
  { bf16*stg=(bf16*)(shm+LDS_OST)+wid*2048;
    #pragma unroll
    for(int r=0;r<16;++r){const int orow=crow(r,hi);
      #pragma unroll
      for(int d0=0;d0<2;++d0)stg[orow*64+d0*32+r32]=__float2bfloat16(o[d0][r]*rli[r]);}
    asm volatile("s_waitcnt lgkmcnt(0)":::"memory");
    #pragma unroll
    for(int i=0;i<4;++i){const int row=i*8+(lane>>3),ch=lane&7; const u32x4 v=*(const u32x4*)(stg+row*64+ch*8);
      float x[8]; _Pragma("unroll") for(int k=0;k<4;++k){x[2*k]=__uint_as_float(v[k]<<16);x[2*k+1]=__uint_as_float(v[k]&0xffff0000u);}
      float ss=0.f; _Pragma("unroll") for(int k=0;k<8;++k)ss+=x[k]*x[k];
      ss+=__shfl_xor(ss,1);ss+=__shfl_xor(ss,2);ss+=__shfl_xor(ss,4);
      const float rs=1.0f/sqrtf(ss*(1.0f/64.0f)+1e-6f); const f32x4_t g0=*(const f32x4_t*)(gain+h*D+ch*8),g1=*(const f32x4_t*)(gain+h*D+ch*8+4);
      u32x4 w; w[0]=cvtpk_s(x[0]*rs*g0[0],x[1]*rs*g0[1]);w[1]=cvtpk_s(x[2]*rs*g0[2],x[3]*rs*g0[3]);w[2]=cvtpk_s(x[4]*rs*g1[0],x[5]*rs*g1[1]);w[3]=cvtpk_s(x[6]*rs*g1[2],x[7]*rs*g1[3]);
      ATTN_STORE16(Ow+(long)row*OPITCH+ch*8,w);} }
  asm volatile("s_waitcnt lgkmcnt(0)\n\ts_barrier":::"memory");
  #undef DMA_K
  #undef DMA_V
  #undef CMASK
  #undef START
  #undef CINIT
  #undef RESC
  #undef ROT
}
constexpr int ATTN_LDS_BYTES=LDS_BYTES;
#undef SBAR
#undef WAIT_BAR
}
#ifndef MK_MULTI
#define MK_MULTI 1
#endif
constexpr int NWAVES = 8, NTHR = 512;
constexpr int Mrows = 32768, DM_ = 1024, DFF = 2816, SEQL = 4096, DPLE = 256;
constexpr int NPH = 12;
constexpr size_t MiB = 1u << 20;
constexpr size_t WS_W1GU = 2 * MiB, WS_W1D = 14 * MiB, WS_WIN = 20 * MiB, WS_WOUT = 27 * MiB, WS_W2GU = 30 * MiB, WS_W2D = 42 * MiB, WS_WPG = 48 * MiB, WS_WPP = 50 * MiB;
constexpr size_t WS_GATES = 52 * MiB, WS_CL = 54 * MiB, WS_BARR = 55 * MiB, WS_RARR = 55 * MiB + 512 * 1024, WS_NLOC = 56 * MiB, WS_NPREV = 56 * MiB + 512 * 1024;
constexpr size_t WS_GARR = 57 * MiB, WS_MLOC = 57 * MiB + 65536, WS_MPREV = 57 * MiB + 131072;
constexpr size_t WS_SS0 = 58 * MiB, WS_SS1 = 60 * MiB, WS_SS2 = 62 * MiB, WS_SS3 = 64 * MiB, WS_SS4 = 66 * MiB, WS_SSP = 68 * MiB;
constexpr size_t WS_XN = 72 * MiB;
constexpr size_t WS_ACTZ = 136 * MiB;
constexpr size_t WS_YMIX = 328 * MiB;
constexpr size_t WS_UT = 392 * MiB;
constexpr size_t WS_CT = 456 * MiB;
constexpr size_t WS_PB = 488 * MiB;
constexpr size_t WS_END = 504 * MiB;
constexpr int LDS_BYTES = 147456;
constexpr int WIN_ROWS = 3328;

#define LAS __attribute__((address_space(3)))
typedef unsigned short bf16;
typedef unsigned v4u __attribute__((ext_vector_type(4)));
typedef float f32x4 __attribute__((ext_vector_type(4)));
typedef short bf16x8 __attribute__((ext_vector_type(8)));
#define LDS_WAIT() asm volatile("s_waitcnt lgkmcnt(0)" ::: "memory")
__device__ __forceinline__ unsigned f2bf(float f) { unsigned u = __builtin_bit_cast(unsigned, f); return (u + 0x7fffu + ((u >> 16) & 1u)) >> 16; }
__device__ __forceinline__ unsigned pk2(float lo, float hi) { return f2bf(lo) | (f2bf(hi) << 16); }
__device__ __forceinline__ float bf2f(unsigned h) { return __uint_as_float(h << 16); }
__device__ __forceinline__ float logsig_f(float x) { return fminf(x, 0.f) - log1pf(__expf(-fabsf(x))); }
__device__ __forceinline__ float sigm_f(float x) { return 1.0f / (1.0f + __expf(-x)); }

__device__ __forceinline__ int wmap(int map, int n) {
    if (map == 1) return ((n >> 7) << 8) + (n & 127);
    if (map == 2) return ((n >> 7) << 8) + 128 + (n & 127);
    if (map == 3) { if (n < 1536) return n; if (n < 1544) return 3072 + (n - 1536); if (n < 3080) return n - 8; return n; }
    return n;
}
__device__ __forceinline__ void p0_transpose_item(const float* __restrict__ W, int K, int N, bf16* WT, int map, const float* __restrict__ gain, LAS float* scr, int item, int lane) {
    const int nblk = (N + 31) / 32, kb = item / nblk, nb = item % nblk, k0 = 64 * kb, n0 = 32 * nb;
    const int nin = n0 + (lane & 31); const bool ok = nin < N;
#pragma unroll 8
    for (int i = 0; i < 32; ++i) { const int kk = 2 * i + (lane >> 5); float v = ok ? W[(size_t)(k0 + kk) * N + nin] : 0.f; if (gain) v *= gain[k0 + kk]; scr[kk * 33 + (lane & 31)] = v; }
    LDS_WAIT(); asm volatile("" ::: "memory");
    const int c = lane & 7;
#pragma unroll
    for (int j = 0; j < 4; ++j) { const int n = (lane >> 3) + 8 * j; const LAS float* s = scr + (8 * c) * 33 + n;
        v4u o; o.x = pk2(s[0 * 33], s[1 * 33]); o.y = pk2(s[2 * 33], s[3 * 33]); o.z = pk2(s[4 * 33], s[5 * 33]); o.w = pk2(s[6 * 33], s[7 * 33]);
        if (n0 + n < N) *(v4u*)(WT + (size_t)wmap(map, n0 + n) * K + k0 + 8 * c) = o; }
    LDS_WAIT(); asm volatile("" ::: "memory");
}

constexpr int LDS_LD = 72;
__device__ __forceinline__ bf16x8 frag(const LAS bf16* X, int r0, int k0, int lane) { return *(const LAS bf16x8*)(X + (r0 + (lane & 15)) * LDS_LD + k0 + 8 * (lane >> 4)); }
#define MMA16(a, b, c) __builtin_amdgcn_mfma_f32_16x16x32_bf16((a), (b), (c), 0, 0, 0)

struct Ptrs {
    const float* gates; float *barr, *rarr, *nloc, *nprev, *garr, *mloc, *mprev, *ut; bf16 *ct, *qkc, *z, *ymix; const float *conv, *gm;
};

__device__ __forceinline__ void mlstm_local_item(int ci, LAS unsigned char* lds, const Ptrs& P) {
    const int tid = threadIdx.x, lane = tid & 63, wid = tid >> 6;
    const int bh = ci >> 6, c = ci & 63, b = bh >> 2, h = bh & 3;
    const size_t row0 = (size_t)b * SEQL + (size_t)c * 64;
    LAS bf16* KwT = (LAS bf16*)lds;
    LAS bf16* VT = (LAS bf16*)(lds + 9216);
    LAS float* wv = (LAS float*)(lds + 9216 + 18432);
    if (wid == 0) {
        const float ip = P.gates[(row0 + lane) * 16 + h], fp = P.gates[(row0 + lane) * 16 + 4 + h];
        float bc = logsig_f(fp);
#pragma unroll
        for (int o = 1; o < 64; o <<= 1) { const float t = __shfl_up(bc, o); if (lane >= o) bc += t; }
        const float g = __shfl(bc, 63);
        const float r = ip - bc; float rm = r;
#pragma unroll
        for (int o = 1; o < 64; o <<= 1) rm = fmaxf(rm, __shfl_xor(rm, o));
        wv[lane] = __expf(r - rm);
        P.barr[ci * 64 + lane] = bc; P.rarr[ci * 64 + lane] = r; if (lane == 0) { P.garr[ci] = g; P.mloc[ci] = g + rm; }
    }
    const int cg8 = tid & 15, tl = tid >> 4, isk = cg8 >> 3, zc = isk * 256 + h * 64 + (cg8 & 7) * 8;
    float kv[2][8];
    {
        float cw[4][8];
#pragma unroll
        for (int j = 0; j < 4; ++j) { const f32x4 a = *(const f32x4*)(P.conv + j * 512 + zc), d = *(const f32x4*)(P.conv + j * 512 + zc + 4);
#pragma unroll
            for (int i = 0; i < 4; ++i) { cw[j][i] = a[i]; cw[j][4 + i] = d[i]; } }
#pragma unroll
        for (int p = 0; p < 2; ++p) { const int t = tl + 32 * p, tpos = c * 64 + t; float a[8];
#pragma unroll
            for (int i = 0; i < 8; ++i) a[i] = 0.f;
#pragma unroll
            for (int j = 0; j < 4; ++j) { const int tp = tpos - 3 + j;
                if (tp >= 0) { const v4u zz = *(const v4u*)(P.z + ((size_t)b * SEQL + tp) * 3072 + zc);
#pragma unroll
                    for (int k = 0; k < 4; ++k) { a[2 * k] += cw[j][2 * k] * bf2f(zz[k] & 0xffffu); a[2 * k + 1] += cw[j][2 * k + 1] * __uint_as_float(zz[k] & 0xffff0000u); } } }
            const float sc = isk ? 1.0f : 0.125f;
#pragma unroll
            for (int i = 0; i < 8; ++i) { a[i] = a[i] * sigm_f(a[i]) * sc; kv[p][i] = a[i]; }
            v4u o; o.x = pk2(a[0], a[1]); o.y = pk2(a[2], a[3]); o.z = pk2(a[4], a[5]); o.w = pk2(a[6], a[7]);
            *(v4u*)(P.qkc + (row0 + t) * 512 + zc) = o; }
    }
#pragma unroll
    for (int p = 0; p < 2; ++p) { const int s = tl + 32 * p; const v4u vv = *(const v4u*)(P.z + (row0 + s) * 3072 + 512 + h * 128 + cg8 * 8);
#pragma unroll
        for (int k = 0; k < 4; ++k) { VT[(cg8 * 8 + 2 * k) * LDS_LD + s] = (bf16)(vv[k] & 0xffffu); VT[(cg8 * 8 + 2 * k + 1) * LDS_LD + s] = (bf16)(vv[k] >> 16); } }
    __syncthreads();
    if (isk) {
#pragma unroll
        for (int p = 0; p < 2; ++p) { const int t = tl + 32 * p; const float w = wv[t];
#pragma unroll
            for (int i = 0; i < 8; ++i) KwT[((cg8 & 7) * 8 + i) * LDS_LD + t] = (bf16)f2bf(kv[p][i] * w); }
    }
    __syncthreads();
    {
        f32x4 acc[4];
#pragma unroll
        for (int dj = 0; dj < 4; ++dj) acc[dj] = (f32x4){0.f, 0.f, 0.f, 0.f};
#pragma unroll
        for (int ks = 0; ks < 2; ++ks) { const bf16x8 a = frag(VT, 16 * wid, ks * 32, lane);
#pragma unroll
            for (int dj = 0; dj < 4; ++dj) acc[dj] = MMA16(a, frag(KwT, 16 * dj, ks * 32, lane), acc[dj]); }
        float* up = P.ut + (size_t)ci * 8192;
#pragma unroll
        for (int dj = 0; dj < 4; ++dj)
#pragma unroll
            for (int r = 0; r < 4; ++r) up[(16 * wid + 4 * (lane >> 4) + r) * 64 + 16 * dj + (lane & 15)] = acc[dj][r];
    }
    if (wid == 0) { float s = 0.f;
#pragma unroll 8
        for (int i = 0; i < 64; ++i) s += bf2f(KwT[lane * LDS_LD + i]);
        P.nloc[ci * 64 + lane] = s; }
    __syncthreads();
}

__device__ __forceinline__ void mlstm_out_item(int ci, LAS unsigned char* lds, const Ptrs& P) {
    const int tid = threadIdx.x, lane = tid & 63, wid = tid >> 6;
    const int bh = ci >> 6, c = ci & 63, b = bh >> 2, h = bh & 3;
    const size_t row0 = (size_t)b * SEQL + (size_t)c * 64;
    LAS bf16* Qs = (LAS bf16*)lds; LAS bf16* Qw = (LAS bf16*)(lds + 9216); LAS bf16* Ks = (LAS bf16*)(lds + 18432); LAS bf16* Ps = (LAS bf16*)(lds + 27648);
    LAS bf16* VT = (LAS bf16*)(lds + 36864); LAS bf16* CTs = (LAS bf16*)(lds + 55296); LAS float* NUM = (LAS float*)(lds + 73728);
    LAS float* rvec = (LAS float*)(lds + 107520); LAS float* Mt = rvec + 64; LAS float* wint = rvec + 128; LAS float* emt = rvec + 192; LAS float* npv = rvec + 256; LAS float* denom = rvec + 320;
    if (wid == 0) {
        const float r = P.rarr[ci * 64 + lane], bt = P.barr[ci * 64 + lane], mp = P.mprev[ci];
        float cm = r;
#pragma unroll
        for (int o = 1; o < 64; o <<= 1) { const float t = __shfl_up(cm, o); if (lane >= o) cm = fmaxf(cm, t); }
        const float M = fmaxf(mp, cm);
        rvec[lane] = r; Mt[lane] = M; wint[lane] = __expf(mp - M); emt[lane] = __expf(-bt - M); npv[lane] = P.nprev[ci * 64 + lane];
    }
    const int t8 = tid >> 3, part = tid & 7;
    { const v4u q = *(const v4u*)(P.qkc + (row0 + t8) * 512 + h * 64 + part * 8); *(LAS v4u*)(Qs + t8 * LDS_LD + part * 8) = q;
      const v4u k = *(const v4u*)(P.qkc + (row0 + t8) * 512 + 256 + h * 64 + part * 8); *(LAS v4u*)(Ks + t8 * LDS_LD + part * 8) = k; }
#pragma unroll
    for (int p = 0; p < 2; ++p) { const int idx = tid + 512 * p, e = idx >> 3, pp = idx & 7; const v4u cc = *(const v4u*)(P.ct + (size_t)ci * 8192 + e * 64 + pp * 8); *(LAS v4u*)(CTs + e * LDS_LD + pp * 8) = cc; }
    { const int cg8 = tid & 15, tl = tid >> 4;
#pragma unroll
      for (int p = 0; p < 2; ++p) { const int s = tl + 32 * p; const v4u vv = *(const v4u*)(P.z + (row0 + s) * 3072 + 512 + h * 128 + cg8 * 8);
#pragma unroll
        for (int k = 0; k < 4; ++k) { VT[(cg8 * 8 + 2 * k) * LDS_LD + s] = (bf16)(vv[k] & 0xffffu); VT[(cg8 * 8 + 2 * k + 1) * LDS_LD + s] = (bf16)(vv[k] >> 16); } } }
    __syncthreads();
    { const float w = wint[t8]; const v4u q = *(const LAS v4u*)(Qs + t8 * LDS_LD + part * 8); v4u o;
#pragma unroll
      for (int k = 0; k < 4; ++k) o[k] = pk2(bf2f(q[k] & 0xffffu) * w, __uint_as_float(q[k] & 0xffff0000u) * w);
      *(LAS v4u*)(Qw + t8 * LDS_LD + part * 8) = o; }
    {
        const int ti = wid >> 1;
#pragma unroll
        for (int jj = 0; jj < 2; ++jj) { const int sj = 2 * (wid & 1) + jj; f32x4 acc = (f32x4){0.f, 0.f, 0.f, 0.f};
            if (sj <= ti) {
#pragma unroll
                for (int ks = 0; ks < 2; ++ks) acc = MMA16(frag(Qs, 16 * ti, ks * 32, lane), frag(Ks, 16 * sj, ks * 32, lane), acc);
            }
            const int s = 16 * sj + (lane & 15); const float rs = rvec[s];
#pragma unroll
            for (int r = 0; r < 4; ++r) { const int t = 16 * ti + 4 * (lane >> 4) + r; const float pv = (s <= t) ? __expf(rs - Mt[t]) * acc[r] : 0.f; Ps[t * LDS_LD + s] = (bf16)f2bf(pv); } }
    }
    __syncthreads();
    {
        const v4u q = *(const LAS v4u*)(Qs + t8 * LDS_LD + part * 8), pp = *(const LAS v4u*)(Ps + t8 * LDS_LD + part * 8); float dot = 0.f, ps = 0.f;
#pragma unroll
        for (int k = 0; k < 4; ++k) { dot += bf2f(q[k] & 0xffffu) * npv[part * 8 + 2 * k] + __uint_as_float(q[k] & 0xffff0000u) * npv[part * 8 + 2 * k + 1]; ps += bf2f(pp[k] & 0xffffu) + __uint_as_float(pp[k] & 0xffff0000u); }
        float v = wint[t8] * dot + ps; v += __shfl_xor(v, 1); v += __shfl_xor(v, 2); v += __shfl_xor(v, 4);
        if (part == 0) denom[t8] = fmaxf(fabsf(v), emt[t8]);
    }
    {
        const int ti = wid >> 1, eh = wid & 1; f32x4 acc[4];
#pragma unroll
        for (int ej = 0; ej < 4; ++ej) acc[ej] = (f32x4){0.f, 0.f, 0.f, 0.f};
#pragma unroll
        for (int ks = 0; ks < 2; ++ks) { const bf16x8 a = frag(Qw, 16 * ti, ks * 32, lane);
#pragma unroll
            for (int ej = 0; ej < 4; ++ej) acc[ej] = MMA16(a, frag(CTs, 64 * eh + 16 * ej, ks * 32, lane), acc[ej]); }
#pragma unroll
        for (int ks = 0; ks < 2; ++ks) { const bf16x8 a = frag(Ps, 16 * ti, ks * 32, lane);
#pragma unroll
            for (int ej = 0; ej < 4; ++ej) acc[ej] = MMA16(a, frag(VT, 64 * eh + 16 * ej, ks * 32, lane), acc[ej]); }
#pragma unroll
        for (int ej = 0; ej < 4; ++ej)
#pragma unroll
            for (int r = 0; r < 4; ++r) NUM[(16 * ti + 4 * (lane >> 4) + r) * 132 + 64 * eh + 16 * ej + (lane & 15)] = acc[ej][r];
    }
    __syncthreads();
    {
        const float rd = 1.0f / denom[t8]; float hv[16]; float ss = 0.f;
#pragma unroll
        for (int i = 0; i < 4; ++i) { const f32x4 x = *(const LAS f32x4*)(NUM + t8 * 132 + part * 16 + 4 * i);
#pragma unroll
            for (int k = 0; k < 4; ++k) { hv[4 * i + k] = x[k] * rd; ss += hv[4 * i + k] * hv[4 * i + k]; } }
        ss += __shfl_xor(ss, 1); ss += __shfl_xor(ss, 2); ss += __shfl_xor(ss, 4);
        const float rs = 1.0f / sqrtf(ss * (1.0f / 128.0f) + 1e-6f);
        const bf16* mo = P.z + (row0 + t8) * 3072 + 1024 + h * 128 + part * 16; const float* gmp = P.gm + h * 128 + part * 16; bf16* yo = P.ymix + (row0 + t8) * 1024 + h * 128 + part * 16;
#pragma unroll
        for (int hh = 0; hh < 2; ++hh) { const v4u mv = *(const v4u*)(mo + 8 * hh); const f32x4 g0 = *(const f32x4*)(gmp + 8 * hh), g1 = *(const f32x4*)(gmp + 8 * hh + 4); float y[8];
#pragma unroll
            for (int k = 0; k < 4; ++k) { const float m0 = bf2f(mv[k] & 0xffffu), m1 = __uint_as_float(mv[k] & 0xffff0000u); const float ga = k < 2 ? g0[2 * k] : g1[2 * k - 4], gb = k < 2 ? g0[2 * k + 1] : g1[2 * k - 3];
                y[2 * k] = hv[8 * hh + 2 * k] * rs * ga * sigm_f(m0); y[2 * k + 1] = hv[8 * hh + 2 * k + 1] * rs * gb * sigm_f(m1); }
            v4u o; o.x = pk2(y[0], y[1]); o.y = pk2(y[2], y[3]); o.z = pk2(y[4], y[5]); o.w = pk2(y[6], y[7]);
            *(v4u*)(yo + 8 * hh) = o; }
    }
    __syncthreads();
}

typedef unsigned u32;
#define RLX_AGENT __ATOMIC_RELAXED, __HIP_MEMORY_SCOPE_AGENT
#define XB_TMO      128
#define XB_XCNT(j)  (256  + 64 * (j))
#define XB_XSUB(j)  (1280 + 64 * (j))
#define XB_XGEN(j)  (2304 + 64 * (j))
#define XB_TOP      3328
#define XB_TOPGEN   3392
#define XCD_BAR_WORDS 3456
#define XB_SPIN_CAP (1u << 18)

__device__ __forceinline__ unsigned xb_ld(unsigned* p)              { return __hip_atomic_load(p, __ATOMIC_RELAXED, __HIP_MEMORY_SCOPE_AGENT); }
__device__ __forceinline__ unsigned xb_add(unsigned* p, unsigned v) { return __hip_atomic_fetch_add(p, v, __ATOMIC_RELAXED, __HIP_MEMORY_SCOPE_AGENT); }
__device__ __forceinline__ unsigned xb_xcc_id() { return (unsigned)__builtin_amdgcn_s_getreg((3 << 11) | 20) & 0xFu; }
#define XB_SPIN(cond, bar) do { unsigned _sp = 0; while (cond) { __builtin_amdgcn_s_sleep(1); \
    if ((++_sp & 255u) == 0u) { if (xb_ld(&(bar)[XB_TMO])) break; if (_sp > XB_SPIN_CAP) { atomicAdd(&(bar)[XB_TMO], 1u); break; } } } } while (0)

struct XcdBarrier {
    unsigned* bar; unsigned x;
    volatile LAS unsigned* st;
};

__device__ __forceinline__ XcdBarrier xcd_barrier_post(unsigned* bar, volatile LAS unsigned* st) {
    XcdBarrier b; b.bar = bar; b.x = xb_xcc_id(); b.st = st;
    if (threadIdx.x == 0) (void)xb_add(&bar[XB_XCNT(b.x)], 1u);
    return b;
}
__device__ __forceinline__ void xcd_barrier_complete(unsigned* bar, unsigned x, unsigned& nloc, unsigned& nx) {
    const unsigned G = gridDim.x * gridDim.y * gridDim.z;
    unsigned sum, cnt, mine, sp = 0u;
    for (;;) {
        sum = 0u; cnt = 0u; mine = 0u;
#pragma unroll
        for (unsigned j = 0; j < 16; ++j) { const unsigned c = xb_ld(&bar[XB_XCNT(j)]); sum += c; cnt += (c > 0u) ? 1u : 0u; mine = (j == x) ? c : mine; }
        if (sum == G) break;
        __builtin_amdgcn_s_sleep(1);
        if ((++sp & 255u) == 0u) { if (xb_ld(&bar[XB_TMO])) break; if (sp > XB_SPIN_CAP) { atomicAdd(&bar[XB_TMO], 1u); break; } }
    }
    nloc = mine > 0u ? mine : 1u; nx = cnt > 0u ? cnt : 1u;
}

__device__ __forceinline__ void xcd_barrier(const XcdBarrier& b) {
    asm volatile("s_waitcnt vmcnt(0)" ::: "memory");
    __syncthreads();
    if (threadIdx.x == 0) {
        unsigned* bar = b.bar;
        __builtin_amdgcn_s_waitcnt(0);
        unsigned nloc = b.st[0], nx = b.st[1];
        if (nloc == 0u) { xcd_barrier_complete(bar, b.x, nloc, nx); b.st[0] = nloc; b.st[1] = nx; }
        const unsigned old = xb_add(&bar[XB_XSUB(b.x)], 1u);
        const unsigned gen = old / nloc;
        if (old + 1u == (gen + 1u) * nloc) {
            __builtin_amdgcn_fence(__ATOMIC_RELEASE, "agent");
            asm volatile("s_waitcnt vmcnt(0)" ::: "memory");
            const unsigned og = xb_add(&bar[XB_TOP], 1u);
            const unsigned tg = og / nx;
            if (og + 1u == (tg + 1u) * nx) xb_add(&bar[XB_TOPGEN], 1u);
            else XB_SPIN(xb_ld(&bar[XB_TOPGEN]) == tg, bar);
            __builtin_amdgcn_fence(__ATOMIC_ACQUIRE, "agent");
            xb_add(&bar[XB_XGEN(b.x)], 1u);
            asm volatile("s_waitcnt vmcnt(0)" ::: "memory");
        } else {
            XB_SPIN(xb_ld(&bar[XB_XGEN(b.x)]) == gen, bar);
            __builtin_amdgcn_fence(__ATOMIC_ACQUIRE, "agent");
            asm volatile("s_waitcnt vmcnt(0)" ::: "memory");
        }
    }
    __syncthreads();
}

struct Args { const float* in[23]; float* out; unsigned char* ws; int ph_lo, ph_hi; };
__global__ void __launch_bounds__(NTHR, 2) hymba_fwd(Args args) {
    extern __shared__ __attribute__((aligned(16))) unsigned char lds_raw[];
    LAS unsigned char* lds = (LAS unsigned char*)lds_raw;
    cg::grid_group grid = cg::this_grid();
    const int tid = threadIdx.x, lane = tid & 63, wave = __builtin_amdgcn_readfirstlane(tid >> 6);
    const int G = gridDim.x; const int bx = blockIdx.x; const int vcu = (G % 8 == 0) ? (bx % 8) * (G / 8) + bx / 8 : bx;
#define H (args.out)
#define W1GU ((bf16*)(args.ws + WS_W1GU))
#define W1D ((bf16*)(args.ws + WS_W1D))
#define WIN ((bf16*)(args.ws + WS_WIN))
#define WOUT ((bf16*)(args.ws + WS_WOUT))
#define W2GU ((bf16*)(args.ws + WS_W2GU))
#define W2D ((bf16*)(args.ws + WS_W2D))
#define WPG ((bf16*)(args.ws + WS_WPG))
#define WPP ((bf16*)(args.ws + WS_WPP))
#define GATES ((float*)(args.ws + WS_GATES))
#define CLG ((float*)(args.ws + WS_CL))
#define SS0 ((float*)(args.ws + WS_SS0))
#define SS1 ((float*)(args.ws + WS_SS1))
#define SS2 ((float*)(args.ws + WS_SS2))
#define SS3 ((float*)(args.ws + WS_SS3))
#define SS4 ((float*)(args.ws + WS_SS4))
#define SSP ((float*)(args.ws + WS_SSP))
#define XN ((bf16*)(args.ws + WS_XN))
#define ACT ((bf16*)(args.ws + WS_ACTZ))
#define Z ((bf16*)(args.ws + WS_ACTZ))
#define YMIX ((bf16*)(args.ws + WS_YMIX))
#define PROJ ((bf16*)(args.ws + WS_YMIX))
#define PB ((bf16*)(args.ws + WS_PB))
#define MKPTRS() Ptrs P; { unsigned char* ws_ = args.ws; P.gates = (const float*)(ws_ + WS_GATES); P.barr = (float*)(ws_ + WS_BARR); P.rarr = (float*)(ws_ + WS_RARR); P.nloc = (float*)(ws_ + WS_NLOC); P.nprev = (float*)(ws_ + WS_NPREV); \
    P.garr = (float*)(ws_ + WS_GARR); P.mloc = (float*)(ws_ + WS_MLOC); P.mprev = (float*)(ws_ + WS_MPREV); P.ut = (float*)(ws_ + WS_UT); P.ct = (bf16*)(ws_ + WS_CT); \
    P.qkc = (bf16*)(ws_ + WS_XN); P.z = (bf16*)(ws_ + WS_ACTZ); P.ymix = (bf16*)(ws_ + WS_YMIX); P.conv = args.in[8]; P.gm = args.in[11]; }
    const int lo = args.ph_lo, hi = args.ph_hi;
#ifndef PH_MASK
#define PH_MASK 0xFFF
#endif
#define IN(k) (((PH_MASK >> (k)) & 1) && lo <= (k) && (k) < hi)
#define SEAM(k) do { if (IN(k) && IN((k) + 1)) { if ((k) == 0) grid.sync(); else xcd_barrier(bar); } } while (0)
    const int gw = vcu * NWAVES + wave, NGW = G * NWAVES;
    if (tid < 8) ((LAS unsigned*)(lds + 131072))[tid] = 0u;
    __syncthreads();
    XcdBarrier bar; bar.bar = (unsigned*)args.ws; bar.x = 0; bar.st = nullptr;
    if (hi - lo > 1) bar = xcd_barrier_post((unsigned*)args.ws, (volatile LAS unsigned*)(lds + 131072));

    if (IN(0)) {
        LAS float* scr = (LAS float*)(lds + wave * 16384);
        constexpr int I_GU = 16 * 88, I_D = 44 * 32, I_IN = 16 * 97, I_O = 16 * 32, I_PP = 4 * 32;
        constexpr int NITEMS = 4 * I_GU + 2 * I_D + I_IN + 2 * I_O + I_PP;
        for (int it = gw; it < NITEMS; it += NGW) {
            int r = it, wi, gi = -1, K = DM_, N = DFF, map = 0; size_t wso;
            if (r < I_GU) { wi = 3; gi = 2; wso = WS_W1GU; map = 1; }
            else if ((r -= I_GU) < I_GU) { wi = 4; gi = 2; wso = WS_W1GU; map = 2; }
            else if ((r -= I_GU) < I_D) { wi = 5; wso = WS_W1D; K = DFF; N = DM_; }
            else if ((r -= I_D) < I_IN) { wi = 7; gi = 6; wso = WS_WIN; N = 3088; map = 3; }
            else if ((r -= I_IN) < I_O) { wi = 13; wso = WS_WOUT; N = DM_; }
            else if ((r -= I_O) < I_GU) { wi = 15; gi = 14; wso = WS_W2GU; map = 1; }
            else if ((r -= I_GU) < I_GU) { wi = 16; gi = 14; wso = WS_W2GU; map = 2; }
            else if ((r -= I_GU) < I_D) { wi = 17; wso = WS_W2D; K = DFF; N = DM_; }
            else if ((r -= I_D) < I_O) { wi = 19; gi = 18; wso = WS_WPG; N = DM_; }
            else { r -= I_O; wi = 20; wso = WS_WPP; K = DPLE; N = DM_; }
            p0_transpose_item(args.in[wi], K, N, (bf16*)(args.ws + wso), map, gi >= 0 ? args.in[gi] : nullptr, scr, r, lane);
        }
        { v4u* zp = (v4u*)(WIN + (size_t)3088 * 1024); const int nz = (WIN_ROWS - 3088) * 1024 * 2 / 16;
          for (int i = bx * NTHR + tid; i < nz; i += G * NTHR) zp[i] = (v4u){0u, 0u, 0u, 0u}; }
        for (int m = gw; m < Mrows; m += NGW) {
            const f32x4* xr = (const f32x4*)(args.in[0] + (size_t)m * 1024) + lane; f32x4 v[4]; float s = 0.f;
#pragma unroll
            for (int j = 0; j < 4; ++j) { v[j] = xr[64 * j]; s += (v[j][0] * v[j][0] + v[j][1] * v[j][1]) + (v[j][2] * v[j][2] + v[j][3] * v[j][3]); }
#pragma unroll
            for (int o = 1; o < 64; o <<= 1) s += __shfl_xor(s, o);
            unsigned long long* o8 = (unsigned long long*)(XN + (size_t)m * 1024) + lane;
#pragma unroll
            for (int j = 0; j < 4; ++j) o8[64 * j] = (unsigned long long)pk2(v[j][0], v[j][1]) | ((unsigned long long)pk2(v[j][2], v[j][3]) << 32);
            if (lane < 16) SS0[(size_t)m * 16 + lane] = lane == 0 ? s : 0.f;
        }
        { const f32x4* pp = (const f32x4*)args.in[1]; unsigned long long* po = (unsigned long long*)PB; const int n4 = Mrows * DPLE / 4;
          for (int i = bx * NTHR + tid; i < n4; i += G * NTHR) { const f32x4 v = pp[i]; po[i] = (unsigned long long)pk2(v[0], v[1]) | ((unsigned long long)pk2(v[2], v[3]) << 32); } }
    }
    SEAM(0);
    if (IN(1)) { pg8::Gemm g{XN, W1GU, Mrows, 2 * DFF, DM_}; pg8::StaticOrder S; S.init(Mrows, 2 * DFF, G, bx);
        pg8::EpiSwiGLU E{ACT, SS0, DFF}; pg8::gemm_phase<pg8::EpiSwiGLU, pg8::StaticOrder, true, true>(lds, g, S, E); }
    SEAM(1);
    if (IN(2)) { pg8::Gemm g{ACT, W1D, Mrows, DM_, DFF}; pg8::StaticOrder S; S.init(Mrows, DM_, G, bx);
        pg8::EpiResid E{args.in[0], H, XN, SS1, 0.5f}; pg8::gemm_phase<pg8::EpiResid, pg8::StaticOrder, true, true>(lds, g, S, E); }
    SEAM(2);
    if (IN(3)) { pg8::Gemm g{XN, WIN, Mrows, WIN_ROWS, DM_}; pg8::StaticOrder S; S.init(Mrows, WIN_ROWS, G, bx);
        pg8::EpiZ E{Z, GATES, SS1, args.in[9], args.in[10], 0.125f * 1.4426950408889634f}; pg8::gemm_phase<pg8::EpiZ, pg8::StaticOrder, true, true>(lds, g, S, E); }
    SEAM(3);
    if (IN(4)) {
        if (wave == 7 && vcu < 64) {
            const int b = vcu >> 3, h = vcu & 7; const float* gp = GATES + ((size_t)b * SEQL + lane * 64) * 16 + 8 + h; float s = 0.f;
#pragma unroll 8
            for (int j = 0; j < 64; ++j) s += logsig_f(gp[j * 16]);
            float inc = s;
#pragma unroll
            for (int o = 1; o < 64; o <<= 1) { const float t = __shfl_up(inc, o); if (lane >= o) inc += t; }
            float run = inc - s; float* co = CLG + (size_t)vcu * SEQL + lane * 64;
#pragma unroll 8
            for (int j = 0; j < 64; ++j) { run += logsig_f(gp[j * 16]); co[j] = run * 1.4426950408889634f; }
        }
        MKPTRS();
        for (int it = vcu; it < 2048; it += G) mlstm_local_item(it, lds, P);
    }
    SEAM(4);
    if (IN(5)) {
        MKPTRS();
        const float* __restrict__ ut = P.ut; bf16* __restrict__ ct = P.ct;
        for (int eid = bx * NTHR + tid; eid < 32 * 8192; eid += G * NTHR) {
            const int bh = eid >> 13, idx = eid & 8191; float C = 0.f, m = 0.f;
            for (int c0 = 0; c0 < 64; c0 += 8) { float u[8];
#pragma unroll
                for (int j = 0; j < 8; ++j) u[j] = ut[((size_t)(bh * 64 + c0 + j) << 13) + idx];
#pragma unroll
                for (int j = 0; j < 8; ++j) { const int ci = bh * 64 + c0 + j; const float g = P.garr[ci], ml = P.mloc[ci]; const float mn = fmaxf(g + m, ml);
                    ct[((size_t)ci << 13) + idx] = (bf16)f2bf(C); if (idx == 0) P.mprev[ci] = m;
                    C = __expf(g + m - mn) * C + __expf(ml - mn) * u[j]; m = mn; } }
        }
        for (int eid = bx * NTHR + tid; eid < 32 * 64; eid += G * NTHR) {
            const int bh = eid >> 6, d = eid & 63; float n = 0.f, m = 0.f;
            for (int c = 0; c < 64; ++c) { const int ci = bh * 64 + c; const float g = P.garr[ci], ml = P.mloc[ci]; const float mn = fmaxf(g + m, ml);
                P.nprev[ci * 64 + d] = n; n = __expf(g + m - mn) * n + __expf(ml - mn) * P.nloc[ci * 64 + d]; m = mn; }
        }
    }
    SEAM(5);
    if (IN(6)) {
        { MKPTRS();
        for (int it = vcu; it < 2048; it += G) mlstm_out_item(it, lds, P); }
        __syncthreads();
        LAS float* cl = (LAS float*)(lds + 86016); int cur_bh = -1;
        const int nu = (1024 + G - 1) / G;
        for (int i = 0; i < nu; ++i) {
            int bh, qb;
            if (G == 256) { const int s = vcu & 3; bh = vcu >> 2; qb = (i == 0) ? s : (i == 1) ? 7 - s : (i == 2) ? 8 + s : 15 - s; }
            else { const int idx = i * G + vcu; if (idx >= 1024) break; bh = idx >> 4; qb = idx & 15; }
            if (bh != cur_bh) { __syncthreads();
                for (int k = tid; k < SEQL / 4; k += NTHR) *(LAS f32x4*)(cl + 4 * k) = *(const f32x4*)(CLG + (size_t)bh * SEQL + 4 * k);
                cur_bh = bh; __syncthreads(); }
            attn_body::attn_unit<8>(bh >> 3, bh & 7, qb, (const attn_body::bf16*)(Z + 1536), (const attn_body::bf16*)(Z + 2048), (const attn_body::bf16*)(Z + 2560), (attn_body::bf16*)(YMIX + 512), (char*)lds_raw, (attn_body::lds_fptr)cl, args.in[12]);
        }
    }
    SEAM(6);
    if (IN(7)) { pg8::Gemm g{YMIX, WOUT, Mrows, DM_, DM_}; pg8::StaticOrder S; S.init(Mrows, DM_, G, bx);
        pg8::EpiResid E{H, H, XN, SS2, 1.0f}; pg8::gemm_phase<pg8::EpiResid, pg8::StaticOrder, true, true>(lds, g, S, E); }
    SEAM(7);
    if (IN(8)) { pg8::Gemm g{XN, W2GU, Mrows, 2 * DFF, DM_}; pg8::StaticOrder S; S.init(Mrows, 2 * DFF, G, bx);
        pg8::EpiSwiGLU E{ACT, SS2, DFF}; pg8::gemm_phase<pg8::EpiSwiGLU, pg8::StaticOrder, true, true>(lds, g, S, E); }
    SEAM(8);
    if (IN(9)) {
        { pg8::Gemm g{ACT, W2D, Mrows, DM_, DFF}; pg8::StaticOrder S; S.init(Mrows, DM_, G, bx);
          pg8::EpiResid E{H, H, XN, SS3, 0.5f}; pg8::gemm_phase<pg8::EpiResid, pg8::StaticOrder, true, true>(lds, g, S, E); }
        { pg8::Gemm g{PB, WPP, Mrows, DM_, DPLE}; pg8::StaticOrder S; S.init(Mrows, DM_, G, bx);
          pg8::EpiProj E{PROJ, SSP}; pg8::gemm_phase<pg8::EpiProj, pg8::StaticOrder, true, true>(lds, g, S, E); }
    }
    SEAM(9);
    if (IN(10)) { pg8::Gemm g{XN, WPG, Mrows, DM_, DM_}; pg8::StaticOrder S; S.init(Mrows, DM_, G, bx);
        pg8::EpiPle E{H, PROJ, SS3, SSP, args.in[21], SS4}; pg8::gemm_phase<pg8::EpiPle, pg8::StaticOrder, true, true>(lds, g, S, E); }
    SEAM(10);
    if (IN(11)) {
        const f32x4* gf = (const f32x4*)args.in[22];
        for (int m = gw; m < Mrows; m += NGW) { const float rs = pg8::row_rstd(SS4, m); f32x4* hp = (f32x4*)(H + (size_t)m * 1024) + lane;
#pragma unroll
            for (int j = 0; j < 4; ++j) { const f32x4 v = hp[64 * j]; hp[64 * j] = v * rs * gf[64 * j + lane]; } }
    }
#undef IN
#undef SEAM
}

extern "C" void kernel_launch(void* const* d_in, const int* in_sizes, int n_in, void* d_out, int out_size, void* d_ws, size_t ws_size, hipStream_t stream) {
    static int grid = 0;
    if (grid == 0) {
        if (n_in != 23 || out_size != Mrows * DM_ || ws_size < WS_END) { fprintf(stderr, "kernel_launch: unexpected shapes (n_in %d out %d ws %zu)\n", n_in, out_size, ws_size); grid = -1; return; }
        int dev = 0, cus = 0, per_cu = 0;
        hipGetDevice(&dev); hipDeviceGetAttribute(&cus, hipDeviceAttributeMultiprocessorCount, dev);
        if (hipFuncSetAttribute((const void*)hymba_fwd, hipFuncAttributeMaxDynamicSharedMemorySize, LDS_BYTES) != hipSuccess) { fprintf(stderr, "kernel_launch: hipFuncSetAttribute failed\n"); grid = -1; return; }
        if (hipOccupancyMaxActiveBlocksPerMultiprocessor(&per_cu, (const void*)hymba_fwd, NTHR, LDS_BYTES) != hipSuccess || per_cu < 1) { fprintf(stderr, "kernel_launch: occupancy query says %d\n", per_cu); per_cu = 1; }
        (void)hipGetLastError();
        grid = cus * (per_cu > 1 ? 1 : per_cu);
    }
    if (grid < 0) return;
    if (hipMemsetAsync(d_ws, 0, 65536, stream) != hipSuccess) { fprintf(stderr, "kernel_launch: memset failed\n"); return; }
    Args a{};
    for (int i = 0; i < 23; ++i) a.in[i] = (const float*)d_in[i];
    a.out = (float*)d_out; a.ws = (unsigned char*)d_ws;
#if MK_MULTI
    for (int ph = 0; ph < NPH; ++ph) { a.ph_lo = ph; a.ph_hi = ph + 1; hipLaunchKernelGGL(hymba_fwd, dim3(grid), dim3(NTHR), LDS_BYTES, stream, a); }
#else
    a.ph_lo = 0; a.ph_hi = NPH; void* kargs[] = {&a};
    hipError_t e = hipLaunchCooperativeKernel((void*)hymba_fwd, dim3(grid), dim3(NTHR), kargs, LDS_BYTES, stream);
    if (e != hipSuccess) fprintf(stderr, "cooperative launch failed: %s (grid %d)\n", hipGetErrorString(e), grid);
#endif
}
```

```cpp
#include <hip/hip_runtime.h>
#include <hip/hip_cooperative_groups.h>
#include <hip/hip_bf16.h>
#include <cstdio>
#include <cstdint>
#include <cmath>
namespace cg = cooperative_groups;
namespace pg8 {
#define PG8_LAS __attribute__((address_space(3)))
typedef unsigned short bf16_t;
typedef short bf16x8 __attribute__((ext_vector_type(8)));
typedef float f32x4 __attribute__((ext_vector_type(4)));
typedef unsigned u32x4 __attribute__((ext_vector_type(4)));
constexpr int BM = 256, BK = 64, HALF = 128, HTB = HALF * BK * 2  , STAGE_BYTES = 8 * HTB, NXCD = 8, WGM = 8;

__host__ __device__ __forceinline__ int lds_byte(int r, int c) { const int st = (r >> 4) * 2 + (c >> 5), rr = r & 15, cc = c & 31, ob = rr * 64 + cc * 2; return st * 1024 + (ob ^ (((ob >> 9) & 1) << 5)); }
__host__ __device__ __forceinline__ void stage_rc(int b, int& R, int& C) { const int st = b / 1024, sb = b % 1024, swz = sb ^ (((sb >> 9) & 1) << 5); R = (st >> 1) * 16 + swz / 64; C = (st & 1) * 32 + (swz % 64) / 2; }
__host__ __device__ __forceinline__ int perm32(int rho) { const int n = rho >> 4, i = rho & 15; return 8 * (i >> 2) + 4 * n + (i & 3); }

struct Unit { int pm, pn; };
struct Gemm { const bf16_t* A; const bf16_t* Bt; int M, N, K; };

struct StaticOrder {
    int nM, nN, nwg, G, c;
    __host__ __device__ void init(int M, int N, int G_, int c_) { nM = M / BM; nN = N / BM; nwg = nM * nN; G = G_; c = c_; }
    __host__ __device__ bool next(int i, Unit& u) const {
        const long L = (long)i * G + c; if (L >= nwg) return false;
        int wgid = (int)L; { const int q = nwg / NXCD, r = nwg % NXCD, xcd = wgid % NXCD, off = wgid / NXCD; wgid = (xcd < r ? xcd * (q + 1) : r * (q + 1) + (xcd - r) * q) + off; }
        const int nig = WGM * nN, gid = wgid / nig, fm = gid * WGM, gsz = (nM - fm) < WGM ? (nM - fm) : WGM;
        u.pm = fm + ((wgid % nig) % gsz); u.pn = (wgid % nig) / gsz; return true;
    }
    __device__ __forceinline__ void a_ready(const Unit&) const {}
    __device__ __forceinline__ void done(const Unit&) const {}
};

__device__ __forceinline__ unsigned cvt_pk_bf16(float lo, float hi) { unsigned r; asm volatile("v_cvt_pk_bf16_f32 %0, %1, %2" : "=v"(r) : "v"(lo), "v"(hi)); return r; }
typedef float f32x2 __attribute__((ext_vector_type(2)));
typedef unsigned u32x2 __attribute__((ext_vector_type(2)));
constexpr float RMS_EPS = 1e-6f;
__device__ __forceinline__ float row_rstd(const float* __restrict__ ss, int row) {
    const f32x4* p = (const f32x4*)(ss + (size_t)row * 16);
    const f32x4 a = p[0], b = p[1], c = p[2], d = p[3];
    const float s = (((a[0] + a[1]) + (a[2] + a[3])) + ((b[0] + b[1]) + (b[2] + b[3]))) + (((c[0] + c[1]) + (c[2] + c[3])) + ((d[0] + d[1]) + (d[2] + d[3])));
    return 1.0f / sqrtf(s * (1.0f / 1024.0f) + RMS_EPS);
}
__device__ __forceinline__ float sigmoid_f(float x) { return __builtin_amdgcn_rcpf(1.0f + __builtin_amdgcn_exp2f(-1.4426950408889634f * x)); }
__device__ __forceinline__ float silu_f(float x) { return x * sigmoid_f(x); }

struct EpiSwiGLU {
    static constexpr bool PERM = true, AFTER_DRAIN = false;
    bf16_t* O; const float* ss; int ldo;
    __device__ __forceinline__ void operator()(const f32x4 (&acc)[2][2][4][2], const Unit& u, int wr, int wc, int fr, int fq) const {
        const int row0 = u.pm * BM + wr * 64 + fr, col0 = u.pn * 128 + wc * 32 + 8 * fq;
#pragma unroll
        for (int ai = 0; ai < 2; ++ai)
#pragma unroll
            for (int m = 0; m < 4; ++m) { const int row = row0 + ai * HALF + m * 16; const float rs = row_rstd(ss, row);
                const f32x4 g0 = acc[ai][0][m][0] * rs, g1 = acc[ai][0][m][1] * rs, u0 = acc[ai][1][m][0] * rs, u1 = acc[ai][1][m][1] * rs;
                u32x4 w; w.x = cvt_pk_bf16(silu_f(g0[0]) * u0[0], silu_f(g0[1]) * u0[1]); w.y = cvt_pk_bf16(silu_f(g0[2]) * u0[2], silu_f(g0[3]) * u0[3]);
                w.z = cvt_pk_bf16(silu_f(g1[0]) * u1[0], silu_f(g1[1]) * u1[1]); w.w = cvt_pk_bf16(silu_f(g1[2]) * u1[2], silu_f(g1[3]) * u1[3]);
                *(u32x4*)(O + (size_t)row * ldo + col0) = w; }
    }
};
struct EpiResid {
    static constexpr bool PERM = false, AFTER_DRAIN = false;
    const float* base; float* out; bf16_t* xn; float* sso; float coef;
    __device__ __forceinline__ void operator()(const f32x4 (&acc)[2][2][4][2], const Unit& u, int wr, int wc, int fr, int fq) const {
        const int col0 = u.pn * BM + wc * 32 + 4 * fq;
#pragma unroll
        for (int ai = 0; ai < 2; ++ai)
#pragma unroll
            for (int m = 0; m < 4; ++m) { const int row = u.pm * BM + ai * HALF + wr * 64 + m * 16 + fr; const size_t off = (size_t)row * 1024 + col0; float q = 0.f;
#pragma unroll
                for (int bj = 0; bj < 2; ++bj)
#pragma unroll
                    for (int n = 0; n < 2; ++n) { const f32x4 bs = *(const f32x4*)(base + off + bj * HALF + n * 16); const f32x4 o = bs + acc[ai][bj][m][n] * coef;
                        *(f32x4*)(out + off + bj * HALF + n * 16) = o; q += (o[0] * o[0] + o[1] * o[1]) + (o[2] * o[2] + o[3] * o[3]);
                        u32x2 w; w.x = cvt_pk_bf16(o[0], o[1]); w.y = cvt_pk_bf16(o[2], o[3]); *(u32x2*)(xn + off + bj * HALF + n * 16) = w; }
                q += __shfl_xor(q, 16); q += __shfl_xor(q, 32);
                if (fq == 0) sso[(size_t)row * 16 + u.pn * 4 + wc] = q; }
    }
};
struct EpiZ {
    static constexpr bool PERM = true, AFTER_DRAIN = false;
    bf16_t* Z; float* gates; const float* ss; const float* bm; const float* bf; float qscale;
    __device__ __forceinline__ void operator()(const f32x4 (&acc)[2][2][4][2], const Unit& u, int wr, int wc, int fr, int fq) const {
        const int row0 = u.pm * BM + wr * 64 + fr;
        if (u.pn < 12) {
            const float sc = (u.pn == 6 || u.pn == 7) ? qscale : 1.0f; const int col0 = u.pn * BM + wc * 32 + 8 * fq;
#pragma unroll
            for (int ai = 0; ai < 2; ++ai)
#pragma unroll
                for (int m = 0; m < 4; ++m) { const int row = row0 + ai * HALF + m * 16; const float rs = row_rstd(ss, row) * sc;
#pragma unroll
                    for (int bj = 0; bj < 2; ++bj) { const f32x4 v0 = acc[ai][bj][m][0] * rs, v1 = acc[ai][bj][m][1] * rs;
                        u32x4 w; w.x = cvt_pk_bf16(v0[0], v0[1]); w.y = cvt_pk_bf16(v0[2], v0[3]); w.z = cvt_pk_bf16(v1[0], v1[1]); w.w = cvt_pk_bf16(v1[2], v1[3]);
                        *(u32x4*)(Z + (size_t)row * 3072 + col0 + bj * HALF) = w; } }
        } else if (wc == 0 && fq < 2) {
            const float* bp = fq == 0 ? bm : bf; const f32x4 b0 = *(const f32x4*)bp, b1 = *(const f32x4*)(bp + 4);
#pragma unroll
            for (int ai = 0; ai < 2; ++ai)
#pragma unroll
                for (int m = 0; m < 4; ++m) { const int row = row0 + ai * HALF + m * 16; const float rs = row_rstd(ss, row);
                    *(f32x4*)(gates + (size_t)row * 16 + 8 * fq) = acc[ai][0][m][0] * rs + b0; *(f32x4*)(gates + (size_t)row * 16 + 8 * fq + 4) = acc[ai][0][m][1] * rs + b1; }
        }
    }
};
struct EpiProj {
    static constexpr bool PERM = true, AFTER_DRAIN = false;
    bf16_t* O; float* sso;
    __device__ __forceinline__ void operator()(const f32x4 (&acc)[2][2][4][2], const Unit& u, int wr, int wc, int fr, int fq) const {
        const int row0 = u.pm * BM + wr * 64 + fr, col0 = u.pn * BM + wc * 32 + 8 * fq;
#pragma unroll
        for (int ai = 0; ai < 2; ++ai)
#pragma unroll
            for (int m = 0; m < 4; ++m) { const int row = row0 + ai * HALF + m * 16; float q = 0.f;
#pragma unroll
                for (int bj = 0; bj < 2; ++bj) { const f32x4 v0 = acc[ai][bj][m][0], v1 = acc[ai][bj][m][1];
                    q += ((v0[0] * v0[0] + v0[1] * v0[1]) + (v0[2] * v0[2] + v0[3] * v0[3])) + ((v1[0] * v1[0] + v1[1] * v1[1]) + (v1[2] * v1[2] + v1[3] * v1[3]));
                    u32x4 w; w.x = cvt_pk_bf16(v0[0], v0[1]); w.y = cvt_pk_bf16(v0[2], v0[3]); w.z = cvt_pk_bf16(v1[0], v1[1]); w.w = cvt_pk_bf16(v1[2], v1[3]);
                    *(u32x4*)(O + (size_t)row * 1024 + col0 + bj * HALF) = w; }
                q += __shfl_xor(q, 16); q += __shfl_xor(q, 32);
                if (fq == 0) sso[(size_t)row * 16 + u.pn * 4 + wc] = q; }
    }
};
struct EpiPle {
    static constexpr bool PERM = false, AFTER_DRAIN = false;
    float* H; const bf16_t* proj; const float* ss3; const float* ssp; const float* gp; float* sso;
    __device__ __forceinline__ void operator()(const f32x4 (&acc)[2][2][4][2], const Unit& u, int wr, int wc, int fr, int fq) const {
        const int col0 = u.pn * BM + wc * 32 + 4 * fq;
#pragma unroll
        for (int ai = 0; ai < 2; ++ai)
#pragma unroll
            for (int m = 0; m < 4; ++m) { const int row = u.pm * BM + ai * HALF + wr * 64 + m * 16 + fr; const size_t off = (size_t)row * 1024 + col0; float q = 0.f;
                const float rs3 = row_rstd(ss3, row), rsp = row_rstd(ssp, row);
#pragma unroll
                for (int bj = 0; bj < 2; ++bj)
#pragma unroll
                    for (int n = 0; n < 2; ++n) { const int co = bj * HALF + n * 16; const f32x4 hb = *(const f32x4*)(H + off + co); const u32x2 pw = *(const u32x2*)(proj + off + co);
                        const f32x4 g = *(const f32x4*)(gp + col0 + co); const f32x4 a = acc[ai][bj][m][n] * rs3;
                        f32x4 pr; pr[0] = __uint_as_float(pw.x << 16); pr[1] = __uint_as_float(pw.x & 0xffff0000u); pr[2] = __uint_as_float(pw.y << 16); pr[3] = __uint_as_float(pw.y & 0xffff0000u);
                        f32x4 o;
#pragma unroll
                        for (int i = 0; i < 4; ++i) o[i] = hb[i] + sigmoid_f(a[i]) * (pr[i] * rsp * g[i]);
                        *(f32x4*)(H + off + co) = o; q += (o[0] * o[0] + o[1] * o[1]) + (o[2] * o[2] + o[3] * o[3]); }
                q += __shfl_xor(q, 16); q += __shfl_xor(q, 32);
                if (fq == 0) sso[(size_t)row * 16 + u.pn * 4 + wc] = q; }
    }
};

template <class Epi, class Sched, bool ALIGN_EPI = false, bool SP2 = false>
__device__ __forceinline__ void gemm_phase(PG8_LAS unsigned char* lds, const Gemm g, const Sched& S, const Epi& E) {
    const int tid = threadIdx.x, wid = __builtin_amdgcn_readfirstlane(tid >> 6), lane = tid & 63, wr = wid >> 2, wc = wid & 3, fr = lane & 15, fq = lane >> 4;
    const int K = g.K, nt = K / BK;
    unsigned voffA[2], voffB[2];
#pragma unroll
    for (int i = 0; i < 2; ++i) { int R, C; stage_rc(tid * 16 + i * 8192, R, C); const int Rb = Epi::PERM ? ((R & ~31) + perm32(R & 31)) : R;
        voffA[i] = (unsigned)(R * K + C) * 2u; voffB[i] = (unsigned)(Rb * K + C) * 2u; }
    const size_t kstep = (size_t)(BK * 2);
    const size_t hstep = (size_t)HALF * K * 2;
    const size_t tstep = 2 * hstep;
    const unsigned ldsw = (unsigned)wid * 1024u;
    const int aoff = lds_byte(wr * 64 + fr, fq * 8), boff = lds_byte(wc * 32 + fr, fq * 8);
#define PG8_SA(b, h) (((b) * 2 + (h)) * HTB)
#define PG8_SB(b, h) ((4 + (b) * 2 + (h)) * HTB)
#define PG8_STAGE(bufoff, gbase, voff) do { _Pragma("unroll") for (int _i = 0; _i < 2; ++_i) \
        __builtin_amdgcn_global_load_lds((const unsigned*)((const char*)(gbase) + (voff)[_i]), (PG8_LAS unsigned*)(lds + (bufoff) + ldsw + _i * 8192), 16, 0, 0); } while (0)
#define PG8_LDA(dst, b, h) do { _Pragma("unroll") for (int m = 0; m < 4; ++m) _Pragma("unroll") for (int k = 0; k < 2; ++k) dst[m][k] = *(const PG8_LAS bf16x8*)(lds + PG8_SA(b, h) + aoff + m * 2048 + k * 1024); } while (0)
#define PG8_LDB(dst, b, h) do { _Pragma("unroll") for (int n = 0; n < 2; ++n) _Pragma("unroll") for (int k = 0; k < 2; ++k) dst[n][k] = *(const PG8_LAS bf16x8*)(lds + PG8_SB(b, h) + boff + n * 2048 + k * 1024); } while (0)
#define PG8_MMA(ai, bj, At, Bt) do { __builtin_amdgcn_s_setprio(1); _Pragma("unroll") for (int m = 0; m < 4; ++m) _Pragma("unroll") for (int n = 0; n < 2; ++n) _Pragma("unroll") for (int k = 0; k < 2; ++k) \
        acc[ai][bj][m][n] = __builtin_amdgcn_mfma_f32_16x16x32_bf16(Bt[n][k], At[m][k], acc[ai][bj][m][n], 0, 0, 0); __builtin_amdgcn_s_setprio(0); } while (0)
#define PG8_WAIT_V(n) asm volatile("s_waitcnt vmcnt(" #n ")" ::: "memory")
#define PG8_WAIT_L(n) asm volatile("s_waitcnt lgkmcnt(" #n ")" ::: "memory")
#define PG8_BAR __builtin_amdgcn_s_barrier()
#define PG8_SCHED __builtin_amdgcn_sched_barrier(0)
    Unit cur, nxt; int ui = 0;
    if (!S.next(0, cur)) return;
    f32x4 acc[2][2][4][2];
#pragma unroll
    for (int a = 0; a < 2; ++a)
#pragma unroll
        for (int b = 0; b < 2; ++b)
#pragma unroll
            for (int m = 0; m < 4; ++m)
#pragma unroll
                for (int n = 0; n < 2; ++n) acc[a][b][m][n] = (f32x4){0.f, 0.f, 0.f, 0.f};
    bf16x8 At[4][2], B0[2][2], B1[2][2];
    const char* cA = (const char*)g.A + (size_t)cur.pm * tstep; const char* cB = (const char*)g.Bt + (size_t)cur.pn * tstep;
    S.a_ready(cur);
    if constexpr (SP2) {
        PG8_STAGE(PG8_SB(0, 0), cB, voffB); PG8_STAGE(PG8_SB(0, 1), cB + hstep, voffB); PG8_STAGE(PG8_SA(0, 0), cA, voffA); PG8_STAGE(PG8_SA(0, 1), cA + hstep, voffA);
        if (wr == 1) PG8_BAR;
        PG8_WAIT_V(2); PG8_BAR;
        PG8_STAGE(PG8_SB(1, 0), cB + kstep, voffB); PG8_STAGE(PG8_SA(1, 0), cA + kstep, voffA); PG8_STAGE(PG8_SB(1, 1), cB + hstep + kstep, voffB);
        PG8_WAIT_V(6); PG8_BAR;
    } else {
        PG8_STAGE(PG8_SB(0, 0), cB, voffB); PG8_STAGE(PG8_SA(0, 0), cA, voffA); PG8_STAGE(PG8_SB(0, 1), cB + hstep, voffB); PG8_STAGE(PG8_SA(0, 1), cA + hstep, voffA);
        if (wr == 1) PG8_BAR;
        PG8_WAIT_V(4); PG8_BAR;
        PG8_STAGE(PG8_SB(1, 0), cB + kstep, voffB); PG8_STAGE(PG8_SA(1, 0), cA + kstep, voffA); PG8_STAGE(PG8_SB(1, 1), cB + hstep + kstep, voffB);
        PG8_WAIT_V(6); PG8_BAR;
    }
    for (;;) {
        const bool has_next = S.next(ui + 1, nxt);
        const char* nA = has_next ? (const char*)g.A + (size_t)nxt.pm * tstep : cA; const char* nB = has_next ? (const char*)g.Bt + (size_t)nxt.pn * tstep : cB;
        for (int t = 0; t < nt; t += 2) {
            const bool last = (t == nt - 2);
            const char* a1 = cA + (size_t)(t + 1) * kstep;
            const char* a2 = last ? nA : cA + (size_t)(t + 2) * kstep; const char* b2 = last ? nB : cB + (size_t)(t + 2) * kstep;
            const char* a3 = a2 + kstep; const char* b3 = b2 + kstep;
            if (last && has_next) S.a_ready(nxt);
            if constexpr (SP2) {
            PG8_LDB(B0, 0, 0); PG8_LDB(B1, 0, 1); PG8_SCHED; PG8_LDA(At, 0, 0); PG8_STAGE(PG8_SA(1, 1), a1 + hstep, voffA);
            PG8_WAIT_V(8); PG8_WAIT_L(0); PG8_BAR; PG8_MMA(0, 0, At, B0); PG8_MMA(0, 1, At, B1); PG8_BAR; PG8_SCHED;
            PG8_LDA(At, 0, 1); PG8_STAGE(PG8_SB(0, 0), b2, voffB); PG8_STAGE(PG8_SB(0, 1), b2 + hstep, voffB); PG8_STAGE(PG8_SA(0, 0), a2, voffA);
            PG8_WAIT_V(8); PG8_WAIT_L(0); PG8_BAR; PG8_MMA(1, 0, At, B0); PG8_MMA(1, 1, At, B1); PG8_BAR; PG8_SCHED;
            PG8_LDB(B0, 1, 0); PG8_LDB(B1, 1, 1); PG8_SCHED; PG8_LDA(At, 1, 0); PG8_STAGE(PG8_SA(0, 1), a2 + hstep, voffA);
            PG8_WAIT_V(8); PG8_WAIT_L(0); PG8_BAR; PG8_MMA(0, 0, At, B0); PG8_MMA(0, 1, At, B1); PG8_BAR; PG8_SCHED;
            PG8_LDA(At, 1, 1); PG8_STAGE(PG8_SB(1, 0), b3, voffB); PG8_STAGE(PG8_SB(1, 1), b3 + hstep, voffB); PG8_STAGE(PG8_SA(1, 0), a3, voffA);
            PG8_WAIT_V(8); PG8_WAIT_L(0); PG8_BAR; PG8_MMA(1, 0, At, B0); PG8_MMA(1, 1, At, B1); PG8_BAR; PG8_SCHED;
            } else {
            PG8_LDB(B0, 0, 0); PG8_SCHED; PG8_LDA(At, 0, 0); PG8_STAGE(PG8_SA(1, 1), a1 + hstep, voffA);
            PG8_WAIT_L(8); PG8_BAR; PG8_WAIT_L(0); PG8_MMA(0, 0, At, B0); PG8_BAR; PG8_SCHED;
            PG8_LDB(B1, 0, 1); PG8_STAGE(PG8_SB(0, 0), b2, voffB);
            PG8_BAR; PG8_WAIT_L(0); PG8_MMA(0, 1, At, B1); PG8_BAR;
            PG8_LDA(At, 0, 1); PG8_STAGE(PG8_SA(0, 0), a2, voffA);
            PG8_BAR; PG8_WAIT_L(0); PG8_MMA(1, 0, At, B0); PG8_BAR; PG8_SCHED;
            PG8_STAGE(PG8_SB(0, 1), b2 + hstep, voffB);
            PG8_WAIT_V(6); PG8_BAR; PG8_MMA(1, 1, At, B1); PG8_BAR;
            PG8_LDB(B0, 1, 0); PG8_SCHED; PG8_LDA(At, 1, 0); PG8_STAGE(PG8_SA(0, 1), a2 + hstep, voffA);
            PG8_WAIT_L(8); PG8_BAR; PG8_WAIT_L(0); PG8_MMA(0, 0, At, B0); PG8_BAR; PG8_SCHED;
            PG8_LDB(B1, 1, 1); PG8_STAGE(PG8_SB(1, 0), b3, voffB);
            PG8_BAR; PG8_WAIT_L(0); PG8_MMA(0, 1, At, B1); PG8_BAR;
            PG8_LDA(At, 1, 1); PG8_STAGE(PG8_SA(1, 0), a3, voffA);
            PG8_BAR; PG8_WAIT_L(0); PG8_MMA(1, 0, At, B0); PG8_BAR; PG8_SCHED;
            PG8_STAGE(PG8_SB(1, 1), b3 + hstep, voffB);
            PG8_WAIT_V(6); PG8_BAR; PG8_MMA(1, 1, At, B1); PG8_BAR;
            }
        }
        if constexpr (ALIGN_EPI) { if (wr == 0) PG8_BAR; }
        if constexpr (!Epi::AFTER_DRAIN) { E(acc, cur, wr, wc, fr, fq); S.done(cur); }
        if (!has_next) break;
#pragma unroll
        for (int a = 0; a < 2; ++a)
#pragma unroll
            for (int b = 0; b < 2; ++b)
#pragma unroll
                for (int m = 0; m < 4; ++m)
#pragma unroll
                    for (int n = 0; n < 2; ++n) acc[a][b][m][n] = (f32x4){0.f, 0.f, 0.f, 0.f};
        cur = nxt; cA = nA; cB = nB; ++ui;
        if constexpr (ALIGN_EPI) { if (wr == 1) PG8_BAR; }
    }
    PG8_WAIT_V(0);
    if constexpr (!ALIGN_EPI) { if (wr == 0) PG8_BAR; }
    PG8_BAR;
    if constexpr (Epi::AFTER_DRAIN) { E.fused(acc, cur, wr, wc, fr, fq, lds, wid, lane); S.done(cur); }
#undef PG8_SA
#undef PG8_SB
#undef PG8_STAGE
#undef PG8_LDA
#undef PG8_LDB
#undef PG8_MMA
#undef PG8_WAIT_V
#undef PG8_WAIT_L
#undef PG8_BAR
#undef PG8_SCHED
}
}

#ifndef PG8_SP2
#define PG8_SP2 true
#endif
#include <hip/hip_bf16.h>
#include <cmath>
namespace attn_body {
using bf16=__hip_bfloat16;
using bf16x8=__attribute__((ext_vector_type(8)))short;
using s16x4=__attribute__((ext_vector_type(4)))short;
using f32x16=__attribute__((ext_vector_type(16)))float;
using u32x4=__attribute__((ext_vector_type(4)))unsigned;
constexpr int BATCH=8,NHEAD=8,SEQ=4096,D=64,DM=3072,OPITCH=1024;
constexpr int NW=8,QBLK=32,QB=QBLK*NW,KVBLK=64,NQB=SEQ/QB;
constexpr int ATTN_PITCH=DM, ATTN_UNIT_ROWS=QB;
__device__ __forceinline__ int crow(int r,int hi){return (r&3)+8*(r>>2)+4*hi;}
#define SBAR() __builtin_amdgcn_sched_barrier(0)
__device__ __forceinline__ void cmask(f32x16&p0,f32x16&p1,int jb,int qrel,int hi){
  const float NEG=-INFINITY; int kb=64*jb+4*hi;
  #pragma unroll
  for(int r=0;r<16;++r){int kv=kb+(r&3)+8*(r>>2); if(kv>qrel)p0[r]=NEG; if(kv+32>qrel)p1[r]=NEG;}
}

constexpr int NSLOT=3, SLOTB=8192;
constexpr int LDS_K=0, LDS_V=NSLOT*SLOTB, LDS_WS=2*NSLOT*SLOTB, LDS_OST=LDS_WS+NW*64*4, LDS_BYTES=LDS_OST+NW*4096;
constexpr float C2=0.125f*1.4426950408889634f;
__device__ __forceinline__ void glds16(const void*gsrc,unsigned lds_dst){unsigned keep;
  asm volatile("s_mov_b32 %0, m0\n\ts_mov_b32 m0, %2\n\ts_nop 0\n\tglobal_load_lds_dwordx4 %1, off\n\ts_mov_b32 m0, %0":"=&s"(keep):"v"(gsrc),"s"(lds_dst):"memory");}
__device__ __forceinline__ float max3f(float a,float b,float c){float r;asm("v_max3_f32 %0, %1, %2, %3":"=v"(r):"v"(a),"v"(b),"v"(c));return r;}
__device__ __forceinline__ float max2f(float a,float b){float r;asm("v_max_f32_e32 %0, %1, %2":"=v"(r):"v"(a),"v"(b));return r;}
__device__ __forceinline__ float fadd_s(float a,float b){float r;asm("v_add_f32_e32 %0, %1, %2":"=v"(r):"v"(a),"v"(b));return r;}
__device__ __forceinline__ float fsub_s(float a,float b){float r;asm("v_sub_f32_e32 %0, %1, %2":"=v"(r):"v"(a),"v"(b));return r;}
typedef float f32x2_t __attribute__((ext_vector_type(2))); typedef float f32x4_t __attribute__((ext_vector_type(4))); typedef __bf16 bf16x2_t __attribute__((ext_vector_type(2)));
__device__ __forceinline__ unsigned cvtpk_s(float lo,float hi){f32x2_t v={lo,hi};bf16x2_t b=__builtin_convertvector(v,bf16x2_t);return __builtin_bit_cast(unsigned,b);}
#define WAIT_BAR(N) asm volatile("s_waitcnt vmcnt(" #N ") lgkmcnt(0)\n\ts_barrier":::"memory")

__device__ __forceinline__ void qkt(f32x16&p0,f32x16&p1,const char*Kslot,const bf16x8*qr,int r32,int hi){
  const char*kb=Kslot+hi*1024+r32*16;
  #pragma unroll
  for(int d0=0;d0<4;++d0){
    const bf16x8 b0=*reinterpret_cast<const bf16x8*>(kb+d0*2048);
    const bf16x8 b1=*reinterpret_cast<const bf16x8*>(kb+d0*2048+512);
    p0=__builtin_amdgcn_mfma_f32_32x32x16_bf16(b0,qr[d0],p0,0,0,0);p1=__builtin_amdgcn_mfma_f32_32x32x16_bf16(b1,qr[d0],p1,0,0,0);}
}
typedef __attribute__((address_space(3))) const char* lds_cptr;
typedef short v4i16_t __attribute__((ext_vector_type(4)));
__device__ __forceinline__ void kload8(bf16x8*kf,lds_cptr kp){
  kf[0]=*(const __attribute__((address_space(3))) bf16x8*)(kp);      kf[1]=*(const __attribute__((address_space(3))) bf16x8*)(kp+512);
  kf[2]=*(const __attribute__((address_space(3))) bf16x8*)(kp+2048); kf[3]=*(const __attribute__((address_space(3))) bf16x8*)(kp+2560);
  kf[4]=*(const __attribute__((address_space(3))) bf16x8*)(kp+4096); kf[5]=*(const __attribute__((address_space(3))) bf16x8*)(kp+4608);
  kf[6]=*(const __attribute__((address_space(3))) bf16x8*)(kp+6144); kf[7]=*(const __attribute__((address_space(3))) bf16x8*)(kp+6656);
}
__device__ __forceinline__ void kload2(bf16x8*kf,lds_cptr kp,int j){ kf[2*j]=*(const __attribute__((address_space(3))) bf16x8*)(kp+j*2048); kf[2*j+1]=*(const __attribute__((address_space(3))) bf16x8*)(kp+j*2048+512); }
__device__ __forceinline__ s16x4 vtr(lds_cptr p){ return __builtin_bit_cast(s16x4,__builtin_amdgcn_ds_read_tr16_b64_v4i16((__attribute__((address_space(3))) v4i16_t*)p)); }
__device__ __forceinline__ float rowmax(const f32x16&p0,const f32x16&p1){
  float a=max3f(p0[0],p0[1],p1[0]),b=max3f(p0[2],p0[3],p1[1]);a=max3f(a,p1[2],p1[3]);
  #pragma unroll
  for(int r=4;r<16;r+=4){a=max3f(a,p0[r],p0[r+1]);b=max3f(b,p0[r+2],p0[r+3]);a=max3f(a,p1[r],p1[r+1]);b=max3f(b,p1[r+2],p1[r+3]);}
  const float m=max2f(a,b);
  auto rr=__builtin_amdgcn_permlane32_swap(__float_as_uint(m),__float_as_uint(m),false,false);
  return max2f(__uint_as_float(rr[0]),__uint_as_float(rr[1]));
}
__device__ __forceinline__ void pv(f32x16*o,int vb,bf16x8 pa0,bf16x8 pa1,bf16x8 pa2,bf16x8 pa3){
  #pragma unroll
  for(int d0=0;d0<2;++d0){s16x4 lo[4],hi[4];
    #pragma unroll
    for(int ks=0;ks<4;++ks){
      asm volatile("ds_read_b64_tr_b16 %0,%1 offset:%c2":"=&v"(lo[ks]):"v"(vb),"i"(d0*4096+ks*1024):"memory");
      asm volatile("ds_read_b64_tr_b16 %0,%1 offset:%c2":"=&v"(hi[ks]):"v"(vb),"i"(d0*4096+ks*1024+512):"memory");}
    asm volatile("s_waitcnt lgkmcnt(0)":::"memory");SBAR();
    #define PK(k) (bf16x8){lo[k][0],lo[k][1],lo[k][2],lo[k][3],hi[k][0],hi[k][1],hi[k][2],hi[k][3]}
    o[d0]=__builtin_amdgcn_mfma_f32_32x32x16_bf16(pa0,PK(0),o[d0],0,0,0);
    o[d0]=__builtin_amdgcn_mfma_f32_32x32x16_bf16(pa1,PK(1),o[d0],0,0,0);
    o[d0]=__builtin_amdgcn_mfma_f32_32x32x16_bf16(pa2,PK(2),o[d0],0,0,0);
    o[d0]=__builtin_amdgcn_mfma_f32_32x32x16_bf16(pa3,PK(3),o[d0],0,0,0);
    #undef PK
  }
}

#ifndef ATTN_STORE16
#define ATTN_STORE16(p,v) (*(u32x4*)(p)=(v))
#endif
typedef __attribute__((address_space(3))) const float* lds_fptr; typedef __attribute__((address_space(3))) const f32x4_t* lds_f4ptr;
template<int THRL> __device__ __forceinline__ void attn_unit(int b,int h,int qb,const bf16*Q,const bf16*__restrict__ K,const bf16*__restrict__ V,bf16*O,char*shm,lds_fptr cl,const float*__restrict__ gain){
  const int tid=threadIdx.x,lane=tid&63,r32=lane&31,hi=lane>>5; const int wid=__builtin_amdgcn_readfirstlane(tid>>6);
  const long rowbase=(long)b*SEQ; const int q0=qb*QB;
  const bf16*Qw=Q+(rowbase+q0+wid*QBLK)*DM+h*D;
  const bf16*Kh=K+rowbase*DM+h*D,*Vh=V+rowbase*DM+h*D;
  const unsigned lds0=(unsigned)(uintptr_t)shm;
  float*wsf=(float*)(shm+LDS_WS)+wid*64;
  const bf16*ksrc=Kh+(long)lane*DM+wid*8;
  const bf16*vsrc=Vh+(long)(16*(wid&3)+(lane>>2))*DM+(wid>>2)*32+(lane&3)*8;
  const unsigned kdst=lds0+LDS_K+wid*1024, vdst=lds0+LDS_V+wid*1024;
  #define DMA_K(t,slot) glds16(ksrc+(long)(t)*KVBLK*DM,(unsigned)__builtin_amdgcn_readfirstlane(kdst+(slot)))
  #define DMA_V(t,slot) glds16(vsrc+(long)(t)*KVBLK*DM,(unsigned)__builtin_amdgcn_readfirstlane(vdst+(slot)))
  const int vb0=(int)(lds0+LDS_V)+((lane>>4)&1)*32+(lane&3)*8+(4*hi+((lane&15)>>2))*64;
  const char*Kbase=shm+LDS_K; bf16x8 kf[8];
  const lds_cptr shm3=(lds_cptr)shm; const lds_cptr kp0=shm3+LDS_K+hi*1024+r32*16; const lds_cptr vp0=shm3+LDS_V+((lane>>4)&1)*32+(lane&3)*8+(4*hi+((lane&15)>>2))*64;
  const int NT=(q0+QB)/KVBLK;
  DMA_K(0,0);DMA_V(0,0);DMA_K(1,SLOTB);
  bf16x8 qr[4];
  #pragma unroll
  for(int d0=0;d0<4;++d0)qr[d0]=*reinterpret_cast<const bf16x8*>(&Qw[(long)r32*DM+d0*16+hi*8]);
  float l_reg=0.f;f32x16 o[2];o[0]=f32x16{};o[1]=f32x16{};
  const int qrel=wid*QBLK+r32;
  float aq=cl[q0+qrel];
  #define CINIT(C0,C1,t) do{ const lds_f4ptr cp_=(lds_f4ptr)(cl+64*(t)+4*hi); _Pragma("unroll") for(int j_=0;j_<4;++j_){ const f32x4_t v0_=cp_[2*j_],v1_=cp_[8+2*j_]; _Pragma("unroll") for(int i_=0;i_<4;++i_){ C0[4*j_+i_]=aq-v0_[i_]; C1[4*j_+i_]=aq-v1_[i_]; } } }while(0)
  #define CMASK(P0,P1,t) do{int jb_=(t)-(NT-4); if(jb_>=0)cmask(P0,P1,jb_,qrel,hi);}while(0)
  bool resc=false;
  #define START(P0,P1) do{ const float rm=rowmax(P0,P1); resc=false; \
    { const float dl=rm; aq=fsub_s(aq,dl); \
      _Pragma("unroll") for(int r=0;r<16;++r){P0[r]=fsub_s(P0[r],dl);P1[r]=fsub_s(P1[r],dl);} } \
    _Pragma("unroll") for(int r=0;r<16;++r)P0[r]=__builtin_amdgcn_exp2f(P0[r]); }while(0)
  #define RESC() do{ if(resc){ asm volatile("s_waitcnt lgkmcnt(0)":::"memory"); \
      _Pragma("unroll") for(int d_=0;d_<2;++d_) _Pragma("unroll") for(int r=0;r<16;++r)o[d_][r]*=wsf[crow(r,hi)]; } }while(0)
  f32x16 pA0,pA1,pB0,pB1;
  int sl_prev=0,sl_cur=0,sl_next=SLOTB;
  #define ROT() do{sl_prev=sl_cur;sl_cur=sl_next;sl_next=(sl_next==(NSLOT-1)*SLOTB)?0:sl_next+SLOTB;}while(0)
  DMA_K(2,2*SLOTB);
  WAIT_BAR(3);
  CINIT(pA0,pA1,0);qkt(pA0,pA1,Kbase,qr,r32,hi);asm volatile("s_nop 15\n\ts_nop 7":"+v"(pA0),"+v"(pA1));CMASK(pA0,pA1,0);
  START(pA0,pA1);
  _Pragma("unroll") for(int r=0;r<16;++r)pA1[r]=__builtin_amdgcn_exp2f(pA1[r]);
  WAIT_BAR(0);
  DMA_K(3,0);DMA_V(1,SLOTB);
  ROT();
  kload8(kf,kp0+sl_cur);
  WAIT_BAR(2);
  s16x4 vlo[8],vhi[8]; u32x4 pw0,pw1,pw2,pw3;
  #define PKW(P,B) cvtpk_s(P[B],P[B+1])
  #define PAF(k) __builtin_bit_cast(bf16x8,pw##k)
  #define VFR(i) (bf16x8){vlo[i][0],vlo[i][1],vlo[i][2],vlo[i][3],vhi[i][0],vhi[i][1],vhi[i][2],vhi[i][3]}
  #define PIN(x) asm volatile("":"+v"(x))
  #define MX3(a,b,c) __builtin_fmaxf(__builtin_fmaxf((a),(b)),(c))
  #define GAPA(MF,A0,A1,A2,A3,W0,W1,PW) do{ MF; sacc+=A0; sacc+=A1; sacc+=A2; sacc+=A3; PIN(sacc); W0; W1; PIN(PW); SBAR(); }while(0)
  #define EX(v) __builtin_amdgcn_exp2f(v)
  #define GAPB(MF,X,B) do{ MF; X[B]=EX(X[B]); X[B+1]=EX(X[B+1]); X[B+2]=EX(X[B+2]); X[B+3]=EX(X[B+3]); PIN(X); SBAR(); }while(0)
  #define VRD(i) do{ vlo[i]=vtr(vp_+(((i)>>2)*4096+((i)&3)*1024)); vhi[i]=vtr(vp_+(((i)>>2)*4096+((i)&3)*1024+512)); }while(0)
  #define KRD(G,j) do{ if(G){ kload2(kf,kp0+sl_next,j); SBAR(); } }while(0)
  #define STEP(C0,C1,P0,P1,t,GK,GV,GL) do{ SBAR(); CINIT(C0,C1,t); SBAR(); \
    const lds_cptr vp_=vp0+sl_prev; \
    VRD(0); SBAR(); float sacc=(P0[0]+P0[1]); \
    GAPA(C0=__builtin_amdgcn_mfma_f32_32x32x16_bf16(kf[0],qr[0],C0,0,0,0), P0[2],P0[3],P0[4],P0[5],     pw0[0]=PKW(P0,0), pw0[1]=PKW(P0,2), pw0); \
    VRD(4); SBAR(); GAPA(C1=__builtin_amdgcn_mfma_f32_32x32x16_bf16(kf[1],qr[0],C1,0,0,0), P0[6],P0[7],P0[8],P0[9],     pw0[2]=PKW(P0,4), pw0[3]=PKW(P0,6), pw0); \
    VRD(1); SBAR(); GAPA(C0=__builtin_amdgcn_mfma_f32_32x32x16_bf16(kf[2],qr[1],C0,0,0,0),   P0[10],P0[11],P0[12],P0[13], pw1[0]=PKW(P0,8), pw1[1]=PKW(P0,10), pw1); \
    VRD(5); SBAR(); GAPA(C1=__builtin_amdgcn_mfma_f32_32x32x16_bf16(kf[3],qr[1],C1,0,0,0),   P0[14],P0[15],P1[0],P1[1],   pw1[2]=PKW(P0,12),pw1[3]=PKW(P0,14), pw1); \
    VRD(2); SBAR(); GAPA(C0=__builtin_amdgcn_mfma_f32_32x32x16_bf16(kf[4],qr[2],C0,0,0,0),   P1[2],P1[3],P1[4],P1[5],     pw2[0]=PKW(P1,0), pw2[1]=PKW(P1,2), pw2); \
    VRD(6); SBAR(); GAPA(C1=__builtin_amdgcn_mfma_f32_32x32x16_bf16(kf[5],qr[2],C1,0,0,0),   P1[6],P1[7],P1[8],P1[9],     pw2[2]=PKW(P1,4), pw2[3]=PKW(P1,6), pw2); \
    VRD(3); SBAR(); GAPA(C0=__builtin_amdgcn_mfma_f32_32x32x16_bf16(kf[6],qr[3],C0,0,0,0),   P1[10],P1[11],P1[12],P1[13], pw3[0]=PKW(P1,8), pw3[1]=PKW(P1,10), pw3); \
    VRD(7); SBAR(); GAPA(C1=__builtin_amdgcn_mfma_f32_32x32x16_bf16(kf[7],qr[3],C1,0,0,0),   P1[14],P1[15],0.f,0.f,       pw3[2]=PKW(P1,12),pw3[3]=PKW(P1,14), pw3); \
    l_reg+=sacc; \
    if(GK){DMA_K((t)+3,sl_cur);} if(GV){DMA_V((t)+1,sl_next);} \
    CMASK(C0,C1,t); \
    { float a=MX3(C0[0],C0[1],C1[0]),b=MX3(C0[2],C0[3],C1[1]); a=MX3(a,C1[2],C1[3]); \
      _Pragma("unroll") for(int r=4;r<16;r+=4){a=MX3(a,C0[r],C0[r+1]);b=MX3(b,C0[r+2],C0[r+3]);a=MX3(a,C1[r],C1[r+1]);b=MX3(b,C1[r+2],C1[r+3]);} \
      float rm=__builtin_fmaxf(a,b); { auto rr=__builtin_amdgcn_permlane32_swap(__float_as_uint(rm),__float_as_uint(rm),false,false); rm=__builtin_fmaxf(__uint_as_float(rr[0]),__uint_as_float(rr[1])); } \
      resc=false; \
      if(__builtin_expect(__any(rm>(float)THRL),0)){ const float dl=__builtin_fmaxf(rm,0.f); aq-=dl; \
        _Pragma("unroll") for(int r=0;r<16;++r){C0[r]-=dl;C1[r]-=dl;} \
        const float f=__builtin_amdgcn_exp2f(-dl); l_reg*=f; if(hi==0)wsf[r32]=f; resc=true; } } \
    SBAR(); \
    GAPB(o[0]=__builtin_amdgcn_mfma_f32_32x32x16_bf16(PAF(0),VFR(0),o[0],0,0,0), C0,0); \
    GAPB(o[1]=__builtin_amdgcn_mfma_f32_32x32x16_bf16(PAF(0),VFR(4),o[1],0,0,0), C0,4); \
    KRD(GL,0); GAPB(o[0]=__builtin_amdgcn_mfma_f32_32x32x16_bf16(PAF(1),VFR(1),o[0],0,0,0), C0,8); \
    KRD(GL,1); GAPB(o[1]=__builtin_amdgcn_mfma_f32_32x32x16_bf16(PAF(1),VFR(5),o[1],0,0,0), C0,12); \
    KRD(GL,2); GAPB(o[0]=__builtin_amdgcn_mfma_f32_32x32x16_bf16(PAF(2),VFR(2),o[0],0,0,0), C1,0); \
    KRD(GL,3); GAPB(o[1]=__builtin_amdgcn_mfma_f32_32x32x16_bf16(PAF(2),VFR(6),o[1],0,0,0), C1,4); \
    GAPB(o[0]=__builtin_amdgcn_mfma_f32_32x32x16_bf16(PAF(3),VFR(3),o[0],0,0,0), C1,8); \
    GAPB(o[1]=__builtin_amdgcn_mfma_f32_32x32x16_bf16(PAF(3),VFR(7),o[1],0,0,0), C1,12); \
    }while(0)
  int t=1;
  #undef CMASK
  #define CMASK(P0,P1,t) do{}while(0)
  for(;t+5<NT;t+=2){
    STEP(pB0,pB1,pA0,pA1,t,true,true,true);     WAIT_BAR(2); RESC(); ROT();
    STEP(pA0,pA1,pB0,pB1,t+1,true,true,true);   WAIT_BAR(2); RESC(); ROT();
  }
  #undef CMASK
  #define CMASK(P0,P1,t) do{int jb_=(t)-(NT-4); if(jb_>=0)cmask(P0,P1,jb_,qrel,hi);}while(0)
  #define ENDW(tt) do{ if((tt)+3<NT){WAIT_BAR(2);} else if((tt)+2<NT){WAIT_BAR(1);} else {WAIT_BAR(0);} }while(0)
  for(;t+1<NT;t+=2){
    STEP(pB0,pB1,pA0,pA1,t,(t+3<NT),(t+1<NT),(t+1<NT));       ENDW(t);   RESC(); ROT();
    STEP(pA0,pA1,pB0,pB1,t+1,(t+4<NT),(t+2<NT),(t+2<NT));     ENDW(t+1); RESC(); ROT();
  }
  STEP(pB0,pB1,pA0,pA1,NT-1,false,false,false); RESC();
  { float sacc=pB0[0]+pB0[1]; _Pragma("unroll") for(int r=2;r<16;++r)sacc+=pB0[r]; _Pragma("unroll") for(int r=0;r<16;++r)sacc+=pB1[r]; l_reg+=sacc;
    pw0=(u32x4){PKW(pB0,0),PKW(pB0,2),PKW(pB0,4),PKW(pB0,6)};pw1=(u32x4){PKW(pB0,8),PKW(pB0,10),PKW(pB0,12),PKW(pB0,14)};pw2=(u32x4){PKW(pB1,0),PKW(pB1,2),PKW(pB1,4),PKW(pB1,6)};pw3=(u32x4){PKW(pB1,8),PKW(pB1,10),PKW(pB1,12),PKW(pB1,14)};
    SBAR(); pv(o,vb0+sl_cur,PAF(0),PAF(1),PAF(2),PAF(3)); }
  #undef PKW
  #undef PAF
  #undef VFR
  #undef PIN
  #undef MX3
  #undef GAPA
  #undef GAPB
  #undef EX
  #undef VRD
  #undef KRD
  #undef STEP
  #undef ENDW
  {auto rr=__builtin_amdgcn_permlane32_swap(__float_as_uint(l_reg),__float_as_uint(l_reg),false,false);l_reg=__uint_as_float(rr[0])+__uint_as_float(rr[1]);}
  if(hi==0)wsf[32+r32]=l_reg;asm volatile("s_waitcnt lgkmcnt(0)":::"memory");
  float rli[16];
  #pragma unroll
  for(int r=0;r<16;++r)rli[r]=__builtin_amdgcn_rcpf(wsf[32+crow(r,hi)]);
  bf16*Ow=O+(rowbase+q0+wid*QBLK)*OPITCH+h*D;
  { bf16*stg=(bf16*)(shm+LDS_OST)+wid*2048;
    #pragma unroll
    for(int r=0;r<16;++r){const int orow=crow(r,hi);
      #pragma unroll
      for(int d0=0;d0<2;++d0)stg[orow*64+d0*32+r32]=__float2bfloat16(o[d0][r]*rli[r]);}
    asm volatile("s_waitcnt lgkmcnt(0)":::"memory");
    #pragma unroll
    for(int i=0;i<4;++i){const int row=i*8+(lane>>3),ch=lane&7; const u32x4 v=*(const u32x4*)(stg+row*64+ch*8);
      float x[8]; _Pragma("unroll") for(int k=0;k<4;++k){x[2*k]=__uint_as_float(v[k]<<16);x[2*k+1]=__uint_as_float(v[k]&0xffff0000u);}
      float ss=0.f; _Pragma("unroll") for(int k=0;k<8;++k)ss+=x[k]*x[k];
      ss+=__shfl_xor(ss,1);ss+=__shfl_xor(ss,2);ss+=__shfl_xor(ss,4);
      const float rs=1.0f/sqrtf(ss*(1.0f/64.0f)+1e-6f); const f32x4_t g0=*(const f32x4_t*)(gain+h*D+ch*8),g1=*(const f32x4_t*)(gain+h*D+ch*8+4);
      u32x4 w; w[0]=cvtpk_s(x[0]*rs*g0[0],x[1]*rs*g0[1]);w[1]=cvtpk_s(x[2]*rs*g0[2],x[3]*rs*g0[3]);w[2]=cvtpk_s(x[4]*rs*g1[0],x[5]*rs*g1[1]);w[3]=cvtpk_s(x[6]*rs*g1[2],x[7]*rs*g1[3]);
      ATTN_STORE16(Ow+(long)row*OPITCH+ch*8,w);} }
  asm volatile("s_waitcnt lgkmcnt(0)\n\ts_barrier":::"memory");
  #undef DMA_K
  #undef DMA_V
  #undef CMASK
  #undef START
  #undef CINIT
  #undef RESC
  #undef ROT
}
constexpr int ATTN_LDS_BYTES=LDS_BYTES;
#undef SBAR
#undef WAIT_BAR
}
#ifndef MK_MULTI
#define MK_MULTI 0
#endif
constexpr int NWAVES = 8, NTHR = 512;
constexpr int Mrows = 32768, DM_ = 1024, DFF = 2816, SEQL = 4096, DPLE = 256;
constexpr int NPH = 12;
constexpr size_t MiB = 1u << 20;
constexpr size_t WS_W1GU = 2 * MiB, WS_W1D = 14 * MiB, WS_WIN = 20 * MiB, WS_WOUT = 27 * MiB, WS_W2GU = 30 * MiB, WS_W2D = 42 * MiB, WS_WPG = 48 * MiB, WS_WPP = 50 * MiB;
constexpr size_t WS_GATES = 52 * MiB, WS_CL = 54 * MiB, WS_BARR = 55 * MiB, WS_RARR = 55 * MiB + 512 * 1024, WS_NLOC = 56 * MiB, WS_NPREV = 56 * MiB + 512 * 1024;
constexpr size_t WS_GARR = 57 * MiB, WS_MLOC = 57 * MiB + 65536, WS_MPREV = 57 * MiB + 131072;
constexpr size_t WS_SS0 = 58 * MiB, WS_SS1 = 60 * MiB, WS_SS2 = 62 * MiB, WS_SS3 = 64 * MiB, WS_SS4 = 66 * MiB, WS_SSP = 68 * MiB;
constexpr size_t WS_XN = 72 * MiB;
constexpr size_t WS_ACTZ = 136 * MiB;
constexpr size_t WS_YMIX = 328 * MiB;
constexpr size_t WS_UT = 392 * MiB;
constexpr size_t WS_CT = 456 * MiB;
constexpr size_t WS_PB = 488 * MiB;
constexpr size_t WS_END = 504 * MiB;
constexpr int LDS_BYTES = 147456;
constexpr int WIN_ROWS = 3328;

#define LAS __attribute__((address_space(3)))
typedef unsigned short bf16;
typedef unsigned v4u __attribute__((ext_vector_type(4)));
typedef float f32x4 __attribute__((ext_vector_type(4)));
typedef short bf16x8 __attribute__((ext_vector_type(8)));
#define LDS_WAIT() asm volatile("s_waitcnt lgkmcnt(0)" ::: "memory")
__device__ __forceinline__ unsigned f2bf(float f) { unsigned u = __builtin_bit_cast(unsigned, f); return (u + 0x7fffu + ((u >> 16) & 1u)) >> 16; }
__device__ __forceinline__ unsigned pk2(float lo, float hi) { return f2bf(lo) | (f2bf(hi) << 16); }
__device__ __forceinline__ float bf2f(unsigned h) { return __uint_as_float(h << 16); }
__device__ __forceinline__ float logsig_f(float x) { return fminf(x, 0.f) - log1pf(__expf(-fabsf(x))); }
__device__ __forceinline__ float sigm_f(float x) { return 1.0f / (1.0f + __expf(-x)); }

__device__ __forceinline__ int wmap(int map, int n) {
    if (map == 1) return ((n >> 7) << 8) + (n & 127);
    if (map == 2) return ((n >> 7) << 8) + 128 + (n & 127);
    if (map == 3) { if (n < 1536) return n; if (n < 1544) return 3072 + (n - 1536); if (n < 3080) return n - 8; return n; }
    return n;
}
__device__ __forceinline__ void p0_transpose_item(const float* __restrict__ W, int K, int N, bf16* WT, int map, const float* __restrict__ gain, LAS float* scr, int item, int lane) {
    const int nblk = (N + 31) / 32, kb = item / nblk, nb = item % nblk, k0 = 64 * kb, n0 = 32 * nb;
    const int nin = n0 + (lane & 31); const bool ok = nin < N;
#pragma unroll 8
    for (int i = 0; i < 32; ++i) { const int kk = 2 * i + (lane >> 5); float v = ok ? W[(size_t)(k0 + kk) * N + nin] : 0.f; if (gain) v *= gain[k0 + kk]; scr[kk * 33 + (lane & 31)] = v; }
    LDS_WAIT(); asm volatile("" ::: "memory");
    const int c = lane & 7;
#pragma unroll
    for (int j = 0; j < 4; ++j) { const int n = (lane >> 3) + 8 * j; const LAS float* s = scr + (8 * c) * 33 + n;
        v4u o; o.x = pk2(s[0 * 33], s[1 * 33]); o.y = pk2(s[2 * 33], s[3 * 33]); o.z = pk2(s[4 * 33], s[5 * 33]); o.w = pk2(s[6 * 33], s[7 * 33]);
        if (n0 + n < N) *(v4u*)(WT + (size_t)wmap(map, n0 + n) * K + k0 + 8 * c) = o; }
    LDS_WAIT(); asm volatile("" ::: "memory");
}

constexpr int LDS_LD = 72;
__device__ __forceinline__ bf16x8 frag(const LAS bf16* X, int r0, int k0, int lane) { return *(const LAS bf16x8*)(X + (r0 + (lane & 15)) * LDS_LD + k0 + 8 * (lane >> 4)); }
#define MMA16(a, b, c) __builtin_amdgcn_mfma_f32_16x16x32_bf16((a), (b), (c), 0, 0, 0)

struct Ptrs {
    const float* gates; float *barr, *rarr, *nloc, *nprev, *garr, *mloc, *mprev, *ut; bf16 *ct, *qkc, *z, *ymix; const float *conv, *gm;
};

__device__ __forceinline__ void mlstm_local_item(int ci, LAS unsigned char* lds, const Ptrs& P) {
    const int tid = threadIdx.x, lane = tid & 63, wid = tid >> 6;
    const int bh = ci >> 6, c = ci & 63, b = bh >> 2, h = bh & 3;
    const size_t row0 = (size_t)b * SEQL + (size_t)c * 64;
    LAS bf16* KwT = (LAS bf16*)lds;
    LAS bf16* VT = (LAS bf16*)(lds + 9216);
    LAS float* wv = (LAS float*)(lds + 9216 + 18432);
    if (wid == 0) {
        const float ip = P.gates[(row0 + lane) * 16 + h], fp = P.gates[(row0 + lane) * 16 + 4 + h];
        float bc = logsig_f(fp);
#pragma unroll
        for (int o = 1; o < 64; o <<= 1) { const float t = __shfl_up(bc, o); if (lane >= o) bc += t; }
        const float g = __shfl(bc, 63);
        const float r = ip - bc; float rm = r;
#pragma unroll
        for (int o = 1; o < 64; o <<= 1) rm = fmaxf(rm, __shfl_xor(rm, o));
        wv[lane] = __expf(r - rm);
        P.barr[ci * 64 + lane] = bc; P.rarr[ci * 64 + lane] = r; if (lane == 0) { P.garr[ci] = g; P.mloc[ci] = g + rm; }
    }
    const int cg8 = tid & 15, tl = tid >> 4, isk = cg8 >> 3, zc = isk * 256 + h * 64 + (cg8 & 7) * 8;
    float kv[2][8];
    {
        float cw[4][8];
#pragma unroll
        for (int j = 0; j < 4; ++j) { const f32x4 a = *(const f32x4*)(P.conv + j * 512 + zc), d = *(const f32x4*)(P.conv + j * 512 + zc + 4);
#pragma unroll
            for (int i = 0; i < 4; ++i) { cw[j][i] = a[i]; cw[j][4 + i] = d[i]; } }
#pragma unroll
        for (int p = 0; p < 2; ++p) { const int t = tl + 32 * p, tpos = c * 64 + t; float a[8];
#pragma unroll
            for (int i = 0; i < 8; ++i) a[i] = 0.f;
#pragma unroll
            for (int j = 0; j < 4; ++j) { const int tp = tpos - 3 + j;
                if (tp >= 0) { const v4u zz = *(const v4u*)(P.z + ((size_t)b * SEQL + tp) * 3072 + zc);
#pragma unroll
                    for (int k = 0; k < 4; ++k) { a[2 * k] += cw[j][2 * k] * bf2f(zz[k] & 0xffffu); a[2 * k + 1] += cw[j][2 * k + 1] * __uint_as_float(zz[k] & 0xffff0000u); } } }
            const float sc = isk ? 1.0f : 0.125f;
#pragma unroll
            for (int i = 0; i < 8; ++i) { a[i] = a[i] * sigm_f(a[i]) * sc; kv[p][i] = a[i]; }
            v4u o; o.x = pk2(a[0], a[1]); o.y = pk2(a[2], a[3]); o.z = pk2(a[4], a[5]); o.w = pk2(a[6], a[7]);
            *(v4u*)(P.qkc + (row0 + t) * 512 + zc) = o; }
    }
#pragma unroll
    for (int p = 0; p < 2; ++p) { const int s = tl + 32 * p; const v4u vv = *(const v4u*)(P.z + (row0 + s) * 3072 + 512 + h * 128 + cg8 * 8);
#pragma unroll
        for (int k = 0; k < 4; ++k) { VT[(cg8 * 8 + 2 * k) * LDS_LD + s] = (bf16)(vv[k] & 0xffffu); VT[(cg8 * 8 + 2 * k + 1) * LDS_LD + s] = (bf16)(vv[k] >> 16); } }
    __syncthreads();
    if (isk) {
#pragma unroll
        for (int p = 0; p < 2; ++p) { const int t = tl + 32 * p; const float w = wv[t];
#pragma unroll
            for (int i = 0; i < 8; ++i) KwT[((cg8 & 7) * 8 + i) * LDS_LD + t] = (bf16)f2bf(kv[p][i] * w); }
    }
    __syncthreads();
    {
        f32x4 acc[4];
#pragma unroll
        for (int dj = 0; dj < 4; ++dj) acc[dj] = (f32x4){0.f, 0.f, 0.f, 0.f};
#pragma unroll
        for (int ks = 0; ks < 2; ++ks) { const bf16x8 a = frag(VT, 16 * wid, ks * 32, lane);
#pragma unroll
            for (int dj = 0; dj < 4; ++dj) acc[dj] = MMA16(a, frag(KwT, 16 * dj, ks * 32, lane), acc[dj]); }
        float* up = P.ut + (size_t)ci * 8192;
#pragma unroll
        for (int dj = 0; dj < 4; ++dj)
#pragma unroll
            for (int r = 0; r < 4; ++r) up[(16 * wid + 4 * (lane >> 4) + r) * 64 + 16 * dj + (lane & 15)] = acc[dj][r];
    }
    if (wid == 0) { float s = 0.f;
#pragma unroll 8
        for (int i = 0; i < 64; ++i) s += bf2f(KwT[lane * LDS_LD + i]);
        P.nloc[ci * 64 + lane] = s; }
    __syncthreads();
}

__device__ __forceinline__ void mlstm_out_item(int ci, LAS unsigned char* lds, const Ptrs& P) {
    const int tid = threadIdx.x, lane = tid & 63, wid = tid >> 6;
    const int bh = ci >> 6, c = ci & 63, b = bh >> 2, h = bh & 3;
    const size_t row0 = (size_t)b * SEQL + (size_t)c * 64;
    LAS bf16* Qs = (LAS bf16*)lds; LAS bf16* Qw = (LAS bf16*)(lds + 9216); LAS bf16* Ks = (LAS bf16*)(lds + 18432); LAS bf16* Ps = (LAS bf16*)(lds + 27648);
    LAS bf16* VT = (LAS bf16*)(lds + 36864); LAS bf16* CTs = (LAS bf16*)(lds + 55296); LAS float* NUM = (LAS float*)(lds + 73728);
    LAS float* rvec = (LAS float*)(lds + 107520); LAS float* Mt = rvec + 64; LAS float* wint = rvec + 128; LAS float* emt = rvec + 192; LAS float* npv = rvec + 256; LAS float* denom = rvec + 320;
    if (wid == 0) {
        const float r = P.rarr[ci * 64 + lane], bt = P.barr[ci * 64 + lane], mp = P.mprev[ci];
        float cm = r;
#pragma unroll
        for (int o = 1; o < 64; o <<= 1) { const float t = __shfl_up(cm, o); if (lane >= o) cm = fmaxf(cm, t); }
        const float M = fmaxf(mp, cm);
        rvec[lane] = r; Mt[lane] = M; wint[lane] = __expf(mp - M); emt[lane] = __expf(-bt - M); npv[lane] = P.nprev[ci * 64 + lane];
    }
    const int t8 = tid >> 3, part = tid & 7;
    { const v4u q = *(const v4u*)(P.qkc + (row0 + t8) * 512 + h * 64 + part * 8); *(LAS v4u*)(Qs + t8 * LDS_LD + part * 8) = q;
      const v4u k = *(const v4u*)(P.qkc + (row0 + t8) * 512 + 256 + h * 64 + part * 8); *(LAS v4u*)(Ks + t8 * LDS_LD + part * 8) = k; }
#pragma unroll
    for (int p = 0; p < 2; ++p) { const int idx = tid + 512 * p, e = idx >> 3, pp = idx & 7; const v4u cc = *(const v4u*)(P.ct + (size_t)ci * 8192 + e * 64 + pp * 8); *(LAS v4u*)(CTs + e * LDS_LD + pp * 8) = cc; }
    { const int cg8 = tid & 15, tl = tid >> 4;
#pragma unroll
      for (int p = 0; p < 2; ++p) { const int s = tl + 32 * p; const v4u vv = *(const v4u*)(P.z + (row0 + s) * 3072 + 512 + h * 128 + cg8 * 8);
#pragma unroll
        for (int k = 0; k < 4; ++k) { VT[(cg8 * 8 + 2 * k) * LDS_LD + s] = (bf16)(vv[k] & 0xffffu); VT[(cg8 * 8 + 2 * k + 1) * LDS_LD + s] = (bf16)(vv[k] >> 16); } } }
    __syncthreads();
    { const float w = wint[t8]; const v4u q = *(const LAS v4u*)(Qs + t8 * LDS_LD + part * 8); v4u o;
#pragma unroll
      for (int k = 0; k < 4; ++k) o[k] = pk2(bf2f(q[k] & 0xffffu) * w, __uint_as_float(q[k] & 0xffff0000u) * w);
      *(LAS v4u*)(Qw + t8 * LDS_LD + part * 8) = o; }
    {
        const int ti = wid >> 1;
#pragma unroll
        for (int jj = 0; jj < 2; ++jj) { const int sj = 2 * (wid & 1) + jj; f32x4 acc = (f32x4){0.f, 0.f, 0.f, 0.f};
            if (sj <= ti) {
#pragma unroll
                for (int ks = 0; ks < 2; ++ks) acc = MMA16(frag(Qs, 16 * ti, ks * 32, lane), frag(Ks, 16 * sj, ks * 32, lane), acc);
            }
            const int s = 16 * sj + (lane & 15); const float rs = rvec[s];
#pragma unroll
            for (int r = 0; r < 4; ++r) { const int t = 16 * ti + 4 * (lane >> 4) + r; const float pv = (s <= t) ? __expf(rs - Mt[t]) * acc[r] : 0.f; Ps[t * LDS_LD + s] = (bf16)f2bf(pv); } }
    }
    __syncthreads();
    {
        const v4u q = *(const LAS v4u*)(Qs + t8 * LDS_LD + part * 8), pp = *(const LAS v4u*)(Ps + t8 * LDS_LD + part * 8); float dot = 0.f, ps = 0.f;
#pragma unroll
        for (int k = 0; k < 4; ++k) { dot += bf2f(q[k] & 0xffffu) * npv[part * 8 + 2 * k] + __uint_as_float(q[k] & 0xffff0000u) * npv[part * 8 + 2 * k + 1]; ps += bf2f(pp[k] & 0xffffu) + __uint_as_float(pp[k] & 0xffff0000u); }
        float v = wint[t8] * dot + ps; v += __shfl_xor(v, 1); v += __shfl_xor(v, 2); v += __shfl_xor(v, 4);
        if (part == 0) denom[t8] = fmaxf(fabsf(v), emt[t8]);
    }
    {
        const int ti = wid >> 1, eh = wid & 1; f32x4 acc[4];
#pragma unroll
        for (int ej = 0; ej < 4; ++ej) acc[ej] = (f32x4){0.f, 0.f, 0.f, 0.f};
#pragma unroll
        for (int ks = 0; ks < 2; ++ks) { const bf16x8 a = frag(Qw, 16 * ti, ks * 32, lane);
#pragma unroll
            for (int ej = 0; ej < 4; ++ej) acc[ej] = MMA16(a, frag(CTs, 64 * eh + 16 * ej, ks * 32, lane), acc[ej]); }
#pragma unroll
        for (int ks = 0; ks < 2; ++ks) { const bf16x8 a = frag(Ps, 16 * ti, ks * 32, lane);
#pragma unroll
            for (int ej = 0; ej < 4; ++ej) acc[ej] = MMA16(a, frag(VT, 64 * eh + 16 * ej, ks * 32, lane), acc[ej]); }
#pragma unroll
        for (int ej = 0; ej < 4; ++ej)
#pragma unroll
            for (int r = 0; r < 4; ++r) NUM[(16 * ti + 4 * (lane >> 4) + r) * 132 + 64 * eh + 16 * ej + (lane & 15)] = acc[ej][r];
    }
    __syncthreads();
    {
        const float rd = 1.0f / denom[t8]; float hv[16]; float ss = 0.f;
#pragma unroll
        for (int i = 0; i < 4; ++i) { const f32x4 x = *(const LAS f32x4*)(NUM + t8 * 132 + part * 16 + 4 * i);
#pragma unroll
            for (int k = 0; k < 4; ++k) { hv[4 * i + k] = x[k] * rd; ss += hv[4 * i + k] * hv[4 * i + k]; } }
        ss += __shfl_xor(ss, 1); ss += __shfl_xor(ss, 2); ss += __shfl_xor(ss, 4);
        const float rs = 1.0f / sqrtf(ss * (1.0f / 128.0f) + 1e-6f);
        const bf16* mo = P.z + (row0 + t8) * 3072 + 1024 + h * 128 + part * 16; const float* gmp = P.gm + h * 128 + part * 16; bf16* yo = P.ymix + (row0 + t8) * 1024 + h * 128 + part * 16;
#pragma unroll
        for (int hh = 0; hh < 2; ++hh) { const v4u mv = *(const v4u*)(mo + 8 * hh); const f32x4 g0 = *(const f32x4*)(gmp + 8 * hh), g1 = *(const f32x4*)(gmp + 8 * hh + 4); float y[8];
#pragma unroll
            for (int k = 0; k < 4; ++k) { const float m0 = bf2f(mv[k] & 0xffffu), m1 = __uint_as_float(mv[k] & 0xffff0000u); const float ga = k < 2 ? g0[2 * k] : g1[2 * k - 4], gb = k < 2 ? g0[2 * k + 1] : g1[2 * k - 3];
                y[2 * k] = hv[8 * hh + 2 * k] * rs * ga * sigm_f(m0); y[2 * k + 1] = hv[8 * hh + 2 * k + 1] * rs * gb * sigm_f(m1); }
            v4u o; o.x = pk2(y[0], y[1]); o.y = pk2(y[2], y[3]); o.z = pk2(y[4], y[5]); o.w = pk2(y[6], y[7]);
            *(v4u*)(yo + 8 * hh) = o; }
    }
    __syncthreads();
}

typedef unsigned u32;
#define RLX_AGENT __ATOMIC_RELAXED, __HIP_MEMORY_SCOPE_AGENT
#define XB_TMO      128
#define XB_XCNT(j)  (256  + 64 * (j))
#define XB_XSUB(j)  (1280 + 64 * (j))
#define XB_XGEN(j)  (2304 + 64 * (j))
#define XB_TOP      3328
#define XB_TOPGEN   3392
#define XCD_BAR_WORDS 3456
#define XB_SPIN_CAP (1u << 18)

__device__ __forceinline__ unsigned xb_ld(unsigned* p)              { return __hip_atomic_load(p, __ATOMIC_RELAXED, __HIP_MEMORY_SCOPE_AGENT); }
__device__ __forceinline__ unsigned xb_add(unsigned* p, unsigned v) { return __hip_atomic_fetch_add(p, v, __ATOMIC_RELAXED, __HIP_MEMORY_SCOPE_AGENT); }
__device__ __forceinline__ unsigned xb_xcc_id() { return (unsigned)__builtin_amdgcn_s_getreg((3 << 11) | 20) & 0xFu; }
#define XB_SPIN(cond, bar) do { unsigned _sp = 0; while (cond) { __builtin_amdgcn_s_sleep(1); \
    if ((++_sp & 255u) == 0u) { if (xb_ld(&(bar)[XB_TMO])) break; if (_sp > XB_SPIN_CAP) { atomicAdd(&(bar)[XB_TMO], 1u); break; } } } } while (0)

struct XcdBarrier {
    unsigned* bar; unsigned x;
    volatile LAS unsigned* st;
};

__device__ __forceinline__ XcdBarrier xcd_barrier_post(unsigned* bar, volatile LAS unsigned* st) {
    XcdBarrier b; b.bar = bar; b.x = xb_xcc_id(); b.st = st;
    if (threadIdx.x == 0) (void)xb_add(&bar[XB_XCNT(b.x)], 1u);
    return b;
}
__device__ __forceinline__ void xcd_barrier_complete(unsigned* bar, unsigned x, unsigned& nloc, unsigned& nx) {
    const unsigned G = gridDim.x * gridDim.y * gridDim.z;
    unsigned sum, cnt, mine, sp = 0u;
    for (;;) {
        sum = 0u; cnt = 0u; mine = 0u;
#pragma unroll
        for (unsigned j = 0; j < 16; ++j) { const unsigned c = xb_ld(&bar[XB_XCNT(j)]); sum += c; cnt += (c > 0u) ? 1u : 0u; mine = (j == x) ? c : mine; }
        if (sum == G) break;
        __builtin_amdgcn_s_sleep(1);
        if ((++sp & 255u) == 0u) { if (xb_ld(&bar[XB_TMO])) break; if (sp > XB_SPIN_CAP) { atomicAdd(&bar[XB_TMO], 1u); break; } }
    }
    nloc = mine > 0u ? mine : 1u; nx = cnt > 0u ? cnt : 1u;
}

__device__ __forceinline__ void xcd_barrier(const XcdBarrier& b) {
    asm volatile("s_waitcnt vmcnt(0)" ::: "memory");
    __syncthreads();
    if (threadIdx.x == 0) {
        unsigned* bar = b.bar;
        __builtin_amdgcn_s_waitcnt(0);
        unsigned nloc = b.st[0], nx = b.st[1];
        if (nloc == 0u) { xcd_barrier_complete(bar, b.x, nloc, nx); b.st[0] = nloc; b.st[1] = nx; }
        const unsigned old = xb_add(&bar[XB_XSUB(b.x)], 1u);
        const unsigned gen = old / nloc;
        if (old + 1u == (gen + 1u) * nloc) {
            __builtin_amdgcn_fence(__ATOMIC_RELEASE, "agent");
            asm volatile("s_waitcnt vmcnt(0)" ::: "memory");
            const unsigned og = xb_add(&bar[XB_TOP], 1u);
            const unsigned tg = og / nx;
            if (og + 1u == (tg + 1u) * nx) xb_add(&bar[XB_TOPGEN], 1u);
            else XB_SPIN(xb_ld(&bar[XB_TOPGEN]) == tg, bar);
            __builtin_amdgcn_fence(__ATOMIC_ACQUIRE, "agent");
            xb_add(&bar[XB_XGEN(b.x)], 1u);
            asm volatile("s_waitcnt vmcnt(0)" ::: "memory");
        } else {
            XB_SPIN(xb_ld(&bar[XB_XGEN(b.x)]) == gen, bar);
            __builtin_amdgcn_fence(__ATOMIC_ACQUIRE, "agent");
            asm volatile("s_waitcnt vmcnt(0)" ::: "memory");
        }
    }
    __syncthreads();
}

struct Args { const float* in[23]; float* out; unsigned char* ws; int ph_lo, ph_hi; };
__global__ void __launch_bounds__(NTHR, 2) hymba_fwd(Args args) {
    extern __shared__ __attribute__((aligned(16))) unsigned char lds_raw[];
    LAS unsigned char* lds = (LAS unsigned char*)lds_raw;
    cg::grid_group grid = cg::this_grid();
    const int tid = threadIdx.x, lane = tid & 63, wave = __builtin_amdgcn_readfirstlane(tid >> 6);
    const int G = gridDim.x; const int bx = blockIdx.x; const int vcu = (G % 8 == 0) ? (bx % 8) * (G / 8) + bx / 8 : bx;
#define H (args.out)
#define W1GU ((bf16*)(args.ws + WS_W1GU))
#define W1D ((bf16*)(args.ws + WS_W1D))
#define WIN ((bf16*)(args.ws + WS_WIN))
#define WOUT ((bf16*)(args.ws + WS_WOUT))
#define W2GU ((bf16*)(args.ws + WS_W2GU))
#define W2D ((bf16*)(args.ws + WS_W2D))
#define WPG ((bf16*)(args.ws + WS_WPG))
#define WPP ((bf16*)(args.ws + WS_WPP))
#define GATES ((float*)(args.ws + WS_GATES))
#define CLG ((float*)(args.ws + WS_CL))
#define SS0 ((float*)(args.ws + WS_SS0))
#define SS1 ((float*)(args.ws + WS_SS1))
#define SS2 ((float*)(args.ws + WS_SS2))
#define SS3 ((float*)(args.ws + WS_SS3))
#define SS4 ((float*)(args.ws + WS_SS4))
#define SSP ((float*)(args.ws + WS_SSP))
#define XN ((bf16*)(args.ws + WS_XN))
#define ACT ((bf16*)(args.ws + WS_ACTZ))
#define Z ((bf16*)(args.ws + WS_ACTZ))
#define YMIX ((bf16*)(args.ws + WS_YMIX))
#define PROJ ((bf16*)(args.ws + WS_YMIX))
#define PB ((bf16*)(args.ws + WS_PB))
#define MKPTRS() Ptrs P; { unsigned char* ws_ = args.ws; P.gates = (const float*)(ws_ + WS_GATES); P.barr = (float*)(ws_ + WS_BARR); P.rarr = (float*)(ws_ + WS_RARR); P.nloc = (float*)(ws_ + WS_NLOC); P.nprev = (float*)(ws_ + WS_NPREV); \
    P.garr = (float*)(ws_ + WS_GARR); P.mloc = (float*)(ws_ + WS_MLOC); P.mprev = (float*)(ws_ + WS_MPREV); P.ut = (float*)(ws_ + WS_UT); P.ct = (bf16*)(ws_ + WS_CT); \
    P.qkc = (bf16*)(ws_ + WS_XN); P.z = (bf16*)(ws_ + WS_ACTZ); P.ymix = (bf16*)(ws_ + WS_YMIX); P.conv = args.in[8]; P.gm = args.in[11]; }
    const int lo = args.ph_lo, hi = args.ph_hi;
#ifndef PH_MASK
#define PH_MASK 0xFFF
#endif
#define IN(k) (((PH_MASK >> (k)) & 1) && lo <= (k) && (k) < hi)
#define SEAM(k) do { if (IN(k) && IN((k) + 1)) { if ((k) == 0) grid.sync(); else xcd_barrier(bar); } } while (0)
    const int gw = vcu * NWAVES + wave, NGW = G * NWAVES;
    if (tid < 8) ((LAS unsigned*)(lds + 131072))[tid] = 0u;
    __syncthreads();
    XcdBarrier bar; bar.bar = (unsigned*)args.ws; bar.x = 0; bar.st = nullptr;
    if (hi - lo > 1) bar = xcd_barrier_post((unsigned*)args.ws, (volatile LAS unsigned*)(lds + 131072));

    if (IN(0)) {
        LAS float* scr = (LAS float*)(lds + wave * 16384);
        constexpr int I_GU = 16 * 88, I_D = 44 * 32, I_IN = 16 * 97, I_O = 16 * 32, I_PP = 4 * 32;
        constexpr int NITEMS = 4 * I_GU + 2 * I_D + I_IN + 2 * I_O + I_PP;
        for (int it = gw; it < NITEMS; it += NGW) {
            int r = it, wi, gi = -1, K = DM_, N = DFF, map = 0; size_t wso;
            if (r < I_GU) { wi = 3; gi = 2; wso = WS_W1GU; map = 1; }
            else if ((r -= I_GU) < I_GU) { wi = 4; gi = 2; wso = WS_W1GU; map = 2; }
            else if ((r -= I_GU) < I_D) { wi = 5; wso = WS_W1D; K = DFF; N = DM_; }
            else if ((r -= I_D) < I_IN) { wi = 7; gi = 6; wso = WS_WIN; N = 3088; map = 3; }
            else if ((r -= I_IN) < I_O) { wi = 13; wso = WS_WOUT; N = DM_; }
            else if ((r -= I_O) < I_GU) { wi = 15; gi = 14; wso = WS_W2GU; map = 1; }
            else if ((r -= I_GU) < I_GU) { wi = 16; gi = 14; wso = WS_W2GU; map = 2; }
            else if ((r -= I_GU) < I_D) { wi = 17; wso = WS_W2D; K = DFF; N = DM_; }
            else if ((r -= I_D) < I_O) { wi = 19; gi = 18; wso = WS_WPG; N = DM_; }
            else { r -= I_O; wi = 20; wso = WS_WPP; K = DPLE; N = DM_; }
            p0_transpose_item(args.in[wi], K, N, (bf16*)(args.ws + wso), map, gi >= 0 ? args.in[gi] : nullptr, scr, r, lane);
        }
        { v4u* zp = (v4u*)(WIN + (size_t)3088 * 1024); const int nz = (WIN_ROWS - 3088) * 1024 * 2 / 16;
          for (int i = bx * NTHR + tid; i < nz; i += G * NTHR) zp[i] = (v4u){0u, 0u, 0u, 0u}; }
        for (int m = gw; m < Mrows; m += NGW) {
            const f32x4* xr = (const f32x4*)(args.in[0] + (size_t)m * 1024) + lane; f32x4 v[4]; float s = 0.f;
#pragma unroll
            for (int j = 0; j < 4; ++j) { v[j] = xr[64 * j]; s += (v[j][0] * v[j][0] + v[j][1] * v[j][1]) + (v[j][2] * v[j][2] + v[j][3] * v[j][3]); }
#pragma unroll
            for (int o = 1; o < 64; o <<= 1) s += __shfl_xor(s, o);
            unsigned long long* o8 = (unsigned long long*)(XN + (size_t)m * 1024) + lane;
#pragma unroll
            for (int j = 0; j < 4; ++j) o8[64 * j] = (unsigned long long)pk2(v[j][0], v[j][1]) | ((unsigned long long)pk2(v[j][2], v[j][3]) << 32);
            if (lane < 16) SS0[(size_t)m * 16 + lane] = lane == 0 ? s : 0.f;
        }
        { const f32x4* pp = (const f32x4*)args.in[1]; unsigned long long* po = (unsigned long long*)PB; const int n4 = Mrows * DPLE / 4;
          for (int i = bx * NTHR + tid; i < n4; i += G * NTHR) { const f32x4 v = pp[i]; po[i] = (unsigned long long)pk2(v[0], v[1]) | ((unsigned long long)pk2(v[2], v[3]) << 32); } }
    }
    SEAM(0);
    if (IN(1)) { pg8::Gemm g{XN, W1GU, Mrows, 2 * DFF, DM_}; pg8::StaticOrder S; S.init(Mrows, 2 * DFF, G, bx);
        pg8::EpiSwiGLU E{ACT, SS0, DFF}; pg8::gemm_phase<pg8::EpiSwiGLU, pg8::StaticOrder, true, true>(lds, g, S, E); }
    SEAM(1);
    if (IN(2)) { pg8::Gemm g{ACT, W1D, Mrows, DM_, DFF}; pg8::StaticOrder S; S.init(Mrows, DM_, G, bx);
        pg8::EpiResid E{args.in[0], H, XN, SS1, 0.5f}; pg8::gemm_phase<pg8::EpiResid, pg8::StaticOrder, true, true>(lds, g, S, E); }
    SEAM(2);
    if (IN(3)) { pg8::Gemm g{XN, WIN, Mrows, WIN_ROWS, DM_}; pg8::StaticOrder S; S.init(Mrows, WIN_ROWS, G, bx);
        pg8::EpiZ E{Z, GATES, SS1, args.in[9], args.in[10], 0.125f * 1.4426950408889634f}; pg8::gemm_phase<pg8::EpiZ, pg8::StaticOrder, true, true>(lds, g, S, E); }
    SEAM(3);
    if (IN(4)) {
        if (wave == 7 && vcu < 64) {
            const int b = vcu >> 3, h = vcu & 7; const float* gp = GATES + ((size_t)b * SEQL + lane * 64) * 16 + 8 + h; float s = 0.f;
#pragma unroll 8
            for (int j = 0; j < 64; ++j) s += logsig_f(gp[j * 16]);
            float inc = s;
#pragma unroll
            for (int o = 1; o < 64; o <<= 1) { const float t = __shfl_up(inc, o); if (lane >= o) inc += t; }
            float run = inc - s; float* co = CLG + (size_t)vcu * SEQL + lane * 64;
#pragma unroll 8
            for (int j = 0; j < 64; ++j) { run += logsig_f(gp[j * 16]); co[j] = run * 1.4426950408889634f; }
        }
        MKPTRS();
        for (int it = vcu; it < 2048; it += G) mlstm_local_item(it, lds, P);
    }
    SEAM(4);
    if (IN(5)) {
        MKPTRS();
        const float* __restrict__ ut = P.ut; bf16* __restrict__ ct = P.ct;
        for (int eid = bx * NTHR + tid; eid < 32 * 8192; eid += G * NTHR) {
            const int bh = eid >> 13, idx = eid & 8191; float C = 0.f, m = 0.f;
            for (int c0 = 0; c0 < 64; c0 += 8) { float u[8];
#pragma unroll
                for (int j = 0; j < 8; ++j) u[j] = ut[((size_t)(bh * 64 + c0 + j) << 13) + idx];
#pragma unroll
                for (int j = 0; j < 8; ++j) { const int ci = bh * 64 + c0 + j; const float g = P.garr[ci], ml = P.mloc[ci]; const float mn = fmaxf(g + m, ml);
                    ct[((size_t)ci << 13) + idx] = (bf16)f2bf(C); if (idx == 0) P.mprev[ci] = m;
                    C = __expf(g + m - mn) * C + __expf(ml - mn) * u[j]; m = mn; } }
        }
        for (int eid = bx * NTHR + tid; eid < 32 * 64; eid += G * NTHR) {
            const int bh = eid >> 6, d = eid & 63; float n = 0.f, m = 0.f;
            for (int c = 0; c < 64; ++c) { const int ci = bh * 64 + c; const float g = P.garr[ci], ml = P.mloc[ci]; const float mn = fmaxf(g + m, ml);
                P.nprev[ci * 64 + d] = n; n = __expf(g + m - mn) * n + __expf(ml - mn) * P.nloc[ci * 64 + d]; m = mn; }
        }
    }
    SEAM(5);
    if (IN(6)) {
        { MKPTRS();
        for (int it = vcu; it < 2048; it += G) mlstm_out_item(it, lds, P); }
        __syncthreads();
        LAS float* cl = (LAS float*)(lds + 86016); int cur_bh = -1;
        const int nu = (1024 + G - 1) / G;
        for (int i = 0; i < nu; ++i) {
            int bh, qb;
            if (G == 256) { const int s = vcu & 3; bh = vcu >> 2; qb = (i == 0) ? s : (i == 1) ? 7 - s : (i == 2) ? 8 + s : 15 - s; }
            else { const int idx = i * G + vcu; if (idx >= 1024) break; bh = idx >> 4; qb = idx & 15; }
            if (bh != cur_bh) { __syncthreads();
                for (int k = tid; k < SEQL / 4; k += NTHR) *(LAS f32x4*)(cl + 4 * k) = *(const f32x4*)(CLG + (size_t)bh * SEQL + 4 * k);
                cur_bh = bh; __syncthreads(); }
            attn_body::attn_unit<8>(bh >> 3, bh & 7, qb, (const attn_body::bf16*)(Z + 1536), (const attn_body::bf16*)(Z + 2048), (const attn_body::bf16*)(Z + 2560), (attn_body::bf16*)(YMIX + 512), (char*)lds_raw, (attn_body::lds_fptr)cl, args.in[12]);
        }
    }
    SEAM(6);
    if (IN(7)) { pg8::Gemm g{YMIX, WOUT, Mrows, DM_, DM_}; pg8::StaticOrder S; S.init(Mrows, DM_, G, bx);
        pg8::EpiResid E{H, H, XN, SS2, 1.0f}; pg8::gemm_phase<pg8::EpiResid, pg8::StaticOrder, true, true>(lds, g, S, E); }
    SEAM(7);
    if (IN(8)) { pg8::Gemm g{XN, W2GU, Mrows, 2 * DFF, DM_}; pg8::StaticOrder S; S.init(Mrows, 2 * DFF, G, bx);
        pg8::EpiSwiGLU E{ACT, SS2, DFF}; pg8::gemm_phase<pg8::EpiSwiGLU, pg8::StaticOrder, true, true>(lds, g, S, E); }
    SEAM(8);
    if (IN(9)) {
        { pg8::Gemm g{ACT, W2D, Mrows, DM_, DFF}; pg8::StaticOrder S; S.init(Mrows, DM_, G, bx);
          pg8::EpiResid E{H, H, XN, SS3, 0.5f}; pg8::gemm_phase<pg8::EpiResid, pg8::StaticOrder, true, true>(lds, g, S, E); }
        { pg8::Gemm g{PB, WPP, Mrows, DM_, DPLE}; pg8::StaticOrder S; S.init(Mrows, DM_, G, bx);
          pg8::EpiProj E{PROJ, SSP}; pg8::gemm_phase<pg8::EpiProj, pg8::StaticOrder, true, true>(lds, g, S, E); }
    }
    SEAM(9);
    if (IN(10)) { pg8::Gemm g{XN, WPG, Mrows, DM_, DM_}; pg8::StaticOrder S; S.init(Mrows, DM_, G, bx);
        pg8::EpiPle E{H, PROJ, SS3, SSP, args.in[21], SS4}; pg8::gemm_phase<pg8::EpiPle, pg8::StaticOrder, true, true>(lds, g, S, E); }
    SEAM(10);
    if (IN(11)) {
        const f32x4* gf = (const f32x4*)args.in[22];
        for (int m = gw; m < Mrows; m += NGW) { const float rs = pg8::row_rstd(SS4, m); f32x4* hp = (f32x4*)(H + (size_t)m * 1024) + lane;
#pragma unroll
            for (int j = 0; j < 4; ++j) { const f32x4 v = hp[64 * j]; hp[64 * j] = v * rs * gf[64 * j + lane]; } }
    }
#undef IN
#undef SEAM
}

extern "C" void kernel_launch(void* const* d_in, const int* in_sizes, int n_in, void* d_out, int out_size, void* d_ws, size_t ws_size, hipStream_t stream) {
    static int grid = 0;
    if (grid == 0) {
        if (n_in != 23 || out_size != Mrows * DM_ || ws_size < WS_END) { fprintf(stderr, "kernel_launch: unexpected shapes (n_in %d out %d ws %zu)\n", n_in, out_size, ws_size); grid = -1; return; }
        int dev = 0, cus = 0, per_cu = 0;
        hipGetDevice(&dev); hipDeviceGetAttribute(&cus, hipDeviceAttributeMultiprocessorCount, dev);
        if (hipFuncSetAttribute((const void*)hymba_fwd, hipFuncAttributeMaxDynamicSharedMemorySize, LDS_BYTES) != hipSuccess) { fprintf(stderr, "kernel_launch: hipFuncSetAttribute failed\n"); grid = -1; return; }
        if (hipOccupancyMaxActiveBlocksPerMultiprocessor(&per_cu, (const void*)hymba_fwd, NTHR, LDS_BYTES) != hipSuccess || per_cu < 1) { fprintf(stderr, "kernel_launch: occupancy query says %d\n", per_cu); per_cu = 1; }
        (void)hipGetLastError();
        grid = cus * (per_cu > 1 ? 1 : per_cu);
    }
    if (grid < 0) return;
    if (hipMemsetAsync(d_ws, 0, 65536, stream) != hipSuccess) { fprintf(stderr, "kernel_launch: memset failed\n"); return; }
    Args a{};
    for (int i = 0; i < 23; ++i) a.in[i] = (const float*)d_in[i];
    a.out = (float*)d_out; a.ws = (unsigned char*)d_ws;
#if MK_MULTI
    for (int ph = 0; ph < NPH; ++ph) { a.ph_lo = ph; a.ph_hi = ph + 1; hipLaunchKernelGGL(hymba_fwd, dim3(grid), dim3(NTHR), LDS_BYTES, stream, a); }
#else
    a.ph_lo = 0; a.ph_hi = NPH; void* kargs[] = {&a};
    hipError_t e = hipLaunchCooperativeKernel((void*)hymba_fwd, dim3(grid), dim3(NTHR), kargs, LDS_BYTES, stream);
    if (e != hipSuccess) fprintf(stderr, "cooperative launch failed: %s (grid %d)\n", hipGetErrorString(e), grid);
#endif
}
```

```cpp
#include <hip/hip_runtime.h>
#include <hip/hip_cooperative_groups.h>
#include <hip/hip_bf16.h>
#include <cstdio>
#include <cstdint>
#include <cmath>
namespace cg = cooperative_groups;
namespace pg8 {
#define PG8_LAS __attribute__((address_space(3)))
typedef unsigned short bf16_t;
typedef short bf16x8 __attribute__((ext_vector_type(8)));
typedef float f32x4 __attribute__((ext_vector_type(4)));
typedef unsigned u32x4 __attribute__((ext_vector_type(4)));
constexpr int BM = 256, BK = 64, HALF = 128, HTB = HALF * BK * 2  , STAGE_BYTES = 8 * HTB, NXCD = 8, WGM = 8;

__host__ __device__ __forceinline__ int lds_byte(int r, int c) { const int st = (r >> 4) * 2 + (c >> 5), rr = r & 15, cc = c & 31, ob = rr * 64 + cc * 2; return st * 1024 + (ob ^ (((ob >> 9) & 1) << 5)); }
__host__ __device__ __forceinline__ void stage_rc(int b, int& R, int& C) { const int st = b / 1024, sb = b % 1024, swz = sb ^ (((sb >> 9) & 1) << 5); R = (st >> 1) * 16 + swz / 64; C = (st & 1) * 32 + (swz % 64) / 2; }
__host__ __device__ __forceinline__ int perm32(int rho) { const int n = rho >> 4, i = rho & 15; return 8 * (i >> 2) + 4 * n + (i & 3); }

struct Unit { int pm, pn; };
struct Gemm { const bf16_t* A; const bf16_t* Bt; int M, N, K; };

struct StaticOrder {
    int nM, nN, nwg, G, c;
    __host__ __device__ void init(int M, int N, int G_, int c_) { nM = M / BM; nN = N / BM; nwg = nM * nN; G = G_; c = c_; }
    __host__ __device__ bool next(int i, Unit& u) const {
        const long L = (long)i * G + c; if (L >= nwg) return false;
        int wgid = (int)L; { const int q = nwg / NXCD, r = nwg % NXCD, xcd = wgid % NXCD, off = wgid / NXCD; wgid = (xcd < r ? xcd * (q + 1) : r * (q + 1) + (xcd - r) * q) + off; }
        const int nig = WGM * nN, gid = wgid / nig, fm = gid * WGM, gsz = (nM - fm) < WGM ? (nM - fm) : WGM;
        u.pm = fm + ((wgid % nig) % gsz); u.pn = (wgid % nig) / gsz; return true;
    }
    __device__ __forceinline__ void a_ready(const Unit&) const {}
    __device__ __forceinline__ void done(const Unit&) const {}
};

__device__ __forceinline__ unsigned cvt_pk_bf16(float lo, float hi) { unsigned r; asm volatile("v_cvt_pk_bf16_f32 %0, %1, %2" : "=v"(r) : "v"(lo), "v"(hi)); return r; }
typedef float f32x2 __attribute__((ext_vector_type(2)));
typedef unsigned u32x2 __attribute__((ext_vector_type(2)));
constexpr float RMS_EPS = 1e-6f;
__device__ __forceinline__ float row_rstd(const float* __restrict__ ss, int row) {
    const f32x4* p = (const f32x4*)(ss + (size_t)row * 16);
    const f32x4 a = p[0], b = p[1], c = p[2], d = p[3];
    const float s = (((a[0] + a[1]) + (a[2] + a[3])) + ((b[0] + b[1]) + (b[2] + b[3]))) + (((c[0] + c[1]) + (c[2] + c[3])) + ((d[0] + d[1]) + (d[2] + d[3])));
    return 1.0f / sqrtf(s * (1.0f / 1024.0f) + RMS_EPS);
}
__device__ __forceinline__ float sigmoid_f(float x) { return __builtin_amdgcn_rcpf(1.0f + __builtin_amdgcn_exp2f(-1.4426950408889634f * x)); }
__device__ __forceinline__ float silu_f(float x) { return x * sigmoid_f(x); }

struct EpiSwiGLU {
    static constexpr bool PERM = true, AFTER_DRAIN = false;
    bf16_t* O; const float* ss; int ldo;
    __device__ __forceinline__ void operator()(const f32x4 (&acc)[2][2][4][2], const Unit& u, int wr, int wc, int fr, int fq) const {
        const int row0 = u.pm * BM + wr * 64 + fr, col0 = u.pn * 128 + wc * 32 + 8 * fq;
#pragma unroll
        for (int ai = 0; ai < 2; ++ai)
#pragma unroll
            for (int m = 0; m < 4; ++m) { const int row = row0 + ai * HALF + m * 16; const float rs = row_rstd(ss, row);
                const f32x4 g0 = acc[ai][0][m][0] * rs, g1 = acc[ai][0][m][1] * rs, u0 = acc[ai][1][m][0] * rs, u1 = acc[ai][1][m][1] * rs;
                u32x4 w; w.x = cvt_pk_bf16(silu_f(g0[0]) * u0[0], silu_f(g0[1]) * u0[1]); w.y = cvt_pk_bf16(silu_f(g0[2]) * u0[2], silu_f(g0[3]) * u0[3]);
                w.z = cvt_pk_bf16(silu_f(g1[0]) * u1[0], silu_f(g1[1]) * u1[1]); w.w = cvt_pk_bf16(silu_f(g1[2]) * u1[2], silu_f(g1[3]) * u1[3]);
                *(u32x4*)(O + (size_t)row * ldo + col0) = w; }
    }
};
struct EpiResid {
    static constexpr bool PERM = false, AFTER_DRAIN = false;
    const float* base; float* out; bf16_t* xn; float* sso; float coef;
    __device__ __forceinline__ void operator()(const f32x4 (&acc)[2][2][4][2], const Unit& u, int wr, int wc, int fr, int fq) const {
        const int col0 = u.pn * BM + wc * 32 + 4 * fq;
#pragma unroll
        for (int ai = 0; ai < 2; ++ai)
#pragma unroll
            for (int m = 0; m < 4; ++m) { const int row = u.pm * BM + ai * HALF + wr * 64 + m * 16 + fr; const size_t off = (size_t)row * 1024 + col0; float q = 0.f;
#pragma unroll
                for (int bj = 0; bj < 2; ++bj)
#pragma unroll
                    for (int n = 0; n < 2; ++n) { const f32x4 bs = *(const f32x4*)(base + off + bj * HALF + n * 16); const f32x4 o = bs + acc[ai][bj][m][n] * coef;
                        *(f32x4*)(out + off + bj * HALF + n * 16) = o; q += (o[0] * o[0] + o[1] * o[1]) + (o[2] * o[2] + o[3] * o[3]);
                        u32x2 w; w.x = cvt_pk_bf16(o[0], o[1]); w.y = cvt_pk_bf16(o[2], o[3]); *(u32x2*)(xn + off + bj * HALF + n * 16) = w; }
                q += __shfl_xor(q, 16); q += __shfl_xor(q, 32);
                if (fq == 0) sso[(size_t)row * 16 + u.pn * 4 + wc] = q; }
    }
};
struct EpiZ {
    static constexpr bool PERM = true, AFTER_DRAIN = false;
    bf16_t* Z; float* gates; const float* ss; const float* bm; const float* bf; float qscale;
    __device__ __forceinline__ void operator()(const f32x4 (&acc)[2][2][4][2], const Unit& u, int wr, int wc, int fr, int fq) const {
        const int row0 = u.pm * BM + wr * 64 + fr;
        if (u.pn < 12) {
            const float sc = (u.pn == 6 || u.pn == 7) ? qscale : 1.0f; const int col0 = u.pn * BM + wc * 32 + 8 * fq;
#pragma unroll
            for (int ai = 0; ai < 2; ++ai)
#pragma unroll
                for (int m = 0; m < 4; ++m) { const int row = row0 + ai * HALF + m * 16; const float rs = row_rstd(ss, row) * sc;
#pragma unroll
                    for (int bj = 0; bj < 2; ++bj) { const f32x4 v0 = acc[ai][bj][m][0] * rs, v1 = acc[ai][bj][m][1] * rs;
                        u32x4 w; w.x = cvt_pk_bf16(v0[0], v0[1]); w.y = cvt_pk_bf16(v0[2], v0[3]); w.z = cvt_pk_bf16(v1[0], v1[1]); w.w = cvt_pk_bf16(v1[2], v1[3]);
                        *(u32x4*)(Z + (size_t)row * 3072 + col0 + bj * HALF) = w; } }
        } else if (wc == 0 && fq < 2) {
            const float* bp = fq == 0 ? bm : bf; const f32x4 b0 = *(const f32x4*)bp, b1 = *(const f32x4*)(bp + 4);
#pragma unroll
            for (int ai = 0; ai < 2; ++ai)
#pragma unroll
                for (int m = 0; m < 4; ++m) { const int row = row0 + ai * HALF + m * 16; const float rs = row_rstd(ss, row);
                    *(f32x4*)(gates + (size_t)row * 16 + 8 * fq) = acc[ai][0][m][0] * rs + b0; *(f32x4*)(gates + (size_t)row * 16 + 8 * fq + 4) = acc[ai][0][m][1] * rs + b1; }
        }
    }
};
struct EpiProj {
    static constexpr bool PERM = true, AFTER_DRAIN = false;
    bf16_t* O; float* sso;
    __device__ __forceinline__ void operator()(const f32x4 (&acc)[2][2][4][2], const Unit& u, int wr, int wc, int fr, int fq) const {
        const int row0 = u.pm * BM + wr * 64 + fr, col0 = u.pn * BM + wc * 32 + 8 * fq;
#pragma unroll
        for (int ai = 0; ai < 2; ++ai)
#pragma unroll
            for (int m = 0; m < 4; ++m) { const int row = row0 + ai * HALF + m * 16; float q = 0.f;
#pragma unroll
                for (int bj = 0; bj < 2; ++bj) { const f32x4 v0 = acc[ai][bj][m][0], v1 = acc[ai][bj][m][1];
                    q += ((v0[0] * v0[0] + v0[1] * v0[1]) + (v0[2] * v0[2] + v0[3] * v0[3])) + ((v1[0] * v1[0] + v1[1] * v1[1]) + (v1[2] * v1[2] + v1[3] * v1[3]));
                    u32x4 w; w.x = cvt_pk_bf16(v0[0], v0[1]); w.y = cvt_pk_bf16(v0[2], v0[3]); w.z = cvt_pk_bf16(v1[0], v1[1]); w.w = cvt_pk_bf16(v1[2], v1[3]);
                    *(u32x4*)(O + (size_t)row * 1024 + col0 + bj * HALF) = w; }
                q += __shfl_xor(q, 16); q += __shfl_xor(q, 32);
                if (fq == 0) sso[(size_t)row * 16 + u.pn * 4 + wc] = q; }
    }
};
struct EpiPle {
    static constexpr bool PERM = false, AFTER_DRAIN = false;
    float* H; const bf16_t* proj; const float* ss3; const float* ssp; const float* gp; float* sso;
    __device__ __forceinline__ void operator()(const f32x4 (&acc)[2][2][4][2], const Unit& u, int wr, int wc, int fr, int fq) const {
        const int col0 = u.pn * BM + wc * 32 + 4 * fq;
#pragma unroll
        for (int ai = 0; ai < 2; ++ai)
#pragma unroll
            for (int m = 0; m < 4; ++m) { const int row = u.pm * BM + ai * HALF + wr * 64 + m * 16 + fr; const size_t off = (size_t)row * 1024 + col0; float q = 0.f;
                const float rs3 = row_rstd(ss3, row), rsp = row_rstd(ssp, row);
#pragma unroll
                for (int bj = 0; bj < 2; ++bj)
#pragma unroll
                    for (int n = 0; n < 2; ++n) { const int co = bj * HALF + n * 16; const f32x4 hb = *(const f32x4*)(H + off + co); const u32x2 pw = *(const u32x2*)(proj + off + co);
                        const f32x4 g = *(const f32x4*)(gp + col0 + co); const f32x4 a = acc[ai][bj][m][n] * rs3;
                        f32x4 pr; pr[0] = __uint_as_float(pw.x << 16); pr[1] = __uint_as_float(pw.x & 0xffff0000u); pr[2] = __uint_as_float(pw.y << 16); pr[3] = __uint_as_float(pw.y & 0xffff0000u);
                        f32x4 o;
#pragma unroll
                        for (int i = 0; i < 4; ++i) o[i] = hb[i] + sigmoid_f(a[i]) * (pr[i] * rsp * g[i]);
                        *(f32x4*)(H + off + co) = o; q += (o[0] * o[0] + o[1] * o[1]) + (o[2] * o[2] + o[3] * o[3]); }
                q += __shfl_xor(q, 16); q += __shfl_xor(q, 32);
                if (fq == 0) sso[(size_t)row * 16 + u.pn * 4 + wc] = q; }
    }
};

template <class Epi, class Sched, bool ALIGN_EPI = false, bool SP2 = false>
__device__ __forceinline__ void gemm_phase(PG8_LAS unsigned char* lds, const Gemm g, const Sched& S, const Epi& E) {
    const int tid = threadIdx.x, wid = __builtin_amdgcn_readfirstlane(tid >> 6), lane = tid & 63, wr = wid >> 2, wc = wid & 3, fr = lane & 15, fq = lane >> 4;
    const int K = g.K, nt = K / BK;
    unsigned voffA[2], voffB[2];
#pragma unroll
    for (int i = 0; i < 2; ++i) { int R, C; stage_rc(tid * 16 + i * 8192, R, C); const int Rb = Epi::PERM ? ((R & ~31) + perm32(R & 31)) : R;
        voffA[i] = (unsigned)(R * K + C) * 2u; voffB[i] = (unsigned)(Rb * K + C) * 2u; }
    const size_t kstep = (size_t)(BK * 2);
    const size_t hstep = (size_t)HALF * K * 2;
    const size_t tstep = 2 * hstep;
    const unsigned ldsw = (unsigned)wid * 1024u;
    const int aoff = lds_byte(wr * 64 + fr, fq * 8), boff = lds_byte(wc * 32 + fr, fq * 8);
#define PG8_SA(b, h) (((b) * 2 + (h)) * HTB)
#define PG8_SB(b, h) ((4 + (b) * 2 + (h)) * HTB)
#define PG8_STAGE(bufoff, gbase, voff) do { _Pragma("unroll") for (int _i = 0; _i < 2; ++_i) \
        __builtin_amdgcn_global_load_lds((const unsigned*)((const char*)(gbase) + (voff)[_i]), (PG8_LAS unsigned*)(lds + (bufoff) + ldsw + _i * 8192), 16, 0, 0); } while (0)
#define PG8_LDA(dst, b, h) do { _Pragma("unroll") for (int m = 0; m < 4; ++m) _Pragma("unroll") for (int k = 0; k < 2; ++k) dst[m][k] = *(const PG8_LAS bf16x8*)(lds + PG8_SA(b, h) + aoff + m * 2048 + k * 1024); } while (0)
#define PG8_LDB(dst, b, h) do { _Pragma("unroll") for (int n = 0; n < 2; ++n) _Pragma("unroll") for (int k = 0; k < 2; ++k) dst[n][k] = *(const PG8_LAS bf16x8*)(lds + PG8_SB(b, h) + boff + n * 2048 + k * 1024); } while (0)
#define PG8_MMA(ai, bj, At, Bt) do { __builtin_amdgcn_s_setprio(1); _Pragma("unroll") for (int m = 0; m < 4; ++m) _Pragma("unroll") for (int n = 0; n < 2; ++n) _Pragma("unroll") for (int k = 0; k < 2; ++k) \
        acc[ai][bj][m][n] = __builtin_amdgcn_mfma_f32_16x16x32_bf16(Bt[n][k], At[m][k], acc[ai][bj][m][n], 0, 0, 0); __builtin_amdgcn_s_setprio(0); } while (0)
#define PG8_WAIT_V(n) asm volatile("s_waitcnt vmcnt(" #n ")" ::: "memory")
#define PG8_WAIT_L(n) asm volatile("s_waitcnt lgkmcnt(" #n ")" ::: "memory")
#define PG8_BAR __builtin_amdgcn_s_barrier()
#define PG8_SCHED __builtin_amdgcn_sched_barrier(0)
    Unit cur, nxt; int ui = 0;
    if (!S.next(0, cur)) return;
    f32x4 acc[2][2][4][2];
#pragma unroll
    for (int a = 0; a < 2; ++a)
#pragma unroll
        for (int b = 0; b < 2; ++b)
#pragma unroll
            for (int m = 0; m < 4; ++m)
#pragma unroll
                for (int n = 0; n < 2; ++n) acc[a][b][m][n] = (f32x4){0.f, 0.f, 0.f, 0.f};
    bf16x8 At[4][2], B0[2][2], B1[2][2];
    const char* cA = (const char*)g.A + (size_t)cur.pm * tstep; const char* cB = (const char*)g.Bt + (size_t)cur.pn * tstep;
    S.a_ready(cur);
    if constexpr (SP2) {
        PG8_STAGE(PG8_SB(0, 0), cB, voffB); PG8_STAGE(PG8_SB(0, 1), cB + hstep, voffB); PG8_STAGE(PG8_SA(0, 0), cA, voffA); PG8_STAGE(PG8_SA(0, 1), cA + hstep, voffA);
        if (wr == 1) PG8_BAR;
        PG8_WAIT_V(2); PG8_BAR;
        PG8_STAGE(PG8_SB(1, 0), cB + kstep, voffB); PG8_STAGE(PG8_SA(1, 0), cA + kstep, voffA); PG8_STAGE(PG8_SB(1, 1), cB + hstep + kstep, voffB);
        PG8_WAIT_V(6); PG8_BAR;
    } else {
        PG8_STAGE(PG8_SB(0, 0), cB, voffB); PG8_STAGE(PG8_SA(0, 0), cA, voffA); PG8_STAGE(PG8_SB(0, 1), cB + hstep, voffB); PG8_STAGE(PG8_SA(0, 1), cA + hstep, voffA);
        if (wr == 1) PG8_BAR;
        PG8_WAIT_V(4); PG8_BAR;
        PG8_STAGE(PG8_SB(1, 0), cB + kstep, voffB); PG8_STAGE(PG8_SA(1, 0), cA + kstep, voffA); PG8_STAGE(PG8_SB(1, 1), cB + hstep + kstep, voffB);
        PG8_WAIT_V(6); PG8_BAR;
    }
    for (;;) {
        const bool has_next = S.next(ui + 1, nxt);
        const char* nA = has_next ? (const char*)g.A + (size_t)nxt.pm * tstep : cA; const char* nB = has_next ? (const char*)g.Bt + (size_t)nxt.pn * tstep : cB;
        for (int t = 0; t < nt; t += 2) {
            const bool last = (t == nt - 2);
            const char* a1 = cA + (size_t)(t + 1) * kstep;
            const char* a2 = last ? nA : cA + (size_t)(t + 2) * kstep; const char* b2 = last ? nB : cB + (size_t)(t + 2) * kstep;
            const char* a3 = a2 + kstep; const char* b3 = b2 + kstep;
            if (last && has_next) S.a_ready(nxt);
            if constexpr (SP2) {
            PG8_LDB(B0, 0, 0); PG8_LDB(B1, 0, 1); PG8_SCHED; PG8_LDA(At, 0, 0); PG8_STAGE(PG8_SA(1, 1), a1 + hstep, voffA);
            PG8_WAIT_V(8); PG8_WAIT_L(0); PG8_BAR; PG8_MMA(0, 0, At, B0); PG8_MMA(0, 1, At, B1); PG8_BAR; PG8_SCHED;
            PG8_LDA(At, 0, 1); PG8_STAGE(PG8_SB(0, 0), b2, voffB); PG8_STAGE(PG8_SB(0, 1), b2 + hstep, voffB); PG8_STAGE(PG8_SA(0, 0), a2, voffA);
            PG8_WAIT_V(8); PG8_WAIT_L(0); PG8_BAR; PG8_MMA(1, 0, At, B0); PG8_MMA(1, 1, At, B1); PG8_BAR; PG8_SCHED;
            PG8_LDB(B0, 1, 0); PG8_LDB(B1, 1, 1); PG8_SCHED; PG8_LDA(At, 1, 0); PG8_STAGE(PG8_SA(0, 1), a2 + hstep, voffA);
            PG8_WAIT_V(8); PG8_WAIT_L(0); PG8_BAR; PG8_MMA(0, 0, At, B0); PG8_MMA(0, 1, At, B1); PG8_BAR; PG8_SCHED;
            PG8_LDA(At, 1, 1); PG8_STAGE(PG8_SB(1, 0), b3, voffB); PG8_STAGE(PG8_SB(1, 1), b3 + hstep, voffB); PG8_STAGE(PG8_SA(1, 0), a3, voffA);
            PG8_WAIT_V(8); PG8_WAIT_L(0); PG8_BAR; PG8_MMA(1, 0, At, B0); PG8_MMA(1, 1, At, B1); PG8_BAR; PG8_SCHED;
            } else {
            PG8_LDB(B0, 0, 0); PG8_SCHED; PG8_LDA(At, 0, 0); PG8_STAGE(PG8_SA(1, 1), a1 + hstep, voffA);
            PG8_WAIT_L(8); PG8_BAR; PG8_WAIT_L(0); PG8_MMA(0, 0, At, B0); PG8_BAR; PG8_SCHED;
            PG8_LDB(B1, 0, 1); PG8_STAGE(PG8_SB(0, 0), b2, voffB);
            PG8_BAR; PG8_WAIT_L(0); PG8_MMA(0, 1, At, B1); PG8_BAR;
            PG8_LDA(At, 0, 1); PG8_STAGE(PG8_SA(0, 0), a2, voffA);
            PG8_BAR; PG8_WAIT_L(0); PG8_MMA(1, 0, At, B0); PG8_BAR; PG8_SCHED;
            PG8_STAGE(PG8_SB(0, 1), b2 + hstep, voffB);
            PG8_WAIT_V(6); PG8_BAR; PG8_MMA(1, 1, At, B1); PG8_BAR;
            PG8_LDB(B0, 1, 0); PG8_SCHED; PG8_LDA(At, 1, 0); PG8_STAGE(PG8_SA(0, 1), a2 + hstep, voffA);
            PG8_WAIT_L(8); PG8_BAR; PG8_WAIT_L(0); PG8_MMA(0, 0, At, B0); PG8_BAR; PG8_SCHED;
            PG8_LDB(B1, 1, 1); PG8_STAGE(PG8_SB(1, 0), b3, voffB);
            PG8_BAR; PG8_WAIT_L(0); PG8_MMA(0, 1, At, B1); PG8_BAR;
            PG8_LDA(At, 1, 1); PG8_STAGE(PG8_SA(1, 0), a3, voffA);
            PG8_BAR; PG8_WAIT_L(0); PG8_MMA(1, 0, At, B0); PG8_BAR; PG8_SCHED;
            PG8_STAGE(PG8_SB(1, 1), b3 + hstep, voffB);
            PG8_WAIT_V(6); PG8_BAR; PG8_MMA(1, 1, At, B1); PG8_BAR;
            }
        }
        if constexpr (ALIGN_EPI) { if (wr == 0) PG8_BAR; }
        if constexpr (!Epi::AFTER_DRAIN) { E(acc, cur, wr, wc, fr, fq); S.done(cur); }
        if (!has_next) break;
#pragma unroll
        for (int a = 0; a < 2; ++a)
#pragma unroll
            for (int b = 0; b < 2; ++b)
#pragma unroll
                for (int m = 0; m < 4; ++m)
#pragma unroll
                    for (int n = 0; n < 2; ++n) acc[a][b][m][n] = (f32x4){0.f, 0.f, 0.f, 0.f};
        cur = nxt; cA = nA; cB = nB; ++ui;
        if constexpr (ALIGN_EPI) { if (wr == 1) PG8_BAR; }
    }
    PG8_WAIT_V(0);
    if constexpr (!ALIGN_EPI) { if (wr == 0) PG8_BAR; }
    PG8_BAR;
    if constexpr (Epi::AFTER_DRAIN) { E.fused(acc, cur, wr, wc, fr, fq, lds, wid, lane); S.done(cur); }
#undef PG8_SA
#undef PG8_SB
#undef PG8_STAGE
#undef PG8_LDA
#undef PG8_LDB
#undef PG8_MMA
#undef PG8_WAIT_V
#undef PG8_WAIT_L
#undef PG8_BAR
#undef PG8_SCHED
}
}

#ifndef PG8_SP2
#define PG8_SP2 true
#endif
#include <hip/hip_bf16.h>
#include <cmath>
namespace attn_body {
using bf16=__hip_bfloat16;
using bf16x8=__attribute__((ext_vector_type(8)))short;
using s16x4=__attribute__((ext_vector_type(4)))short;
using f32x16=__attribute__((ext_vector_type(16)))float;
using u32x4=__attribute__((ext_vector_type(4)))unsigned;
constexpr int BATCH=8,NHEAD=8,SEQ=4096,D=64,DM=3072,OPITCH=1024;
constexpr int NW=8,QBLK=32,QB=QBLK*NW,KVBLK=64,NQB=SEQ/QB;
constexpr int ATTN_PITCH=DM, ATTN_UNIT_ROWS=QB;
__device__ __forceinline__ int crow(int r,int hi){return (r&3)+8*(r>>2)+4*hi;}
#define SBAR() __builtin_amdgcn_sched_barrier(0)
__device__ __forceinline__ void cmask(f32x16&p0,f32x16&p1,int jb,int qrel,int hi){
  const float NEG=-INFINITY; int kb=64*jb+4*hi;
  #pragma unroll
  for(int r=0;r<16;++r){int kv=kb+(r&3)+8*(r>>2); if(kv>qrel)p0[r]=NEG; if(kv+32>qrel)p1[r]=NEG;}
}

constexpr int NSLOT=3, SLOTB=8192;
constexpr int LDS_K=0, LDS_V=NSLOT*SLOTB, LDS_WS=2*NSLOT*SLOTB, LDS_OST=LDS_WS+NW*64*4, LDS_BYTES=LDS_OST+NW*4096;
constexpr float C2=0.125f*1.4426950408889634f;
__device__ __forceinline__ void glds16(const void*gsrc,unsigned lds_dst){unsigned keep;
  asm volatile("s_mov_b32 %0, m0\n\ts_mov_b32 m0, %2\n\ts_nop 0\n\tglobal_load_lds_dwordx4 %1, off\n\ts_mov_b32 m0, %0":"=&s"(keep):"v"(gsrc),"s"(lds_dst):"memory");}
__device__ __forceinline__ float max3f(float a,float b,float c){float r;asm("v_max3_f32 %0, %1, %2, %3":"=v"(r):"v"(a),"v"(b),"v"(c));return r;}
__device__ __forceinline__ float max2f(float a,float b){float r;asm("v_max_f32_e32 %0, %1, %2":"=v"(r):"v"(a),"v"(b));return r;}
__device__ __forceinline__ float fadd_s(float a,float b){float r;asm("v_add_f32_e32 %0, %1, %2":"=v"(r):"v"(a),"v"(b));return r;}
__device__ __forceinline__ float fsub_s(float a,float b){float r;asm("v_sub_f32_e32 %0, %1, %2":"=v"(r):"v"(a),"v"(b));return r;}
typedef float f32x2_t __attribute__((ext_vector_type(2))); typedef float f32x4_t __attribute__((ext_vector_type(4))); typedef __bf16 bf16x2_t __attribute__((ext_vector_type(2)));
__device__ __forceinline__ unsigned cvtpk_s(float lo,float hi){f32x2_t v={lo,hi};bf16x2_t b=__builtin_convertvector(v,bf16x2_t);return __builtin_bit_cast(unsigned,b);}
#define WAIT_BAR(N) asm volatile("s_waitcnt vmcnt(" #N ") lgkmcnt(0)\n\ts_barrier":::"memory")

__device__ __forceinline__ void qkt(f32x16&p0,f32x16&p1,const char*Kslot,const bf16x8*qr,int r32,int hi){
  const char*kb=Kslot+hi*1024+r32*16;
  #pragma unroll
  for(int d0=0;d0<4;++d0){
    const bf16x8 b0=*reinterpret_cast<const bf16x8*>(kb+d0*2048);
    const bf16x8 b1=*reinterpret_cast<const bf16x8*>(kb+d0*2048+512);
    p0=__builtin_amdgcn_mfma_f32_32x32x16_bf16(b0,qr[d0],p0,0,0,0);p1=__builtin_amdgcn_mfma_f32_32x32x16_bf16(b1,qr[d0],p1,0,0,0);}
}
typedef __attribute__((address_space(3))) const char* lds_cptr;
typedef short v4i16_t __attribute__((ext_vector_type(4)));
__device__ __forceinline__ void kload8(bf16x8*kf,lds_cptr kp){
  kf[0]=*(const __attribute__((address_space(3))) bf16x8*)(kp);      kf[1]=*(const __attribute__((address_space(3))) bf16x8*)(kp+512);
  kf[2]=*(const __attribute__((address_space(3))) bf16x8*)(kp+2048); kf[3]=*(const __attribute__((address_space(3))) bf16x8*)(kp+2560);
  kf[4]=*(const __attribute__((address_space(3))) bf16x8*)(kp+4096); kf[5]=*(const __attribute__((address_space(3))) bf16x8*)(kp+4608);
  kf[6]=*(const __attribute__((address_space(3))) bf16x8*)(kp+6144); kf[7]=*(const __attribute__((address_space(3))) bf16x8*)(kp+6656);
}
__device__ __forceinline__ void kload2(bf16x8*kf,lds_cptr kp,int j){ kf[2*j]=*(const __attribute__((address_space(3))) bf16x8*)(kp+j*2048); kf[2*j+1]=*(const __attribute__((address_space(3))) bf16x8*)(kp+j*2048+512); }
__device__ __forceinline__ s16x4 vtr(lds_cptr p){ return __builtin_bit_cast(s16x4,__builtin_amdgcn_ds_read_tr16_b64_v4i16((__attribute__((address_space(3))) v4i16_t*)p)); }
__device__ __forceinline__ float rowmax(const f32x16&p0,const f32x16&p1){
  float a=max3f(p0[0],p0[1],p1[0]),b=max3f(p0[2],p0[3],p1[1]);a=max3f(a,p1[2],p1[3]);
  #pragma unroll
  for(int r=4;r<16;r+=4){a=max3f(a,p0[r],p0[r+1]);b=max3f(b,p0[r+2],p0[r+3]);a=max3f(a,p1[r],p1[r+1]);b=max3f(b,p1[r+2],p1[r+3]);}
  const float m=max2f(a,b);
  auto rr=__builtin_amdgcn_permlane32_swap(__float_as_uint(m),__float_as_uint(m),false,false);
  return max2f(__uint_as_float(rr[0]),__uint_as_float(rr[1]));
}
__device__ __forceinline__ void pv(f32x16*o,int vb,bf16x8 pa0,bf16x8 pa1,bf16x8 pa2,bf16x8 pa3){
  #pragma unroll
  for(int d0=0;d0<2;++d0){s16x4 lo[4],hi[4];
    #pragma unroll
    for(int ks=0;ks<4;++ks){
      asm volatile("ds_read_b64_tr_b16 %0,%1 offset:%c2":"=&v"(lo[ks]):"v"(vb),"i"(d0*4096+ks*1024):"memory");
      asm volatile("ds_read_b64_tr_b16 %0,%1 offset:%c2":"=&v"(hi[ks]):"v"(vb),"i"(d0*4096+ks*1024+512):"memory");}
    asm volatile("s_waitcnt lgkmcnt(0)":::"memory");SBAR();
    #define PK(k) (bf16x8){lo[k][0],lo[k][1],lo[k][2],lo[k][3],hi[k][0],hi[k][1],hi[k][2],hi[k][3]}
    o[d0]=__builtin_amdgcn_mfma_f32_32x32x16_bf16(pa0,PK(0),o[d0],0,0,0);
    o[d0]=__builtin_amdgcn_mfma_f32_32x32x16_bf16(pa1,PK(1),o[d0],0,0,0);
    o[d0]=__builtin_amdgcn_mfma_f32_32x32x16_bf16(pa2,PK(2),o[d0],0,0,0);
    o[d0]=__builtin_amdgcn_mfma_f32_32x32x16_bf16(pa3,PK(3),o[d0],0,0,0);
    #undef PK
  }
}

#ifndef ATTN_STORE16
#define ATTN_STORE16(p,v) (*(u32x4*)(p)=(v))
#endif
typedef __attribute__((address_space(3))) const float* lds_fptr; typedef __attribute__((address_space(3))) const f32x4_t* lds_f4ptr;
template<int THRL> __device__ __forceinline__ void attn_unit(int b,int h,int qb,const bf16*Q,const bf16*__restrict__ K,const bf16*__restrict__ V,bf16*O,char*shm,lds_fptr cl,const float*__restrict__ gain){
  const int tid=threadIdx.x,lane=tid&63,r32=lane&31,hi=lane>>5; const int wid=__builtin_amdgcn_readfirstlane(tid>>6);
  const long rowbase=(long)b*SEQ; const int q0=qb*QB;
  const bf16*Qw=Q+(rowbase+q0+wid*QBLK)*DM+h*D;
  const bf16*Kh=K+rowbase*DM+h*D,*Vh=V+rowbase*DM+h*D;
  const unsigned lds0=(unsigned)(uintptr_t)shm;
  float*wsf=(float*)(shm+LDS_WS)+wid*64;
  const bf16*ksrc=Kh+(long)lane*DM+wid*8;
  const bf16*vsrc=Vh+(long)(16*(wid&3)+(lane>>2))*DM+(wid>>2)*32+(lane&3)*8;
  const unsigned kdst=lds0+LDS_K+wid*1024, vdst=lds0+LDS_V+wid*1024;
  #define DMA_K(t,slot) glds16(ksrc+(long)(t)*KVBLK*DM,(unsigned)__builtin_amdgcn_readfirstlane(kdst+(slot)))
  #define DMA_V(t,slot) glds16(vsrc+(long)(t)*KVBLK*DM,(unsigned)__builtin_amdgcn_readfirstlane(vdst+(slot)))
  const int vb0=(int)(lds0+LDS_V)+((lane>>4)&1)*32+(lane&3)*8+(4*hi+((lane&15)>>2))*64;
  const char*Kbase=shm+LDS_K; bf16x8 kf[8];
  const lds_cptr shm3=(lds_cptr)shm; const lds_cptr kp0=shm3+LDS_K+hi*1024+r32*16; const lds_cptr vp0=shm3+LDS_V+((lane>>4)&1)*32+(lane&3)*8+(4*hi+((lane&15)>>2))*64;
  const int NT=(q0+QB)/KVBLK;
  DMA_K(0,0);DMA_V(0,0);DMA_K(1,SLOTB);
  bf16x8 qr[4];
  #pragma unroll
  for(int d0=0;d0<4;++d0)qr[d0]=*reinterpret_cast<const bf16x8*>(&Qw[(long)r32*DM+d0*16+hi*8]);
  float l_reg=0.f;f32x16 o[2];o[0]=f32x16{};o[1]=f32x16{};
  const int qrel=wid*QBLK+r32;
  float aq=cl[q0+qrel];
  #define CINIT(C0,C1,t) do{ const lds_f4ptr cp_=(lds_f4ptr)(cl+64*(t)+4*hi); _Pragma("unroll") for(int j_=0;j_<4;++j_){ const f32x4_t v0_=cp_[2*j_],v1_=cp_[8+2*j_]; _Pragma("unroll") for(int i_=0;i_<4;++i_){ C0[4*j_+i_]=aq-v0_[i_]; C1[4*j_+i_]=aq-v1_[i_]; } } }while(0)
  #define CMASK(P0,P1,t) do{int jb_=(t)-(NT-4); if(jb_>=0)cmask(P0,P1,jb_,qrel,hi);}while(0)
  bool resc=false;
  #define START(P0,P1) do{ const float rm=rowmax(P0,P1); resc=false; \
    { const float dl=__builtin_fmaxf(rm,0.f);     aq=fsub_s(aq,dl); \
      _Pragma("unroll") for(int r=0;r<16;++r){P0[r]=fsub_s(P0[r],dl);P1[r]=fsub_s(P1[r],dl);} } \
    _Pragma("unroll") for(int r=0;r<16;++r)P0[r]=__builtin_amdgcn_exp2f(P0[r]); }while(0)
  #define RESC() do{ if(resc){ asm volatile("s_waitcnt lgkmcnt(0)":::"memory"); \
      _Pragma("unroll") for(int d_=0;d_<2;++d_) _Pragma("unroll") for(int r=0;r<16;++r)o[d_][r]*=wsf[crow(r,hi)]; } }while(0)
  f32x16 pA0,pA1,pB0,pB1;
  int sl_prev=0,sl_cur=0,sl_next=SLOTB;
  #define ROT() do{sl_prev=sl_cur;sl_cur=sl_next;sl_next=(sl_next==(NSLOT-1)*SLOTB)?0:sl_next+SLOTB;}while(0)
  DMA_K(2,2*SLOTB);
  WAIT_BAR(3);
  CINIT(pA0,pA1,0);qkt(pA0,pA1,Kbase,qr,r32,hi);asm volatile("s_nop 15\n\ts_nop 7":"+v"(pA0),"+v"(pA1));CMASK(pA0,pA1,0);
  START(pA0,pA1);
  _Pragma("unroll") for(int r=0;r<16;++r)pA1[r]=__builtin_amdgcn_exp2f(pA1[r]);
  WAIT_BAR(0);
  DMA_K(3,0);DMA_V(1,SLOTB);
  ROT();
  kload8(kf,kp0+sl_cur);
  WAIT_BAR(2);
  s16x4 vlo[8],vhi[8]; u32x4 pw0,pw1,pw2,pw3;
  #define PKW(P,B) cvtpk_s(P[B],P[B+1])
  #define PAF(k) __builtin_bit_cast(bf16x8,pw##k)
  #define VFR(i) (bf16x8){vlo[i][0],vlo[i][1],vlo[i][2],vlo[i][3],vhi[i][0],vhi[i][1],vhi[i][2],vhi[i][3]}
  #define PIN(x) asm volatile("":"+v"(x))
  #define MX3(a,b,c) __builtin_fmaxf(__builtin_fmaxf((a),(b)),(c))
  #define GAPA(MF,A0,A1,A2,A3,W0,W1,PW) do{ MF; sacc+=A0; sacc+=A1; sacc+=A2; sacc+=A3; PIN(sacc); W0; W1; PIN(PW); SBAR(); }while(0)
  #define EX(v) __builtin_amdgcn_exp2f(v)
  #define GAPB(MF,X,B) do{ MF; X[B]=EX(X[B]); X[B+1]=EX(X[B+1]); X[B+2]=EX(X[B+2]); X[B+3]=EX(X[B+3]); PIN(X); SBAR(); }while(0)
  #define VRD(i) do{ vlo[i]=vtr(vp_+(((i)>>2)*4096+((i)&3)*1024)); vhi[i]=vtr(vp_+(((i)>>2)*4096+((i)&3)*1024+512)); }while(0)
  #define KRD(G,j) do{ if(G){ kload2(kf,kp0+sl_next,j); SBAR(); } }while(0)
  #define STEP(C0,C1,P0,P1,t,GK,GV,GL) do{ SBAR(); CINIT(C0,C1,t); SBAR(); \
    const lds_cptr vp_=vp0+sl_prev; \
    VRD(0); SBAR(); float sacc=(P0[0]+P0[1]); \
    GAPA(C0=__builtin_amdgcn_mfma_f32_32x32x16_bf16(kf[0],qr[0],C0,0,0,0), P0[2],P0[3],P0[4],P0[5],     pw0[0]=PKW(P0,0), pw0[1]=PKW(P0,2), pw0); \
    VRD(4); SBAR(); GAPA(C1=__builtin_amdgcn_mfma_f32_32x32x16_bf16(kf[1],qr[0],C1,0,0,0), P0[6],P0[7],P0[8],P0[9],     pw0[2]=PKW(P0,4), pw0[3]=PKW(P0,6), pw0); \
    VRD(1); SBAR(); GAPA(C0=__builtin_amdgcn_mfma_f32_32x32x16_bf16(kf[2],qr[1],C0,0,0,0),   P0[10],P0[11],P0[12],P0[13], pw1[0]=PKW(P0,8), pw1[1]=PKW(P0,10), pw1); \
    VRD(5); SBAR(); GAPA(C1=__builtin_amdgcn_mfma_f32_32x32x16_bf16(kf[3],qr[1],C1,0,0,0),   P0[14],P0[15],P1[0],P1[1],   pw1[2]=PKW(P0,12),pw1[3]=PKW(P0,14), pw1); \
    VRD(2); SBAR(); GAPA(C0=__builtin_amdgcn_mfma_f32_32x32x16_bf16(kf[4],qr[2],C0,0,0,0),   P1[2],P1[3],P1[4],P1[5],     pw2[0]=PKW(P1,0), pw2[1]=PKW(P1,2), pw2); \
    VRD(6); SBAR(); GAPA(C1=__builtin_amdgcn_mfma_f32_32x32x16_bf16(kf[5],qr[2],C1,0,0,0),   P1[6],P1[7],P1[8],P1[9],     pw2[2]=PKW(P1,4), pw2[3]=PKW(P1,6), pw2); \
    VRD(3); SBAR(); GAPA(C0=__builtin_amdgcn_mfma_f32_32x32x16_bf16(kf[6],qr[3],C0,0,0,0),   P1[10],P1[11],P1[12],P1[13], pw3[0]=PKW(P1,8), pw3[1]=PKW(P1,10), pw3); \
    VRD(7); SBAR(); GAPA(C1=__builtin_amdgcn_mfma_f32_32x32x16_bf16(kf[7],qr[3],C1,0,0,0),   P1[14],P1[15],0.f,0.f,       pw3[2]=PKW(P1,12),pw3[3]=PKW(P1,14), pw3); \
    l_reg+=sacc; \
    if(GK){DMA_K((t)+3,sl_cur);} if(GV){DMA_V((t)+1,sl_next);} \
    CMASK(C0,C1,t); \
    { float a=MX3(C0[0],C0[1],C1[0]),b=MX3(C0[2],C0[3],C1[1]); a=MX3(a,C1[2],C1[3]); \
      _Pragma("unroll") for(int r=4;r<16;r+=4){a=MX3(a,C0[r],C0[r+1]);b=MX3(b,C0[r+2],C0[r+3]);a=MX3(a,C1[r],C1[r+1]);b=MX3(b,C1[r+2],C1[r+3]);} \
      float rm=__builtin_fmaxf(a,b); { auto rr=__builtin_amdgcn_permlane32_swap(__float_as_uint(rm),__float_as_uint(rm),false,false); rm=__builtin_fmaxf(__uint_as_float(rr[0]),__uint_as_float(rr[1])); } \
      resc=false; \
      if(__builtin_expect(__any(rm>(float)THRL),0)){ const float dl=__builtin_fmaxf(rm,0.f); aq-=dl; \
        _Pragma("unroll") for(int r=0;r<16;++r){C0[r]-=dl;C1[r]-=dl;} \
        const float f=__builtin_amdgcn_exp2f(-dl); l_reg*=f; if(hi==0)wsf[r32]=f; resc=true; } } \
    SBAR(); \
    GAPB(o[0]=__builtin_amdgcn_mfma_f32_32x32x16_bf16(PAF(0),VFR(0),o[0],0,0,0), C0,0); \
    GAPB(o[1]=__builtin_amdgcn_mfma_f32_32x32x16_bf16(PAF(0),VFR(4),o[1],0,0,0), C0,4); \
    KRD(GL,0); GAPB(o[0]=__builtin_amdgcn_mfma_f32_32x32x16_bf16(PAF(1),VFR(1),o[0],0,0,0), C0,8); \
    KRD(GL,1); GAPB(o[1]=__builtin_amdgcn_mfma_f32_32x32x16_bf16(PAF(1),VFR(5),o[1],0,0,0), C0,12); \
    KRD(GL,2); GAPB(o[0]=__builtin_amdgcn_mfma_f32_32x32x16_bf16(PAF(2),VFR(2),o[0],0,0,0), C1,0); \
    KRD(GL,3); GAPB(o[1]=__builtin_amdgcn_mfma_f32_32x32x16_bf16(PAF(2),VFR(6),o[1],0,0,0), C1,4); \
    GAPB(o[0]=__builtin_amdgcn_mfma_f32_32x32x16_bf16(PAF(3),VFR(3),o[0],0,0,0), C1,8); \
    GAPB(o[1]=__builtin_amdgcn_mfma_f32_32x32x16_bf16(PAF(3),VFR(7),o[1],0,0,0), C1,12); \
    }while(0)
  int t=1;
  #undef CMASK
  #define CMASK(P0,P1,t) do{}while(0)
  for(;t+5<NT;t+=2){
    STEP(pB0,pB1,pA0,pA1,t,true,true,true);     WAIT_BAR(2); RESC(); ROT();
    STEP(pA0,pA1,pB0,pB1,t+1,true,true,true);   WAIT_BAR(2); RESC(); ROT();
  }
  #undef CMASK
  #define CMASK(P0,P1,t) do{int jb_=(t)-(NT-4); if(jb_>=0)cmask(P0,P1,jb_,qrel,hi);}while(0)
  #define ENDW(tt) do{ if((tt)+3<NT){WAIT_BAR(2);} else if((tt)+2<NT){WAIT_BAR(1);} else {WAIT_BAR(0);} }while(0)
  for(;t+1<NT;t+=2){
    STEP(pB0,pB1,pA0,pA1,t,(t+3<NT),(t+1<NT),(t+1<NT));       ENDW(t);   RESC(); ROT();
    STEP(pA0,pA1,pB0,pB1,t+1,(t+4<NT),(t+2<NT),(t+2<NT));     ENDW(t+1); RESC(); ROT();
  }
  STEP(pB0,pB1,pA0,pA1,NT-1,false,false,false); RESC();
  { float sacc=pB0[0]+pB0[1]; _Pragma("unroll") for(int r=2;r<16;++r)sacc+=pB0[r]; _Pragma("unroll") for(int r=0;r<16;++r)sacc+=pB1[r]; l_reg+=sacc;
    pw0=(u32x4){PKW(pB0,0),PKW(pB0,2),PKW(pB0,4),PKW(pB0,6)};pw1=(u32x4){PKW(pB0,8),PKW(pB0,10),PKW(pB0,12),PKW(pB0,14)};pw2=(u32x4){PKW(pB1,0),PKW(pB1,2),PKW(pB1,4),PKW(pB1,6)};pw3=(u32x4){PKW(pB1,8),PKW(pB1,10),PKW(pB1,12),PKW(pB1,14)};
    SBAR(); pv(o,vb0+sl_cur,PAF(0),PAF(1),PAF(2),PAF(3)); }
  #undef PKW
  #undef PAF
  #undef VFR
  #undef PIN
  #undef MX3
  #undef GAPA
  #undef GAPB
  #undef EX
  #undef VRD
  #undef KRD
  #undef STEP
  #undef ENDW
  {auto rr=__builtin_amdgcn_permlane32_swap(__float_as_uint(l_reg),__float_as_uint(l_reg),false,false);l_reg=__uint_as_float(rr[0])+__uint_as_float(rr[1]);}
  if(hi==0)wsf[32+r32]=l_reg;asm volatile("s_waitcnt lgkmcnt(0)":::"memory");
  float rli[16];
  #pragma unroll
  for(int r=0;r<16;++r)rli[r]=__builtin_amdgcn_rcpf(wsf[32+crow(r,hi)]);
  bf16*Ow=O+(rowbase+q0+wid*QBLK)*OPITCH+h*D;
  { bf16*stg=(bf16*)(shm+LDS_OST)+wid*2048;
    #pragma unroll
    for(int r=0;r<16;++r){const int orow=crow(r,hi);
      #pragma unroll
      for(int d0=0;d0<2;++d0)stg[orow*64+d0*32+r32]=__float2bfloat16(o[d0][r]*rli[r]);}
    asm volatile("s_waitcnt lgkmcnt(0)":::"memory");
    #pragma unroll
    for(int i=0;i<4;++i){const int row=i*8+(lane>>3),ch=lane&7; const u32x4 v=*(const u32x4*)(stg+row*64+ch*8);
      float x[8]; _Pragma("unroll") for(int k=0;k<4;++k){x[2*k]=__uint_as_float(v[k]<<16);x[2*k+1]=__uint_as_float(v[k]&0xffff0000u);}
      float ss=0.f; _Pragma("unroll") for(int k=0;k<8;++k)ss+=x[k]*x[k];
      ss+=__shfl_xor(ss,1);ss+=__shfl_xor(ss,2);ss+=__shfl_xor(ss,4);
      const float rs=1.0f/sqrtf(ss*(1.0f/64.0f)+1e-6f); const f32x4_t g0=*(const f32x4_t*)(gain+h*D+ch*8),g1=*(const f32x4_t*)(gain+h*D+ch*8+4);
      u32x4 w; w[0]=cvtpk_s(x[0]*rs*g0[0],x[1]*rs*g0[1]);w[1]=cvtpk_s(x[2]*rs*g0[2],x[3]*rs*g0[3]);w[2]=cvtpk_s(x[4]*rs*g1[0],x[5]*rs*g1[1]);w[3]=cvtpk_s(x[6]*rs*g1[2],x[7]*rs*g1[3]);
      ATTN_STORE16(Ow+(long)row*OPITCH+ch*8,w);} }
  asm volatile("s_waitcnt lgkmcnt(0)\n\ts_barrier":::"memory");
  #undef DMA_K
  #undef DMA_V
  #undef CMASK
  #undef START
  #undef CINIT
  #undef RESC
  #undef ROT
}
constexpr int ATTN_LDS_BYTES=LDS_BYTES;
#undef SBAR
#undef WAIT_BAR
}
#ifndef MK_MULTI
#define MK_MULTI 0
#endif
constexpr int NWAVES = 8, NTHR = 512;
constexpr int Mrows = 32768, DM_ = 1024, DFF = 2816, SEQL = 4096, DPLE = 256;
constexpr int NPH = 12;
constexpr size_t MiB = 1u << 20;
constexpr size_t WS_W1GU = 2 * MiB, WS_W1D = 14 * MiB, WS_WIN = 20 * MiB, WS_WOUT = 27 * MiB, WS_W2GU = 30 * MiB, WS_W2D = 42 * MiB, WS_WPG = 48 * MiB, WS_WPP = 50 * MiB;
constexpr size_t WS_GATES = 52 * MiB, WS_CL = 54 * MiB, WS_BARR = 55 * MiB, WS_RARR = 55 * MiB + 512 * 1024, WS_NLOC = 56 * MiB, WS_NPREV = 56 * MiB + 512 * 1024;
constexpr size_t WS_GARR = 57 * MiB, WS_MLOC = 57 * MiB + 65536, WS_MPREV = 57 * MiB + 131072;
constexpr size_t WS_SS0 = 58 * MiB, WS_SS1 = 60 * MiB, WS_SS2 = 62 * MiB, WS_SS3 = 64 * MiB, WS_SS4 = 66 * MiB, WS_SSP = 68 * MiB;
constexpr size_t WS_XN = 72 * MiB;
constexpr size_t WS_ACTZ = 136 * MiB;
constexpr size_t WS_YMIX = 328 * MiB;
constexpr size_t WS_UT = 392 * MiB;
constexpr size_t WS_CT = 456 * MiB;
constexpr size_t WS_PB = 488 * MiB;
constexpr size_t WS_END = 504 * MiB;
constexpr int LDS_BYTES = 147456;
constexpr int WIN_ROWS = 3328;

#define LAS __attribute__((address_space(3)))
typedef unsigned short bf16;
typedef unsigned v4u __attribute__((ext_vector_type(4)));
typedef float f32x4 __attribute__((ext_vector_type(4)));
typedef short bf16x8 __attribute__((ext_vector_type(8)));
#define LDS_WAIT() asm volatile("s_waitcnt lgkmcnt(0)" ::: "memory")
__device__ __forceinline__ unsigned f2bf(float f) { unsigned u = __builtin_bit_cast(unsigned, f); return (u + 0x7fffu + ((u >> 16) & 1u)) >> 16; }
__device__ __forceinline__ unsigned pk2(float lo, float hi) { return f2bf(lo) | (f2bf(hi) << 16); }
__device__ __forceinline__ float bf2f(unsigned h) { return __uint_as_float(h << 16); }
__device__ __forceinline__ float logsig_f(float x) { return fminf(x, 0.f) - log1pf(__expf(-fabsf(x))); }
__device__ __forceinline__ float sigm_f(float x) { return 1.0f / (1.0f + __expf(-x)); }

__device__ __forceinline__ int wmap(int map, int n) {
    if (map == 1) return ((n >> 7) << 8) + (n & 127);
    if (map == 2) return ((n >> 7) << 8) + 128 + (n & 127);
    if (map == 3) { if (n < 1536) return n; if (n < 1544) return 3072 + (n - 1536); if (n < 3080) return n - 8; return n; }
    return n;
}
__device__ __forceinline__ void p0_transpose_item(const float* __restrict__ W, int K, int N, bf16* WT, int map, const float* __restrict__ gain, LAS float* scr, int item, int lane) {
    const int nblk = (N + 31) / 32, kb = item / nblk, nb = item % nblk, k0 = 64 * kb, n0 = 32 * nb;
    const int nin = n0 + (lane & 31); const bool ok = nin < N;
#pragma unroll 8
    for (int i = 0; i < 32; ++i) { const int kk = 2 * i + (lane >> 5); float v = ok ? W[(size_t)(k0 + kk) * N + nin] : 0.f; if (gain) v *= gain[k0 + kk]; scr[kk * 33 + (lane & 31)] = v; }
    LDS_WAIT(); asm volatile("" ::: "memory");
    const int c = lane & 7;
#pragma unroll
    for (int j = 0; j < 4; ++j) { const int n = (lane >> 3) + 8 * j; const LAS float* s = scr + (8 * c) * 33 + n;
        v4u o; o.x = pk2(s[0 * 33], s[1 * 33]); o.y = pk2(s[2 * 33], s[3 * 33]); o.z = pk2(s[4 * 33], s[5 * 33]); o.w = pk2(s[6 * 33], s[7 * 33]);
        if (n0 + n < N) *(v4u*)(WT + (size_t)wmap(map, n0 + n) * K + k0 + 8 * c) = o; }
    LDS_WAIT(); asm volatile("" ::: "memory");
}

constexpr int LDS_LD = 72;
__device__ __forceinline__ bf16x8 frag(const LAS bf16* X, int r0, int k0, int lane) { return *(const LAS bf16x8*)(X + (r0 + (lane & 15)) * LDS_LD + k0 + 8 * (lane >> 4)); }
#define MMA16(a, b, c) __builtin_amdgcn_mfma_f32_16x16x32_bf16((a), (b), (c), 0, 0, 0)

struct Ptrs {
    const float* gates; float *barr, *rarr, *nloc, *nprev, *garr, *mloc, *mprev, *ut; bf16 *ct, *qkc, *z, *ymix; const float *conv, *gm;
};

struct LocRegs { v4u zq[2][4]; v4u vv[2]; float ip, fp; };
__device__ __forceinline__ void loc_load(LocRegs& R, int ci, const Ptrs& P) {
    const int tid = threadIdx.x, lane = tid & 63, wid = tid >> 6;
    const int bh = ci >> 6, c = ci & 63, b = bh >> 2, h = bh & 3;
    const size_t row0 = (size_t)b * SEQL + (size_t)c * 64;
    const int cg8 = tid & 15, tl = tid >> 4, isk = cg8 >> 3, zc = isk * 256 + h * 64 + (cg8 & 7) * 8;
#pragma unroll
    for (int p = 0; p < 2; ++p) { const int tpos = c * 64 + tl + 32 * p;
#pragma unroll
        for (int j = 0; j < 4; ++j) { int tp = tpos - 3 + j; tp = tp < 0 ? 0 : tp; R.zq[p][j] = *(const v4u*)(P.z + ((size_t)b * SEQL + tp) * 3072 + zc); }
        R.vv[p] = *(const v4u*)(P.z + (row0 + tl + 32 * p) * 3072 + 512 + h * 128 + cg8 * 8); }
    if (wid == 0) { R.ip = P.gates[(row0 + lane) * 16 + h]; R.fp = P.gates[(row0 + lane) * 16 + 4 + h]; } else { R.ip = 0.f; R.fp = 0.f; }
}
__device__ __forceinline__ void loc_compute(const LocRegs& R, int ci, LAS unsigned char* lds, const Ptrs& P) {
    const int tid = threadIdx.x, lane = tid & 63, wid = tid >> 6;
    const int bh = ci >> 6, c = ci & 63, b = bh >> 2, h = bh & 3;
    const size_t row0 = (size_t)b * SEQL + (size_t)c * 64;
    LAS bf16* KwT = (LAS bf16*)lds;
    LAS bf16* VT = (LAS bf16*)(lds + 9216);
    LAS float* wv = (LAS float*)(lds + 9216 + 18432);
    if (wid == 0) {
        float bc = logsig_f(R.fp);
#pragma unroll
        for (int o = 1; o < 64; o <<= 1) { const float t = __shfl_up(bc, o); if (lane >= o) bc += t; }
        const float g = __shfl(bc, 63);
        const float r = R.ip - bc; float rm = r;
#pragma unroll
        for (int o = 1; o < 64; o <<= 1) rm = fmaxf(rm, __shfl_xor(rm, o));
        wv[lane] = __expf(r - rm);
        P.barr[ci * 64 + lane] = bc; P.rarr[ci * 64 + lane] = r; if (lane == 0) { P.garr[ci] = g; P.mloc[ci] = g + rm; }
    }
    const int cg8 = tid & 15, tl = tid >> 4, isk = cg8 >> 3, zc = isk * 256 + h * 64 + (cg8 & 7) * 8;
    float kv[2][8];
    {
        float cw[4][8];
#pragma unroll
        for (int j = 0; j < 4; ++j) { const f32x4 a = *(const f32x4*)(P.conv + j * 512 + zc), d = *(const f32x4*)(P.conv + j * 512 + zc + 4);
#pragma unroll
            for (int i = 0; i < 4; ++i) { cw[j][i] = a[i]; cw[j][4 + i] = d[i]; } }
#pragma unroll
        for (int p = 0; p < 2; ++p) { const int t = tl + 32 * p, tpos = c * 64 + t; float a[8];
#pragma unroll
            for (int i = 0; i < 8; ++i) a[i] = 0.f;
#pragma unroll
            for (int j = 0; j < 4; ++j) { const float ok = (tpos - 3 + j) >= 0 ? 1.0f : 0.0f; const v4u zz = R.zq[p][j];
#pragma unroll
                for (int k = 0; k < 4; ++k) { a[2 * k] += (cw[j][2 * k] * ok) * bf2f(zz[k] & 0xffffu); a[2 * k + 1] += (cw[j][2 * k + 1] * ok) * __uint_as_float(zz[k] & 0xffff0000u); } }
            const float sc = isk ? 1.0f : 0.125f;
#pragma unroll
            for (int i = 0; i < 8; ++i) { a[i] = a[i] * sigm_f(a[i]) * sc; kv[p][i] = a[i]; }
            v4u o; o.x = pk2(a[0], a[1]); o.y = pk2(a[2], a[3]); o.z = pk2(a[4], a[5]); o.w = pk2(a[6], a[7]);
            *(v4u*)(P.qkc + (row0 + t) * 512 + zc) = o; }
    }
#pragma unroll
    for (int p = 0; p < 2; ++p) { const int s = tl + 32 * p; const v4u vv = R.vv[p];
#pragma unroll
        for (int k = 0; k < 4; ++k) { VT[(cg8 * 8 + 2 * k) * LDS_LD + s] = (bf16)(vv[k] & 0xffffu); VT[(cg8 * 8 + 2 * k + 1) * LDS_LD + s] = (bf16)(vv[k] >> 16); } }
    __syncthreads();
    if (isk) {
#pragma unroll
        for (int p = 0; p < 2; ++p) { const int t = tl + 32 * p; const float w = wv[t];
#pragma unroll
            for (int i = 0; i < 8; ++i) KwT[((cg8 & 7) * 8 + i) * LDS_LD + t] = (bf16)f2bf(kv[p][i] * w); }
    }
    __syncthreads();
    {
        f32x4 acc[4];
#pragma unroll
        for (int dj = 0; dj < 4; ++dj) acc[dj] = (f32x4){0.f, 0.f, 0.f, 0.f};
#pragma unroll
        for (int ks = 0; ks < 2; ++ks) { const bf16x8 a = frag(VT, 16 * wid, ks * 32, lane);
#pragma unroll
            for (int dj = 0; dj < 4; ++dj) acc[dj] = MMA16(a, frag(KwT, 16 * dj, ks * 32, lane), acc[dj]); }
        float* up = P.ut + (size_t)ci * 8192;
#pragma unroll
        for (int dj = 0; dj < 4; ++dj)
#pragma unroll
            for (int r = 0; r < 4; ++r) up[(16 * wid + 4 * (lane >> 4) + r) * 64 + 16 * dj + (lane & 15)] = acc[dj][r];
    }
    if (wid == 0) { float s = 0.f;
#pragma unroll 8
        for (int i = 0; i < 64; ++i) s += bf2f(KwT[lane * LDS_LD + i]);
        P.nloc[ci * 64 + lane] = s; }
    __syncthreads();
}
__device__ __forceinline__ void mlstm_local_phase(int first, int step, int n, LAS unsigned char* lds, const Ptrs& P) {
    LocRegs A, B; int it = first;
    if (it < n) loc_load(A, it, P);
    while (it < n) {
        const int n1 = it + step; if (n1 < n) loc_load(B, n1, P);
        loc_compute(A, it, lds, P);
        it = n1; if (it >= n) break;
        const int n2 = it + step; if (n2 < n) loc_load(A, n2, P);
        loc_compute(B, it, lds, P);
        it = n2;
    }
}

struct OutRegs { v4u q, k, ct[2], vv[2], mo[2]; float r, bt, mp, np; };
__device__ __forceinline__ void out_load(OutRegs& R, int ci, const Ptrs& P) {
    const int tid = threadIdx.x, lane = tid & 63, wid = tid >> 6;
    const int bh = ci >> 6, c = ci & 63, b = bh >> 2, h = bh & 3;
    const size_t row0 = (size_t)b * SEQL + (size_t)c * 64;
    const int t8 = tid >> 3, part = tid & 7, cg8 = tid & 15, tl = tid >> 4;
    R.q = *(const v4u*)(P.qkc + (row0 + t8) * 512 + h * 64 + part * 8);
    R.k = *(const v4u*)(P.qkc + (row0 + t8) * 512 + 256 + h * 64 + part * 8);
#pragma unroll
    for (int p = 0; p < 2; ++p) { const int idx = tid + 512 * p, e = idx >> 3, pp = idx & 7; R.ct[p] = *(const v4u*)(P.ct + (size_t)ci * 8192 + e * 64 + pp * 8);
        R.vv[p] = *(const v4u*)(P.z + (row0 + tl + 32 * p) * 3072 + 512 + h * 128 + cg8 * 8);
        R.mo[p] = *(const v4u*)(P.z + (row0 + t8) * 3072 + 1024 + h * 128 + part * 16 + 8 * p); }
    if (wid == 0) { R.r = P.rarr[ci * 64 + lane]; R.bt = P.barr[ci * 64 + lane]; R.mp = P.mprev[ci]; R.np = P.nprev[ci * 64 + lane]; } else { R.r = 0.f; R.bt = 0.f; R.mp = 0.f; R.np = 0.f; }
}
__device__ __forceinline__ void out_compute(const OutRegs& R, int ci, LAS unsigned char* lds, const Ptrs& P) {
    const int tid = threadIdx.x, lane = tid & 63, wid = tid >> 6;
    const int bh = ci >> 6, c = ci & 63, b = bh >> 2, h = bh & 3;
    const size_t row0 = (size_t)b * SEQL + (size_t)c * 64;
    LAS bf16* Qs = (LAS bf16*)lds; LAS bf16* Qw = (LAS bf16*)(lds + 9216); LAS bf16* Ks = (LAS bf16*)(lds + 18432); LAS bf16* Ps = (LAS bf16*)(lds + 27648);
    LAS bf16* VT = (LAS bf16*)(lds + 36864); LAS bf16* CTs = (LAS bf16*)(lds + 55296); LAS float* NUM = (LAS float*)(lds + 73728);
    LAS float* rvec = (LAS float*)(lds + 107520); LAS float* Mt = rvec + 64; LAS float* wint = rvec + 128; LAS float* emt = rvec + 192; LAS float* npv = rvec + 256; LAS float* denom = rvec + 320;
    if (wid == 0) {
        float cm = R.r;
#pragma unroll
        for (int o = 1; o < 64; o <<= 1) { const float t = __shfl_up(cm, o); if (lane >= o) cm = fmaxf(cm, t); }
        const float M = fmaxf(R.mp, cm);
        rvec[lane] = R.r; Mt[lane] = M; wint[lane] = __expf(R.mp - M); emt[lane] = __expf(-R.bt - M); npv[lane] = R.np;
    }
    const int t8 = tid >> 3, part = tid & 7;
    *(LAS v4u*)(Qs + t8 * LDS_LD + part * 8) = R.q; *(LAS v4u*)(Ks + t8 * LDS_LD + part * 8) = R.k;
#pragma unroll
    for (int p = 0; p < 2; ++p) { const int idx = tid + 512 * p, e = idx >> 3, pp = idx & 7; *(LAS v4u*)(CTs + e * LDS_LD + pp * 8) = R.ct[p]; }
    { const int cg8 = tid & 15, tl = tid >> 4;
#pragma unroll
      for (int p = 0; p < 2; ++p) { const int s = tl + 32 * p; const v4u vv = R.vv[p];
#pragma unroll
        for (int k = 0; k < 4; ++k) { VT[(cg8 * 8 + 2 * k) * LDS_LD + s] = (bf16)(vv[k] & 0xffffu); VT[(cg8 * 8 + 2 * k + 1) * LDS_LD + s] = (bf16)(vv[k] >> 16); } } }
    __syncthreads();
    { const float w = wint[t8]; const v4u q = R.q; v4u o;
#pragma unroll
      for (int k = 0; k < 4; ++k) o[k] = pk2(bf2f(q[k] & 0xffffu) * w, __uint_as_float(q[k] & 0xffff0000u) * w);
      *(LAS v4u*)(Qw + t8 * LDS_LD + part * 8) = o; }
    {
        const int ti = wid >> 1;
#pragma unroll
        for (int jj = 0; jj < 2; ++jj) { const int sj = 2 * (wid & 1) + jj; f32x4 acc = (f32x4){0.f, 0.f, 0.f, 0.f};
            if (sj <= ti) {
#pragma unroll
                for (int ks = 0; ks < 2; ++ks) acc = MMA16(frag(Qs, 16 * ti, ks * 32, lane), frag(Ks, 16 * sj, ks * 32, lane), acc);
            }
            const int s = 16 * sj + (lane & 15); const float rs = rvec[s];
#pragma unroll
            for (int r = 0; r < 4; ++r) { const int t = 16 * ti + 4 * (lane >> 4) + r; const float pv = (s <= t) ? __expf(rs - Mt[t]) * acc[r] : 0.f; Ps[t * LDS_LD + s] = (bf16)f2bf(pv); } }
    }
    __syncthreads();
    {
        const v4u q = R.q, pp = *(const LAS v4u*)(Ps + t8 * LDS_LD + part * 8); float dot = 0.f, ps = 0.f;
#pragma unroll
        for (int k = 0; k < 4; ++k) { dot += bf2f(q[k] & 0xffffu) * npv[part * 8 + 2 * k] + __uint_as_float(q[k] & 0xffff0000u) * npv[part * 8 + 2 * k + 1]; ps += bf2f(pp[k] & 0xffffu) + __uint_as_float(pp[k] & 0xffff0000u); }
        float v = wint[t8] * dot + ps; v += __shfl_xor(v, 1); v += __shfl_xor(v, 2); v += __shfl_xor(v, 4);
        if (part == 0) denom[t8] = fmaxf(fabsf(v), emt[t8]);
    }
    {
        const int ti = wid >> 1, eh = wid & 1; f32x4 acc[4];
#pragma unroll
        for (int ej = 0; ej < 4; ++ej) acc[ej] = (f32x4){0.f, 0.f, 0.f, 0.f};
#pragma unroll
        for (int ks = 0; ks < 2; ++ks) { const bf16x8 a = frag(Qw, 16 * ti, ks * 32, lane);
#pragma unroll
            for (int ej = 0; ej < 4; ++ej) acc[ej] = MMA16(a, frag(CTs, 64 * eh + 16 * ej, ks * 32, lane), acc[ej]); }
#pragma unroll
        for (int ks = 0; ks < 2; ++ks) { const bf16x8 a = frag(Ps, 16 * ti, ks * 32, lane);
#pragma unroll
            for (int ej = 0; ej < 4; ++ej) acc[ej] = MMA16(a, frag(VT, 64 * eh + 16 * ej, ks * 32, lane), acc[ej]); }
#pragma unroll
        for (int ej = 0; ej < 4; ++ej)
#pragma unroll
            for (int r = 0; r < 4; ++r) NUM[(16 * ti + 4 * (lane >> 4) + r) * 132 + 64 * eh + 16 * ej + (lane & 15)] = acc[ej][r];
    }
    __syncthreads();
    {
        const float rd = 1.0f / denom[t8]; float hv[16]; float ss = 0.f;
#pragma unroll
        for (int i = 0; i < 4; ++i) { const f32x4 x = *(const LAS f32x4*)(NUM + t8 * 132 + part * 16 + 4 * i);
#pragma unroll
            for (int k = 0; k < 4; ++k) { hv[4 * i + k] = x[k] * rd; ss += hv[4 * i + k] * hv[4 * i + k]; } }
        ss += __shfl_xor(ss, 1); ss += __shfl_xor(ss, 2); ss += __shfl_xor(ss, 4);
        const float rs = 1.0f / sqrtf(ss * (1.0f / 128.0f) + 1e-6f);
        const float* gmp = P.gm + h * 128 + part * 16; bf16* yo = P.ymix + (row0 + t8) * 1024 + h * 128 + part * 16;
#pragma unroll
        for (int hh = 0; hh < 2; ++hh) { const v4u mv = R.mo[hh]; const f32x4 g0 = *(const f32x4*)(gmp + 8 * hh), g1 = *(const f32x4*)(gmp + 8 * hh + 4); float y[8];
#pragma unroll
            for (int k = 0; k < 4; ++k) { const float m0 = bf2f(mv[k] & 0xffffu), m1 = __uint_as_float(mv[k] & 0xffff0000u); const float ga = k < 2 ? g0[2 * k] : g1[2 * k - 4], gb = k < 2 ? g0[2 * k + 1] : g1[2 * k - 3];
                y[2 * k] = hv[8 * hh + 2 * k] * rs * ga * sigm_f(m0); y[2 * k + 1] = hv[8 * hh + 2 * k + 1] * rs * gb * sigm_f(m1); }
            v4u o; o.x = pk2(y[0], y[1]); o.y = pk2(y[2], y[3]); o.z = pk2(y[4], y[5]); o.w = pk2(y[6], y[7]);
            *(v4u*)(yo + 8 * hh) = o; }
    }
    __syncthreads();
}
__device__ __forceinline__ void mlstm_out_phase(int first, int step, int n, LAS unsigned char* lds, const Ptrs& P) {
    OutRegs A, B; int it = first;
    if (it < n) out_load(A, it & 2047, P);
    while (it < n) {
        const int n1 = it + step; if (n1 < n) out_load(B, n1 & 2047, P);
        out_compute(A, it & 2047, lds, P);
        it = n1; if (it >= n) break;
        const int n2 = it + step; if (n2 < n) out_load(A, n2 & 2047, P);
        out_compute(B, it & 2047, lds, P);
        it = n2;
    }
}

typedef unsigned u32;
#define RLX_AGENT __ATOMIC_RELAXED, __HIP_MEMORY_SCOPE_AGENT
#define XB_TMO      128
#define XB_XCNT(j)  (256  + 64 * (j))
#define XB_XSUB(j)  (1280 + 64 * (j))
#define XB_XGEN(j)  (2304 + 64 * (j))
#define XB_TOP      3328
#define XB_TOPGEN   3392
#define XCD_BAR_WORDS 3456
#define XB_SPIN_CAP (1u << 18)

__device__ __forceinline__ unsigned xb_ld(unsigned* p)              { return __hip_atomic_load(p, __ATOMIC_RELAXED, __HIP_MEMORY_SCOPE_AGENT); }
__device__ __forceinline__ unsigned xb_add(unsigned* p, unsigned v) { return __hip_atomic_fetch_add(p, v, __ATOMIC_RELAXED, __HIP_MEMORY_SCOPE_AGENT); }
__device__ __forceinline__ unsigned xb_xcc_id() { return (unsigned)__builtin_amdgcn_s_getreg((3 << 11) | 20) & 0xFu; }
#define XB_SPIN(cond, bar) do { unsigned _sp = 0; while (cond) { __builtin_amdgcn_s_sleep(1); \
    if ((++_sp & 255u) == 0u) { if (xb_ld(&(bar)[XB_TMO])) break; if (_sp > XB_SPIN_CAP) { atomicAdd(&(bar)[XB_TMO], 1u); break; } } } } while (0)

struct XcdBarrier {
    unsigned* bar; unsigned x;
    volatile LAS unsigned* st;
};

__device__ __forceinline__ XcdBarrier xcd_barrier_post(unsigned* bar, volatile LAS unsigned* st) {
    XcdBarrier b; b.bar = bar; b.x = xb_xcc_id(); b.st = st;
    if (threadIdx.x == 0) (void)xb_add(&bar[XB_XCNT(b.x)], 1u);
    return b;
}
__device__ __forceinline__ void xcd_barrier_complete(unsigned* bar, unsigned x, unsigned& nloc, unsigned& nx) {
    const unsigned G = gridDim.x * gridDim.y * gridDim.z;
    unsigned sum, cnt, mine, sp = 0u;
    for (;;) {
        sum = 0u; cnt = 0u; mine = 0u;
#pragma unroll
        for (unsigned j = 0; j < 16; ++j) { const unsigned c = xb_ld(&bar[XB_XCNT(j)]); sum += c; cnt += (c > 0u) ? 1u : 0u; mine = (j == x) ? c : mine; }
        if (sum == G) break;
        __builtin_amdgcn_s_sleep(1);
        if ((++sp & 255u) == 0u) { if (xb_ld(&bar[XB_TMO])) break; if (sp > XB_SPIN_CAP) { atomicAdd(&bar[XB_TMO], 1u); break; } }
    }
    nloc = mine > 0u ? mine : 1u; nx = cnt > 0u ? cnt : 1u;
}

__device__ __forceinline__ void xcd_barrier(const XcdBarrier& b) {
    asm volatile("s_waitcnt vmcnt(0)" ::: "memory");
    __syncthreads();
    if (threadIdx.x == 0) {
        unsigned* bar = b.bar;
        __builtin_amdgcn_s_waitcnt(0);
        unsigned nloc = b.st[0], nx = b.st[1];
        if (nloc == 0u) { xcd_barrier_complete(bar, b.x, nloc, nx); b.st[0] = nloc; b.st[1] = nx; }
        const unsigned old = xb_add(&bar[XB_XSUB(b.x)], 1u);
        const unsigned gen = old / nloc;
        if (old + 1u == (gen + 1u) * nloc) {
            __builtin_amdgcn_fence(__ATOMIC_RELEASE, "agent");
            asm volatile("s_waitcnt vmcnt(0)" ::: "memory");
            const unsigned og = xb_add(&bar[XB_TOP], 1u);
            const unsigned tg = og / nx;
            if (og + 1u == (tg + 1u) * nx) xb_add(&bar[XB_TOPGEN], 1u);
            else XB_SPIN(xb_ld(&bar[XB_TOPGEN]) == tg, bar);
            __builtin_amdgcn_fence(__ATOMIC_ACQUIRE, "agent");
            xb_add(&bar[XB_XGEN(b.x)], 1u);
            asm volatile("s_waitcnt vmcnt(0)" ::: "memory");
        } else {
            XB_SPIN(xb_ld(&bar[XB_XGEN(b.x)]) == gen, bar);
            __builtin_amdgcn_fence(__ATOMIC_ACQUIRE, "agent");
            asm volatile("s_waitcnt vmcnt(0)" ::: "memory");
        }
    }
    __syncthreads();
}

struct Args { const float* in[23]; float* out; unsigned char* ws; int ph_lo, ph_hi; };
__global__ void __launch_bounds__(NTHR, 2) hymba_fwd(Args args) {
    extern __shared__ __attribute__((aligned(16))) unsigned char lds_raw[];
    LAS unsigned char* lds = (LAS unsigned char*)lds_raw;
    cg::grid_group grid = cg::this_grid();
    const int tid = threadIdx.x, lane = tid & 63, wave = __builtin_amdgcn_readfirstlane(tid >> 6);
    const int G = gridDim.x; const int bx = blockIdx.x; const int vcu = (G % 8 == 0) ? (bx % 8) * (G / 8) + bx / 8 : bx;
#define H (args.out)
#define W1GU ((bf16*)(args.ws + WS_W1GU))
#define W1D ((bf16*)(args.ws + WS_W1D))
#define WIN ((bf16*)(args.ws + WS_WIN))
#define WOUT ((bf16*)(args.ws + WS_WOUT))
#define W2GU ((bf16*)(args.ws + WS_W2GU))
#define W2D ((bf16*)(args.ws + WS_W2D))
#define WPG ((bf16*)(args.ws + WS_WPG))
#define WPP ((bf16*)(args.ws + WS_WPP))
#define GATES ((float*)(args.ws + WS_GATES))
#define CLG ((float*)(args.ws + WS_CL))
#define SS0 ((float*)(args.ws + WS_SS0))
#define SS1 ((float*)(args.ws + WS_SS1))
#define SS2 ((float*)(args.ws + WS_SS2))
#define SS3 ((float*)(args.ws + WS_SS3))
#define SS4 ((float*)(args.ws + WS_SS4))
#define SSP ((float*)(args.ws + WS_SSP))
#define XN ((bf16*)(args.ws + WS_XN))
#define ACT ((bf16*)(args.ws + WS_ACTZ))
#define Z ((bf16*)(args.ws + WS_ACTZ))
#define YMIX ((bf16*)(args.ws + WS_YMIX))
#define PROJ ((bf16*)(args.ws + WS_YMIX))
#define PB ((bf16*)(args.ws + WS_PB))
#define MKPTRS() Ptrs P; { unsigned char* ws_ = args.ws; P.gates = (const float*)(ws_ + WS_GATES); P.barr = (float*)(ws_ + WS_BARR); P.rarr = (float*)(ws_ + WS_RARR); P.nloc = (float*)(ws_ + WS_NLOC); P.nprev = (float*)(ws_ + WS_NPREV); \
    P.garr = (float*)(ws_ + WS_GARR); P.mloc = (float*)(ws_ + WS_MLOC); P.mprev = (float*)(ws_ + WS_MPREV); P.ut = (float*)(ws_ + WS_UT); P.ct = (bf16*)(ws_ + WS_CT); \
    P.qkc = (bf16*)(ws_ + WS_XN); P.z = (bf16*)(ws_ + WS_ACTZ); P.ymix = (bf16*)(ws_ + WS_YMIX); P.conv = args.in[8]; P.gm = args.in[11]; }
    const int lo = args.ph_lo, hi = args.ph_hi;
#ifndef PH_MASK
#define PH_MASK 0xFFF
#endif
#ifndef PROBE_REP
#define PROBE_REP 0
#endif
#define IN(k) (((PH_MASK >> (k)) & 1) && lo <= (k) && (k) < hi)
#define REPS(k) _Pragma("unroll") for (int rep_ = 0; rep_ < 1 + ((PROBE_REP >> (k)) & 1); ++rep_)
#define SEAM(k) do { if (IN(k) && IN((k) + 1)) { if ((k) == 0) grid.sync(); else xcd_barrier(bar); } } while (0)
    const int gw = vcu * NWAVES + wave, NGW = G * NWAVES;
    if (tid < 8) ((LAS unsigned*)(lds + 131072))[tid] = 0u;
    __syncthreads();
    XcdBarrier bar; bar.bar = (unsigned*)args.ws; bar.x = 0; bar.st = nullptr;
    if (hi - lo > 1) bar = xcd_barrier_post((unsigned*)args.ws, (volatile LAS unsigned*)(lds + 131072));

    if (IN(0)) REPS(0) { if (rep_) xcd_barrier(bar);
        LAS float* scr = (LAS float*)(lds + wave * 16384);
        constexpr int I_GU = 16 * 88, I_D = 44 * 32, I_IN = 16 * 97, I_O = 16 * 32, I_PP = 4 * 32;
        constexpr int NITEMS = 4 * I_GU + 2 * I_D + I_IN + 2 * I_O + I_PP;
        for (int it = gw; it < NITEMS; it += NGW) {
            int r = it, wi, gi = -1, K = DM_, N = DFF, map = 0; size_t wso;
            if (r < I_GU) { wi = 3; gi = 2; wso = WS_W1GU; map = 1; }
            else if ((r -= I_GU) < I_GU) { wi = 4; gi = 2; wso = WS_W1GU; map = 2; }
            else if ((r -= I_GU) < I_D) { wi = 5; wso = WS_W1D; K = DFF; N = DM_; }
            else if ((r -= I_D) < I_IN) { wi = 7; gi = 6; wso = WS_WIN; N = 3088; map = 3; }
            else if ((r -= I_IN) < I_O) { wi = 13; wso = WS_WOUT; N = DM_; }
            else if ((r -= I_O) < I_GU) { wi = 15; gi = 14; wso = WS_W2GU; map = 1; }
            else if ((r -= I_GU) < I_GU) { wi = 16; gi = 14; wso = WS_W2GU; map = 2; }
            else if ((r -= I_GU) < I_D) { wi = 17; wso = WS_W2D; K = DFF; N = DM_; }
            else if ((r -= I_D) < I_O) { wi = 19; gi = 18; wso = WS_WPG; N = DM_; }
            else { r -= I_O; wi = 20; wso = WS_WPP; K = DPLE; N = DM_; }
            p0_transpose_item(args.in[wi], K, N, (bf16*)(args.ws + wso), map, gi >= 0 ? args.in[gi] : nullptr, scr, r, lane);
        }
        { v4u* zp = (v4u*)(WIN + (size_t)3088 * 1024); const int nz = (WIN_ROWS - 3088) * 1024 * 2 / 16;
          for (int i = bx * NTHR + tid; i < nz; i += G * NTHR) zp[i] = (v4u){0u, 0u, 0u, 0u}; }
        for (int m = gw; m < Mrows; m += NGW) {
            const f32x4* xr = (const f32x4*)(args.in[0] + (size_t)m * 1024) + lane; f32x4 v[4]; float s = 0.f;
#pragma unroll
            for (int j = 0; j < 4; ++j) { v[j] = xr[64 * j]; s += (v[j][0] * v[j][0] + v[j][1] * v[j][1]) + (v[j][2] * v[j][2] + v[j][3] * v[j][3]); }
#pragma unroll
            for (int o = 1; o < 64; o <<= 1) s += __shfl_xor(s, o);
            unsigned long long* o8 = (unsigned long long*)(XN + (size_t)m * 1024) + lane;
#pragma unroll
            for (int j = 0; j < 4; ++j) o8[64 * j] = (unsigned long long)pk2(v[j][0], v[j][1]) | ((unsigned long long)pk2(v[j][2], v[j][3]) << 32);
            if (lane < 16) SS0[(size_t)m * 16 + lane] = lane == 0 ? s : 0.f;
        }
        { const f32x4* pp = (const f32x4*)args.in[1]; unsigned long long* po = (unsigned long long*)PB; const int n4 = Mrows * DPLE / 4;
          for (int i = bx * NTHR + tid; i < n4; i += G * NTHR) { const f32x4 v = pp[i]; po[i] = (unsigned long long)pk2(v[0], v[1]) | ((unsigned long long)pk2(v[2], v[3]) << 32); } }
    }
    SEAM(0);
    if (IN(1)) REPS(1) { if (rep_) xcd_barrier(bar); pg8::Gemm g{XN, W1GU, Mrows, 2 * DFF, DM_}; pg8::StaticOrder S; S.init(Mrows, 2 * DFF, G, bx);
        pg8::EpiSwiGLU E{ACT, SS0, DFF}; pg8::gemm_phase<pg8::EpiSwiGLU, pg8::StaticOrder, true, true>(lds, g, S, E); }
    SEAM(1);
    if (IN(2)) REPS(2) { if (rep_) xcd_barrier(bar); pg8::Gemm g{ACT, W1D, Mrows, DM_, DFF}; pg8::StaticOrder S; S.init(Mrows, DM_, G, bx);
        pg8::EpiResid E{args.in[0], H, XN, SS1, 0.5f}; pg8::gemm_phase<pg8::EpiResid, pg8::StaticOrder, true, true>(lds, g, S, E); }
    SEAM(2);
    if (IN(3)) REPS(3) { if (rep_) xcd_barrier(bar); pg8::Gemm g{XN, WIN, Mrows, WIN_ROWS, DM_}; pg8::StaticOrder S; S.init(Mrows, WIN_ROWS, G, bx);
        pg8::EpiZ E{Z, GATES, SS1, args.in[9], args.in[10], 0.125f * 1.4426950408889634f}; pg8::gemm_phase<pg8::EpiZ, pg8::StaticOrder, true, true>(lds, g, S, E); }
    SEAM(3);
    if (IN(4)) REPS(4) { if (rep_) xcd_barrier(bar);
        if (wave == 7 && vcu < 64) {
            const int b = vcu >> 3, h = vcu & 7; const float* gp = GATES + ((size_t)b * SEQL + lane * 64) * 16 + 8 + h; float s = 0.f;
#pragma unroll 8
            for (int j = 0; j < 64; ++j) s += logsig_f(gp[j * 16]);
            float inc = s;
#pragma unroll
            for (int o = 1; o < 64; o <<= 1) { const float t = __shfl_up(inc, o); if (lane >= o) inc += t; }
            float run = inc - s; float* co = CLG + (size_t)vcu * SEQL + lane * 64;
#pragma unroll 8
            for (int j = 0; j < 64; ++j) { run += logsig_f(gp[j * 16]); co[j] = run * 1.4426950408889634f; }
        }
        MKPTRS();
        mlstm_local_phase(vcu, G, 2048, lds, P);
    }
    SEAM(4);
    if (IN(5)) REPS(5) { if (rep_) xcd_barrier(bar);
        MKPTRS();
        const float* __restrict__ ut = P.ut; bf16* __restrict__ ct = P.ct;
        for (int eid = bx * NTHR + tid; eid < 32 * 8192; eid += G * NTHR) {
            const int bh = eid >> 13, idx = eid & 8191; float C = 0.f, m = 0.f;
            for (int c0 = 0; c0 < 64; c0 += 8) { float u[8];
#pragma unroll
                for (int j = 0; j < 8; ++j) u[j] = ut[((size_t)(bh * 64 + c0 + j) << 13) + idx];
#pragma unroll
                for (int j = 0; j < 8; ++j) { const int ci = bh * 64 + c0 + j; const float g = P.garr[ci], ml = P.mloc[ci]; const float mn = fmaxf(g + m, ml);
                    ct[((size_t)ci << 13) + idx] = (bf16)f2bf(C); if (idx == 0) P.mprev[ci] = m;
                    C = __expf(g + m - mn) * C + __expf(ml - mn) * u[j]; m = mn; } }
        }
        for (int eid = bx * NTHR + tid; eid < 32 * 64; eid += G * NTHR) {
            const int bh = eid >> 6, d = eid & 63; float n = 0.f, m = 0.f;
            for (int c = 0; c < 64; ++c) { const int ci = bh * 64 + c; const float g = P.garr[ci], ml = P.mloc[ci]; const float mn = fmaxf(g + m, ml);
                P.nprev[ci * 64 + d] = n; n = __expf(g + m - mn) * n + __expf(ml - mn) * P.nloc[ci * 64 + d]; m = mn; }
        }
    }
    SEAM(5);
    if (IN(6)) { constexpr int R6 = 1 + ((PROBE_REP >> 6) & 1), R6A = 1 + ((PROBE_REP >> 7) & 1);
        { MKPTRS();
        mlstm_out_phase(vcu, G, 2048 * R6, lds, P); }
        __syncthreads();
        LAS float* cl = (LAS float*)(lds + 86016); int cur_bh = -1;
        const int nu = (1024 + G - 1) / G;
        for (int i2 = 0; i2 < nu * R6A; ++i2) { const int i = i2 % nu;
            int bh, qb;
            if (G == 256) { const int s = vcu & 3; bh = vcu >> 2; qb = (i == 0) ? s : (i == 1) ? 7 - s : (i == 2) ? 8 + s : 15 - s; }
            else { const int idx = i * G + vcu; if (idx >= 1024) break; bh = idx >> 4; qb = idx & 15; }
            if (bh != cur_bh) { __syncthreads();
                for (int k = tid; k < SEQL / 4; k += NTHR) *(LAS f32x4*)(cl + 4 * k) = *(const f32x4*)(CLG + (size_t)bh * SEQL + 4 * k);
                cur_bh = bh; __syncthreads(); }
            attn_body::attn_unit<8>(bh >> 3, bh & 7, qb, (const attn_body::bf16*)(Z + 1536), (const attn_body::bf16*)(Z + 2048), (const attn_body::bf16*)(Z + 2560), (attn_body::bf16*)(YMIX + 512), (char*)lds_raw, (attn_body::lds_fptr)cl, args.in[12]);
        }
    }
    SEAM(6);
    if (IN(7)) { pg8::Gemm g{YMIX, WOUT, Mrows, DM_, DM_}; pg8::StaticOrder S; S.init(Mrows, DM_, G, bx);
        pg8::EpiResid E{H, H, XN, SS2, 1.0f}; pg8::gemm_phase<pg8::EpiResid, pg8::StaticOrder, true, true>(lds, g, S, E); }
    SEAM(7);
    if (IN(8)) REPS(8) { if (rep_) xcd_barrier(bar); pg8::Gemm g{XN, W2GU, Mrows, 2 * DFF, DM_}; pg8::StaticOrder S; S.init(Mrows, 2 * DFF, G, bx);
        pg8::EpiSwiGLU E{ACT, SS2, DFF}; pg8::gemm_phase<pg8::EpiSwiGLU, pg8::StaticOrder, true, true>(lds, g, S, E); }
    SEAM(8);
    if (IN(9)) {
        { pg8::Gemm g{ACT, W2D, Mrows, DM_, DFF}; pg8::StaticOrder S; S.init(Mrows, DM_, G, bx);
          pg8::EpiResid E{H, H, XN, SS3, 0.5f}; pg8::gemm_phase<pg8::EpiResid, pg8::StaticOrder, true, true>(lds, g, S, E); }
        { pg8::Gemm g{PB, WPP, Mrows, DM_, DPLE}; pg8::StaticOrder S; S.init(Mrows, DM_, G, bx);
          pg8::EpiProj E{PROJ, SSP}; pg8::gemm_phase<pg8::EpiProj, pg8::StaticOrder, true, true>(lds, g, S, E); }
    }
    SEAM(9);
    if (IN(10)) { pg8::Gemm g{XN, WPG, Mrows, DM_, DM_}; pg8::StaticOrder S; S.init(Mrows, DM_, G, bx);
        pg8::EpiPle E{H, PROJ, SS3, SSP, args.in[21], SS4}; pg8::gemm_phase<pg8::EpiPle, pg8::StaticOrder, true, true>(lds, g, S, E); }
    SEAM(10);
    if (IN(11)) {
        const f32x4* gf = (const f32x4*)args.in[22];
        for (int m = gw; m < Mrows; m += NGW) { const float rs = pg8::row_rstd(SS4, m); f32x4* hp = (f32x4*)(H + (size_t)m * 1024) + lane;
#pragma unroll
            for (int j = 0; j < 4; ++j) { const f32x4 v = hp[64 * j]; hp[64 * j] = v * rs * gf[64 * j + lane]; } }
    }
#undef IN
#undef SEAM
}

extern "C" void kernel_launch(void* const* d_in, const int* in_sizes, int n_in, void* d_out, int out_size, void* d_ws, size_t ws_size, hipStream_t stream) {
    static int grid = 0;
    if (grid == 0) {
        if (n_in != 23 || out_size != Mrows * DM_ || ws_size < WS_END) { fprintf(stderr, "kernel_launch: unexpected shapes (n_in %d out %d ws %zu)\n", n_in, out_size, ws_size); grid = -1; return; }
        int dev = 0, cus = 0, per_cu = 0;
        hipGetDevice(&dev); hipDeviceGetAttribute(&cus, hipDeviceAttributeMultiprocessorCount, dev);
        if (hipFuncSetAttribute((const void*)hymba_fwd, hipFuncAttributeMaxDynamicSharedMemorySize, LDS_BYTES) != hipSuccess) { fprintf(stderr, "kernel_launch: hipFuncSetAttribute failed\n"); grid = -1; return; }
        if (hipOccupancyMaxActiveBlocksPerMultiprocessor(&per_cu, (const void*)hymba_fwd, NTHR, LDS_BYTES) != hipSuccess || per_cu < 1) { fprintf(stderr, "kernel_launch: occupancy query says %d\n", per_cu); per_cu = 1; }
        (void)hipGetLastError();
        grid = cus * (per_cu > 1 ? 1 : per_cu);
    }
    if (grid < 0) return;
    if (hipMemsetAsync(d_ws, 0, 65536, stream) != hipSuccess) { fprintf(stderr, "kernel_launch: memset failed\n"); return; }
    Args a{};
    for (int i = 0; i < 23; ++i) a.in[i] = (const float*)d_in[i];
    a.out = (float*)d_out; a.ws = (unsigned char*)d_ws;
#if MK_MULTI
    for (int ph = 0; ph < NPH; ++ph) { a.ph_lo = ph; a.ph_hi = ph + 1; hipLaunchKernelGGL(hymba_fwd, dim3(grid), dim3(NTHR), LDS_BYTES, stream, a); }
#else
    a.ph_lo = 0; a.ph_hi = NPH; void* kargs[] = {&a};
    hipError_t e = hipLaunchCooperativeKernel((void*)hymba_fwd, dim3(grid), dim3(NTHR), kargs, LDS_BYTES, stream);
    if (e != hipSuccess) fprintf(stderr, "cooperative launch failed: %s (grid %d)\n", hipGetErrorString(e), grid);
#endif
}
```

```cpp
#include <hip/hip_runtime.h>
#include <hip/hip_cooperative_groups.h>
#include <hip/hip_bf16.h>
#include <cstdio>
#include <cstdint>
#include <cmath>
namespace cg = cooperative_groups;
namespace pg8 {
#define PG8_LAS __attribute__((address_space(3)))
typedef unsigned short bf16_t;
typedef short bf16x8 __attribute__((ext_vector_type(8)));
typedef float f32x4 __attribute__((ext_vector_type(4)));
typedef unsigned u32x4 __attribute__((ext_vector_type(4)));
constexpr int BM = 256, BK = 64, HALF = 128, HTB = HALF * BK * 2  , STAGE_BYTES = 8 * HTB, NXCD = 8, WGM = 8;

__host__ __device__ __forceinline__ int lds_byte(int r, int c) { const int st = (r >> 4) * 2 + (c >> 5), rr = r & 15, cc = c & 31, ob = rr * 64 + cc * 2; return st * 1024 + (ob ^ (((ob >> 9) & 1) << 5)); }
__host__ __device__ __forceinline__ void stage_rc(int b, int& R, int& C) { const int st = b / 1024, sb = b % 1024, swz = sb ^ (((sb >> 9) & 1) << 5); R = (st >> 1) * 16 + swz / 64; C = (st & 1) * 32 + (swz % 64) / 2; }
__host__ __device__ __forceinline__ int perm32(int rho) { const int n = rho >> 4, i = rho & 15; return 8 * (i >> 2) + 4 * n + (i & 3); }

struct Unit { int pm, pn; };
struct Gemm { const bf16_t* A; const bf16_t* Bt; int M, N, K; };

struct StaticOrder {
    int nM, nN, nwg, G, c;
    __host__ __device__ void init(int M, int N, int G_, int c_) { nM = M / BM; nN = N / BM; nwg = nM * nN; G = G_; c = c_; }
    __host__ __device__ bool next(int i, Unit& u) const {
        const long L = (long)i * G + c; if (L >= nwg) return false;
        int wgid = (int)L; { const int q = nwg / NXCD, r = nwg % NXCD, xcd = wgid % NXCD, off = wgid / NXCD; wgid = (xcd < r ? xcd * (q + 1) : r * (q + 1) + (xcd - r) * q) + off; }
        const int nig = WGM * nN, gid = wgid / nig, fm = gid * WGM, gsz = (nM - fm) < WGM ? (nM - fm) : WGM;
        u.pm = fm + ((wgid % nig) % gsz); u.pn = (wgid % nig) / gsz; return true;
    }
    __device__ __forceinline__ void a_ready(const Unit&) const {}
    __device__ __forceinline__ void done(const Unit&) const {}
};

__device__ __forceinline__ unsigned cvt_pk_bf16(float lo, float hi) { unsigned r; asm volatile("v_cvt_pk_bf16_f32 %0, %1, %2" : "=v"(r) : "v"(lo), "v"(hi)); return r; }
typedef float f32x2 __attribute__((ext_vector_type(2)));
typedef unsigned u32x2 __attribute__((ext_vector_type(2)));
constexpr float RMS_EPS = 1e-6f;
__device__ __forceinline__ float row_rstd(const float* __restrict__ ss, int row) {
    const f32x4* p = (const f32x4*)(ss + (size_t)row * 16);
    const f32x4 a = p[0], b = p[1], c = p[2], d = p[3];
    const float s = (((a[0] + a[1]) + (a[2] + a[3])) + ((b[0] + b[1]) + (b[2] + b[3]))) + (((c[0] + c[1]) + (c[2] + c[3])) + ((d[0] + d[1]) + (d[2] + d[3])));
    return 1.0f / sqrtf(s * (1.0f / 1024.0f) + RMS_EPS);
}
__device__ __forceinline__ float sigmoid_f(float x) { return __builtin_amdgcn_rcpf(1.0f + __builtin_amdgcn_exp2f(-1.4426950408889634f * x)); }
__device__ __forceinline__ float silu_f(float x) { return x * sigmoid_f(x); }

struct EpiSwiGLU {
    static constexpr bool PERM = true, AFTER_DRAIN = false;
    bf16_t* O; const float* ss; int ldo;
    __device__ __forceinline__ void operator()(const f32x4 (&acc)[2][2][4][2], const Unit& u, int wr, int wc, int fr, int fq) const {
        const int row0 = u.pm * BM + wr * 64 + fr, col0 = u.pn * 128 + wc * 32 + 8 * fq;
#pragma unroll
        for (int ai = 0; ai < 2; ++ai)
#pragma unroll
            for (int m = 0; m < 4; ++m) { const int row = row0 + ai * HALF + m * 16; const float rs = row_rstd(ss, row);
                const f32x4 g0 = acc[ai][0][m][0] * rs, g1 = acc[ai][0][m][1] * rs, u0 = acc[ai][1][m][0] * rs, u1 = acc[ai][1][m][1] * rs;
                u32x4 w; w.x = cvt_pk_bf16(silu_f(g0[0]) * u0[0], silu_f(g0[1]) * u0[1]); w.y = cvt_pk_bf16(silu_f(g0[2]) * u0[2], silu_f(g0[3]) * u0[3]);
                w.z = cvt_pk_bf16(silu_f(g1[0]) * u1[0], silu_f(g1[1]) * u1[1]); w.w = cvt_pk_bf16(silu_f(g1[2]) * u1[2], silu_f(g1[3]) * u1[3]);
                *(u32x4*)(O + (size_t)row * ldo + col0) = w; }
    }
};
struct EpiResid {
    static constexpr bool PERM = false, AFTER_DRAIN = false;
    const float* base; float* out; bf16_t* xn; float* sso; float coef;
    __device__ __forceinline__ void operator()(const f32x4 (&acc)[2][2][4][2], const Unit& u, int wr, int wc, int fr, int fq) const {
        const int col0 = u.pn * BM + wc * 32 + 4 * fq;
#pragma unroll
        for (int ai = 0; ai < 2; ++ai)
#pragma unroll
            for (int m = 0; m < 4; ++m) { const int row = u.pm * BM + ai * HALF + wr * 64 + m * 16 + fr; const size_t off = (size_t)row * 1024 + col0; float q = 0.f;
#pragma unroll
                for (int bj = 0; bj < 2; ++bj)
#pragma unroll
                    for (int n = 0; n < 2; ++n) { const f32x4 bs = *(const f32x4*)(base + off + bj * HALF + n * 16); const f32x4 o = bs + acc[ai][bj][m][n] * coef;
                        *(f32x4*)(out + off + bj * HALF + n * 16) = o; q += (o[0] * o[0] + o[1] * o[1]) + (o[2] * o[2] + o[3] * o[3]);
                        u32x2 w; w.x = cvt_pk_bf16(o[0], o[1]); w.y = cvt_pk_bf16(o[2], o[3]); *(u32x2*)(xn + off + bj * HALF + n * 16) = w; }
                q += __shfl_xor(q, 16); q += __shfl_xor(q, 32);
                if (fq == 0) sso[(size_t)row * 16 + u.pn * 4 + wc] = q; }
    }
};
struct EpiZ {
    static constexpr bool PERM = true, AFTER_DRAIN = false;
    bf16_t* Z; float* gates; const float* ss; const float* bm; const float* bf; float qscale;
    __device__ __forceinline__ void operator()(const f32x4 (&acc)[2][2][4][2], const Unit& u, int wr, int wc, int fr, int fq) const {
        const int row0 = u.pm * BM + wr * 64 + fr;
        if (u.pn < 12) {
            const float sc = (u.pn == 6 || u.pn == 7) ? qscale : 1.0f; const int col0 = u.pn * BM + wc * 32 + 8 * fq;
#pragma unroll
            for (int ai = 0; ai < 2; ++ai)
#pragma unroll
                for (int m = 0; m < 4; ++m) { const int row = row0 + ai * HALF + m * 16; const float rs = row_rstd(ss, row) * sc;
#pragma unroll
                    for (int bj = 0; bj < 2; ++bj) { const f32x4 v0 = acc[ai][bj][m][0] * rs, v1 = acc[ai][bj][m][1] * rs;
                        u32x4 w; w.x = cvt_pk_bf16(v0[0], v0[1]); w.y = cvt_pk_bf16(v0[2], v0[3]); w.z = cvt_pk_bf16(v1[0], v1[1]); w.w = cvt_pk_bf16(v1[2], v1[3]);
                        *(u32x4*)(Z + (size_t)row * 3072 + col0 + bj * HALF) = w; } }
        } else if (wc == 0 && fq < 2) {
            const float* bp = fq == 0 ? bm : bf; const f32x4 b0 = *(const f32x4*)bp, b1 = *(const f32x4*)(bp + 4);
#pragma unroll
            for (int ai = 0; ai < 2; ++ai)
#pragma unroll
                for (int m = 0; m < 4; ++m) { const int row = row0 + ai * HALF + m * 16; const float rs = row_rstd(ss, row);
                    *(f32x4*)(gates + (size_t)row * 16 + 8 * fq) = acc[ai][0][m][0] * rs + b0; *(f32x4*)(gates + (size_t)row * 16 + 8 * fq + 4) = acc[ai][0][m][1] * rs + b1; }
        }
    }
};
struct EpiProj {
    static constexpr bool PERM = true, AFTER_DRAIN = false;
    bf16_t* O; float* sso;
    __device__ __forceinline__ void operator()(const f32x4 (&acc)[2][2][4][2], const Unit& u, int wr, int wc, int fr, int fq) const {
        const int row0 = u.pm * BM + wr * 64 + fr, col0 = u.pn * BM + wc * 32 + 8 * fq;
#pragma unroll
        for (int ai = 0; ai < 2; ++ai)
#pragma unroll
            for (int m = 0; m < 4; ++m) { const int row = row0 + ai * HALF + m * 16; float q = 0.f;
#pragma unroll
                for (int bj = 0; bj < 2; ++bj) { const f32x4 v0 = acc[ai][bj][m][0], v1 = acc[ai][bj][m][1];
                    q += ((v0[0] * v0[0] + v0[1] * v0[1]) + (v0[2] * v0[2] + v0[3] * v0[3])) + ((v1[0] * v1[0] + v1[1] * v1[1]) + (v1[2] * v1[2] + v1[3] * v1[3]));
                    u32x4 w; w.x = cvt_pk_bf16(v0[0], v0[1]); w.y = cvt_pk_bf16(v0[2], v0[3]); w.z = cvt_pk_bf16(v1[0], v1[1]); w.w = cvt_pk_bf16(v1[2], v1[3]);
                    *(u32x4*)(O + (size_t)row * 1024 + col0 + bj * HALF) = w; }
                q += __shfl_xor(q, 16); q += __shfl_xor(q, 32);
                if (fq == 0) sso[(size_t)row * 16 + u.pn * 4 + wc] = q; }
    }
};
struct EpiPle {
    static constexpr bool PERM = false, AFTER_DRAIN = false;
    float* H; const bf16_t* proj; const float* ss3; const float* ssp; const float* gp; float* sso;
    __device__ __forceinline__ void operator()(const f32x4 (&acc)[2][2][4][2], const Unit& u, int wr, int wc, int fr, int fq) const {
        const int col0 = u.pn * BM + wc * 32 + 4 * fq;
#pragma unroll
        for (int ai = 0; ai < 2; ++ai)
#pragma unroll
            for (int m = 0; m < 4; ++m) { const int row = u.pm * BM + ai * HALF + wr * 64 + m * 16 + fr; const size_t off = (size_t)row * 1024 + col0; float q = 0.f;
                const float rs3 = row_rstd(ss3, row), rsp = row_rstd(ssp, row);
#pragma unroll
                for (int bj = 0; bj < 2; ++bj)
#pragma unroll
                    for (int n = 0; n < 2; ++n) { const int co = bj * HALF + n * 16; const f32x4 hb = *(const f32x4*)(H + off + co); const u32x2 pw = *(const u32x2*)(proj + off + co);
                        const f32x4 g = *(const f32x4*)(gp + col0 + co); const f32x4 a = acc[ai][bj][m][n] * rs3;
                        f32x4 pr; pr[0] = __uint_as_float(pw.x << 16); pr[1] = __uint_as_float(pw.x & 0xffff0000u); pr[2] = __uint_as_float(pw.y << 16); pr[3] = __uint_as_float(pw.y & 0xffff0000u);
                        f32x4 o;
#pragma unroll
                        for (int i = 0; i < 4; ++i) o[i] = hb[i] + sigmoid_f(a[i]) * (pr[i] * rsp * g[i]);
                        *(f32x4*)(H + off + co) = o; q += (o[0] * o[0] + o[1] * o[1]) + (o[2] * o[2] + o[3] * o[3]); }
                q += __shfl_xor(q, 16); q += __shfl_xor(q, 32);
                if (fq == 0) sso[(size_t)row * 16 + u.pn * 4 + wc] = q; }
    }
};

template <class Epi, class Sched, bool ALIGN_EPI = false, bool SP2 = false>
__device__ __forceinline__ void gemm_phase(PG8_LAS unsigned char* lds, const Gemm g, const Sched& S, const Epi& E) {
    const int tid = threadIdx.x, wid = __builtin_amdgcn_readfirstlane(tid >> 6), lane = tid & 63, wr = wid >> 2, wc = wid & 3, fr = lane & 15, fq = lane >> 4;
    const int K = g.K, nt = K / BK;
    unsigned voffA[2], voffB[2];
#pragma unroll
    for (int i = 0; i < 2; ++i) { int R, C; stage_rc(tid * 16 + i * 8192, R, C); const int Rb = Epi::PERM ? ((R & ~31) + perm32(R & 31)) : R;
        voffA[i] = (unsigned)(R * K + C) * 2u; voffB[i] = (unsigned)(Rb * K + C) * 2u; }
    const size_t kstep = (size_t)(BK * 2);
    const size_t hstep = (size_t)HALF * K * 2;
    const size_t tstep = 2 * hstep;
    const unsigned ldsw = (unsigned)wid * 1024u;
    const int aoff = lds_byte(wr * 64 + fr, fq * 8), boff = lds_byte(wc * 32 + fr, fq * 8);
#define PG8_SA(b, h) (((b) * 2 + (h)) * HTB)
#define PG8_SB(b, h) ((4 + (b) * 2 + (h)) * HTB)
#define PG8_STAGE(bufoff, gbase, voff) do { _Pragma("unroll") for (int _i = 0; _i < 2; ++_i) \
        __builtin_amdgcn_global_load_lds((const unsigned*)((const char*)(gbase) + (voff)[_i]), (PG8_LAS unsigned*)(lds + (bufoff) + ldsw + _i * 8192), 16, 0, 0); } while (0)
#define PG8_LDA(dst, b, h) do { _Pragma("unroll") for (int m = 0; m < 4; ++m) _Pragma("unroll") for (int k = 0; k < 2; ++k) dst[m][k] = *(const PG8_LAS bf16x8*)(lds + PG8_SA(b, h) + aoff + m * 2048 + k * 1024); } while (0)
#define PG8_LDB(dst, b, h) do { _Pragma("unroll") for (int n = 0; n < 2; ++n) _Pragma("unroll") for (int k = 0; k < 2; ++k) dst[n][k] = *(const PG8_LAS bf16x8*)(lds + PG8_SB(b, h) + boff + n * 2048 + k * 1024); } while (0)
#define PG8_MMA(ai, bj, At, Bt) do { __builtin_amdgcn_s_setprio(1); _Pragma("unroll") for (int m = 0; m < 4; ++m) _Pragma("unroll") for (int n = 0; n < 2; ++n) _Pragma("unroll") for (int k = 0; k < 2; ++k) \
        acc[ai][bj][m][n] = __builtin_amdgcn_mfma_f32_16x16x32_bf16(Bt[n][k], At[m][k], acc[ai][bj][m][n], 0, 0, 0); __builtin_amdgcn_s_setprio(0); } while (0)
#define PG8_WAIT_V(n) asm volatile("s_waitcnt vmcnt(" #n ")" ::: "memory")
#define PG8_WAIT_L(n) asm volatile("s_waitcnt lgkmcnt(" #n ")" ::: "memory")
#define PG8_BAR __builtin_amdgcn_s_barrier()
#define PG8_SCHED __builtin_amdgcn_sched_barrier(0)
    Unit cur, nxt; int ui = 0;
    if (!S.next(0, cur)) return;
    f32x4 acc[2][2][4][2];
#pragma unroll
    for (int a = 0; a < 2; ++a)
#pragma unroll
        for (int b = 0; b < 2; ++b)
#pragma unroll
            for (int m = 0; m < 4; ++m)
#pragma unroll
                for (int n = 0; n < 2; ++n) acc[a][b][m][n] = (f32x4){0.f, 0.f, 0.f, 0.f};
    bf16x8 At[4][2], B0[2][2], B1[2][2];
    const char* cA = (const char*)g.A + (size_t)cur.pm * tstep; const char* cB = (const char*)g.Bt + (size_t)cur.pn * tstep;
    S.a_ready(cur);
    if constexpr (SP2) {
        PG8_STAGE(PG8_SB(0, 0), cB, voffB); PG8_STAGE(PG8_SB(0, 1), cB + hstep, voffB); PG8_STAGE(PG8_SA(0, 0), cA, voffA); PG8_STAGE(PG8_SA(0, 1), cA + hstep, voffA);
        if (wr == 1) PG8_BAR;
        PG8_WAIT_V(2); PG8_BAR;
        PG8_STAGE(PG8_SB(1, 0), cB + kstep, voffB); PG8_STAGE(PG8_SA(1, 0), cA + kstep, voffA); PG8_STAGE(PG8_SB(1, 1), cB + hstep + kstep, voffB);
        PG8_WAIT_V(6); PG8_BAR;
    } else {
        PG8_STAGE(PG8_SB(0, 0), cB, voffB); PG8_STAGE(PG8_SA(0, 0), cA, voffA); PG8_STAGE(PG8_SB(0, 1), cB + hstep, voffB); PG8_STAGE(PG8_SA(0, 1), cA + hstep, voffA);
        if (wr == 1) PG8_BAR;
        PG8_WAIT_V(4); PG8_BAR;
        PG8_STAGE(PG8_SB(1, 0), cB + kstep, voffB); PG8_STAGE(PG8_SA(1, 0), cA + kstep, voffA); PG8_STAGE(PG8_SB(1, 1), cB + hstep + kstep, voffB);
        PG8_WAIT_V(6); PG8_BAR;
    }
    for (;;) {
        const bool has_next = S.next(ui + 1, nxt);
        const char* nA = has_next ? (const char*)g.A + (size_t)nxt.pm * tstep : cA; const char* nB = has_next ? (const char*)g.Bt + (size_t)nxt.pn * tstep : cB;
        for (int t = 0; t < nt; t += 2) {
            const bool last = (t == nt - 2);
            const char* a1 = cA + (size_t)(t + 1) * kstep;
            const char* a2 = last ? nA : cA + (size_t)(t + 2) * kstep; const char* b2 = last ? nB : cB + (size_t)(t + 2) * kstep;
            const char* a3 = a2 + kstep; const char* b3 = b2 + kstep;
            if (last && has_next) S.a_ready(nxt);
            if constexpr (SP2) {
            PG8_LDB(B0, 0, 0); PG8_LDB(B1, 0, 1); PG8_SCHED; PG8_LDA(At, 0, 0); PG8_STAGE(PG8_SA(1, 1), a1 + hstep, voffA);
            PG8_WAIT_V(8); PG8_WAIT_L(0); PG8_BAR; PG8_MMA(0, 0, At, B0); PG8_MMA(0, 1, At, B1); PG8_BAR; PG8_SCHED;
            PG8_LDA(At, 0, 1); PG8_STAGE(PG8_SB(0, 0), b2, voffB); PG8_STAGE(PG8_SB(0, 1), b2 + hstep, voffB); PG8_STAGE(PG8_SA(0, 0), a2, voffA);
            PG8_WAIT_V(8); PG8_WAIT_L(0); PG8_BAR; PG8_MMA(1, 0, At, B0); PG8_MMA(1, 1, At, B1); PG8_BAR; PG8_SCHED;
            PG8_LDB(B0, 1, 0); PG8_LDB(B1, 1, 1); PG8_SCHED; PG8_LDA(At, 1, 0); PG8_STAGE(PG8_SA(0, 1), a2 + hstep, voffA);
            PG8_WAIT_V(8); PG8_WAIT_L(0); PG8_BAR; PG8_MMA(0, 0, At, B0); PG8_MMA(0, 1, At, B1); PG8_BAR; PG8_SCHED;
            PG8_LDA(At, 1, 1); PG8_STAGE(PG8_SB(1, 0), b3, voffB); PG8_STAGE(PG8_SB(1, 1), b3 + hstep, voffB); PG8_STAGE(PG8_SA(1, 0), a3, voffA);
            PG8_WAIT_V(8); PG8_WAIT_L(0); PG8_BAR; PG8_MMA(1, 0, At, B0); PG8_MMA(1, 1, At, B1); PG8_BAR; PG8_SCHED;
            } else {
            PG8_LDB(B0, 0, 0); PG8_SCHED; PG8_LDA(At, 0, 0); PG8_STAGE(PG8_SA(1, 1), a1 + hstep, voffA);
            PG8_WAIT_L(8); PG8_BAR; PG8_WAIT_L(0); PG8_MMA(0, 0, At, B0); PG8_BAR; PG8_SCHED;
            PG8_LDB(B1, 0, 1); PG8_STAGE(PG8_SB(0, 0), b2, voffB);
            PG8_BAR; PG8_WAIT_L(0); PG8_MMA(0, 1, At, B1); PG8_BAR;
            PG8_LDA(At, 0, 1); PG8_STAGE(PG8_SA(0, 0), a2, voffA);
            PG8_BAR; PG8_WAIT_L(0); PG8_MMA(1, 0, At, B0); PG8_BAR; PG8_SCHED;
            PG8_STAGE(PG8_SB(0, 1), b2 + hstep, voffB);
            PG8_WAIT_V(6); PG8_BAR; PG8_MMA(1, 1, At, B1); PG8_BAR;
            PG8_LDB(B0, 1, 0); PG8_SCHED; PG8_LDA(At, 1, 0); PG8_STAGE(PG8_SA(0, 1), a2 + hstep, voffA);
            PG8_WAIT_L(8); PG8_BAR; PG8_WAIT_L(0); PG8_MMA(0, 0, At, B0); PG8_BAR; PG8_SCHED;
            PG8_LDB(B1, 1, 1); PG8_STAGE(PG8_SB(1, 0), b3, voffB);
            PG8_BAR; PG8_WAIT_L(0); PG8_MMA(0, 1, At, B1); PG8_BAR;
            PG8_LDA(At, 1, 1); PG8_STAGE(PG8_SA(1, 0), a3, voffA);
            PG8_BAR; PG8_WAIT_L(0); PG8_MMA(1, 0, At, B0); PG8_BAR; PG8_SCHED;
            PG8_STAGE(PG8_SB(1, 1), b3 + hstep, voffB);
            PG8_WAIT_V(6); PG8_BAR; PG8_MMA(1, 1, At, B1); PG8_BAR;
            }
        }
        if constexpr (ALIGN_EPI) { if (wr == 0) PG8_BAR; }
        if constexpr (!Epi::AFTER_DRAIN) { E(acc, cur, wr, wc, fr, fq); S.done(cur); }
        if (!has_next) break;
#pragma unroll
        for (int a = 0; a < 2; ++a)
#pragma unroll
            for (int b = 0; b < 2; ++b)
#pragma unroll
                for (int m = 0; m < 4; ++m)
#pragma unroll
                    for (int n = 0; n < 2; ++n) acc[a][b][m][n] = (f32x4){0.f, 0.f, 0.f, 0.f};
        cur = nxt; cA = nA; cB = nB; ++ui;
        if constexpr (ALIGN_EPI) { if (wr == 1) PG8_BAR; }
    }
    PG8_WAIT_V(0);
    if constexpr (!ALIGN_EPI) { if (wr == 0) PG8_BAR; }
    PG8_BAR;
    if constexpr (Epi::AFTER_DRAIN) { E.fused(acc, cur, wr, wc, fr, fq, lds, wid, lane); S.done(cur); }
#undef PG8_SA
#undef PG8_SB
#undef PG8_STAGE
#undef PG8_LDA
#undef PG8_LDB
#undef PG8_MMA
#undef PG8_WAIT_V
#undef PG8_WAIT_L
#undef PG8_BAR
#undef PG8_SCHED
}
}

#ifndef PG8_SP2
#define PG8_SP2 true
#endif
#include <hip/hip_bf16.h>
#include <cmath>
namespace attn_body {
using bf16=__hip_bfloat16;
using bf16x8=__attribute__((ext_vector_type(8)))short;
using s16x4=__attribute__((ext_vector_type(4)))short;
using f32x16=__attribute__((ext_vector_type(16)))float;
using u32x4=__attribute__((ext_vector_type(4)))unsigned;
constexpr int BATCH=8,NHEAD=8,SEQ=4096,D=64,DM=3072,OPITCH=1024;
constexpr int NW=8,QBLK=32,QB=QBLK*NW,KVBLK=64,NQB=SEQ/QB;
constexpr int ATTN_PITCH=DM, ATTN_UNIT_ROWS=QB;
__device__ __forceinline__ int crow(int r,int hi){return (r&3)+8*(r>>2)+4*hi;}
#define SBAR() __builtin_amdgcn_sched_barrier(0)
__device__ __forceinline__ void cmask(f32x16&p0,f32x16&p1,int jb,int qrel,int hi){
  const float NEG=-INFINITY; int kb=64*jb+4*hi;
  #pragma unroll
  for(int r=0;r<16;++r){int kv=kb+(r&3)+8*(r>>2); if(kv>qrel)p0[r]=NEG; if(kv+32>qrel)p1[r]=NEG;}
}

constexpr int NSLOT=3, SLOTB=8192;
constexpr int LDS_K=0, LDS_V=NSLOT*SLOTB, LDS_WS=2*NSLOT*SLOTB, LDS_OST=LDS_WS+NW*64*4, LDS_BYTES=LDS_OST+NW*4096;
constexpr float C2=0.125f*1.4426950408889634f;
__device__ __forceinline__ void glds16(const void*gsrc,unsigned lds_dst){unsigned keep;
  asm volatile("s_mov_b32 %0, m0\n\ts_mov_b32 m0, %2\n\ts_nop 0\n\tglobal_load_lds_dwordx4 %1, off\n\ts_mov_b32 m0, %0":"=&s"(keep):"v"(gsrc),"s"(lds_dst):"memory");}
__device__ __forceinline__ float max3f(float a,float b,float c){float r;asm("v_max3_f32 %0, %1, %2, %3":"=v"(r):"v"(a),"v"(b),"v"(c));return r;}
__device__ __forceinline__ float max2f(float a,float b){float r;asm("v_max_f32_e32 %0, %1, %2":"=v"(r):"v"(a),"v"(b));return r;}
__device__ __forceinline__ float fadd_s(float a,float b){float r;asm("v_add_f32_e32 %0, %1, %2":"=v"(r):"v"(a),"v"(b));return r;}
__device__ __forceinline__ float fsub_s(float a,float b){float r;asm("v_sub_f32_e32 %0, %1, %2":"=v"(r):"v"(a),"v"(b));return r;}
typedef float f32x2_t __attribute__((ext_vector_type(2))); typedef float f32x4_t __attribute__((ext_vector_type(4))); typedef __bf16 bf16x2_t __attribute__((ext_vector_type(2)));
__device__ __forceinline__ unsigned cvtpk_s(float lo,float hi){f32x2_t v={lo,hi};bf16x2_t b=__builtin_convertvector(v,bf16x2_t);return __builtin_bit_cast(unsigned,b);}
#define WAIT_BAR(N) asm volatile("s_waitcnt vmcnt(" #N ") lgkmcnt(0)\n\ts_barrier":::"memory")

__device__ __forceinline__ void qkt(f32x16&p0,f32x16&p1,const char*Kslot,const bf16x8*qr,int r32,int hi){
  const char*kb=Kslot+hi*1024+r32*16;
  #pragma unroll
  for(int d0=0;d0<4;++d0){
    const bf16x8 b0=*reinterpret_cast<const bf16x8*>(kb+d0*2048);
    const bf16x8 b1=*reinterpret_cast<const bf16x8*>(kb+d0*2048+512);
    p0=__builtin_amdgcn_mfma_f32_32x32x16_bf16(b0,qr[d0],p0,0,0,0);p1=__builtin_amdgcn_mfma_f32_32x32x16_bf16(b1,qr[d0],p1,0,0,0);}
}
typedef __attribute__((address_space(3))) const char* lds_cptr;
typedef short v4i16_t __attribute__((ext_vector_type(4)));
__device__ __forceinline__ void kload8(bf16x8*kf,lds_cptr kp){
  kf[0]=*(const __attribute__((address_space(3))) bf16x8*)(kp);      kf[1]=*(const __attribute__((address_space(3))) bf16x8*)(kp+512);
  kf[2]=*(const __attribute__((address_space(3))) bf16x8*)(kp+2048); kf[3]=*(const __attribute__((address_space(3))) bf16x8*)(kp+2560);
  kf[4]=*(const __attribute__((address_space(3))) bf16x8*)(kp+4096); kf[5]=*(const __attribute__((address_space(3))) bf16x8*)(kp+4608);
  kf[6]=*(const __attribute__((address_space(3))) bf16x8*)(kp+6144); kf[7]=*(const __attribute__((address_space(3))) bf16x8*)(kp+6656);
}
__device__ __forceinline__ void kload2(bf16x8*kf,lds_cptr kp,int j){ kf[2*j]=*(const __attribute__((address_space(3))) bf16x8*)(kp+j*2048); kf[2*j+1]=*(const __attribute__((address_space(3))) bf16x8*)(kp+j*2048+512); }
__device__ __forceinline__ s16x4 vtr(lds_cptr p){ return __builtin_bit_cast(s16x4,__builtin_amdgcn_ds_read_tr16_b64_v4i16((__attribute__((address_space(3))) v4i16_t*)p)); }
__device__ __forceinline__ float rowmax(const f32x16&p0,const f32x16&p1){
  float a=max3f(p0[0],p0[1],p1[0]),b=max3f(p0[2],p0[3],p1[1]);a=max3f(a,p1[2],p1[3]);
  #pragma unroll
  for(int r=4;r<16;r+=4){a=max3f(a,p0[r],p0[r+1]);b=max3f(b,p0[r+2],p0[r+3]);a=max3f(a,p1[r],p1[r+1]);b=max3f(b,p1[r+2],p1[r+3]);}
  const float m=max2f(a,b);
  auto rr=__builtin_amdgcn_permlane32_swap(__float_as_uint(m),__float_as_uint(m),false,false);
  return max2f(__uint_as_float(rr[0]),__uint_as_float(rr[1]));
}
__device__ __forceinline__ void pv(f32x16*o,int vb,bf16x8 pa0,bf16x8 pa1,bf16x8 pa2,bf16x8 pa3){
  #pragma unroll
  for(int d0=0;d0<2;++d0){s16x4 lo[4],hi[4];
    #pragma unroll
    for(int ks=0;ks<4;++ks){
      asm volatile("ds_read_b64_tr_b16 %0,%1 offset:%c2":"=&v"(lo[ks]):"v"(vb),"i"(d0*4096+ks*1024):"memory");
      asm volatile("ds_read_b64_tr_b16 %0,%1 offset:%c2":"=&v"(hi[ks]):"v"(vb),"i"(d0*4096+ks*1024+512):"memory");}
    asm volatile("s_waitcnt lgkmcnt(0)":::"memory");SBAR();
    #define PK(k) (bf16x8){lo[k][0],lo[k][1],lo[k][2],lo[k][3],hi[k][0],hi[k][1],hi[k][2],hi[k][3]}
    o[d0]=__builtin_amdgcn_mfma_f32_32x32x16_bf16(pa0,PK(0),o[d0],0,0,0);
    o[d0]=__builtin_amdgcn_mfma_f32_32x32x16_bf16(pa1,PK(1),o[d0],0,0,0);
    o[d0]=__builtin_amdgcn_mfma_f32_32x32x16_bf16(pa2,PK(2),o[d0],0,0,0);
    o[d0]=__builtin_amdgcn_mfma_f32_32x32x16_bf16(pa3,PK(3),o[d0],0,0,0);
    #undef PK
  }
}

#ifndef ATTN_STORE16
#define ATTN_STORE16(p,v) (*(u32x4*)(p)=(v))
#endif
typedef __attribute__((address_space(3))) const float* lds_fptr; typedef __attribute__((address_space(3))) const f32x4_t* lds_f4ptr;
template<int THRL> __device__ __forceinline__ void attn_unit(int b,int h,int qb,const bf16*Q,const bf16*__restrict__ K,const bf16*__restrict__ V,bf16*O,char*shm,lds_fptr cl,const float*__restrict__ gain){
  const int tid=threadIdx.x,lane=tid&63,r32=lane&31,hi=lane>>5; const int wid=__builtin_amdgcn_readfirstlane(tid>>6);
  const long rowbase=(long)b*SEQ; const int q0=qb*QB;
  const bf16*Qw=Q+(rowbase+q0+wid*QBLK)*DM+h*D;
  const bf16*Kh=K+rowbase*DM+h*D,*Vh=V+rowbase*DM+h*D;
  const unsigned lds0=(unsigned)(uintptr_t)shm;
  float*wsf=(float*)(shm+LDS_WS)+wid*64;
  const bf16*ksrc=Kh+(long)lane*DM+wid*8;
  const bf16*vsrc=Vh+(long)(16*(wid&3)+(lane>>2))*DM+(wid>>2)*32+(lane&3)*8;
  const unsigned kdst=lds0+LDS_K+wid*1024, vdst=lds0+LDS_V+wid*1024;
  #define DMA_K(t,slot) glds16(ksrc+(long)(t)*KVBLK*DM,(unsigned)__builtin_amdgcn_readfirstlane(kdst+(slot)))
  #define DMA_V(t,slot) glds16(vsrc+(long)(t)*KVBLK*DM,(unsigned)__builtin_amdgcn_readfirstlane(vdst+(slot)))
  const int vb0=(int)(lds0+LDS_V)+((lane>>4)&1)*32+(lane&3)*8+(4*hi+((lane&15)>>2))*64;
  const char*Kbase=shm+LDS_K; bf16x8 kf[8];
  const lds_cptr shm3=(lds_cptr)shm; const lds_cptr kp0=shm3+LDS_K+hi*1024+r32*16; const lds_cptr vp0=shm3+LDS_V+((lane>>4)&1)*32+(lane&3)*8+(4*hi+((lane&15)>>2))*64;
  const int NT=(q0+QB)/KVBLK;
  DMA_K(0,0);DMA_V(0,0);DMA_K(1,SLOTB);
  bf16x8 qr[4];
  #pragma unroll
  for(int d0=0;d0<4;++d0)qr[d0]=*reinterpret_cast<const bf16x8*>(&Qw[(long)r32*DM+d0*16+hi*8]);
  float l_reg=0.f;f32x16 o[2];o[0]=f32x16{};o[1]=f32x16{};
  const int qrel=wid*QBLK+r32;
  float aq=cl[q0+qrel];
  #define CINIT(C0,C1,t) do{ const lds_f4ptr cp_=(lds_f4ptr)(cl+64*(t)+4*hi); _Pragma("unroll") for(int j_=0;j_<4;++j_){ const f32x4_t v0_=cp_[2*j_],v1_=cp_[8+2*j_]; _Pragma("unroll") for(int i_=0;i_<4;++i_){ C0[4*j_+i_]=aq-v0_[i_]; C1[4*j_+i_]=aq-v1_[i_]; } } }while(0)
  #define CMASK(P0,P1,t) do{int jb_=(t)-(NT-4); if(jb_>=0)cmask(P0,P1,jb_,qrel,hi);}while(0)
  bool resc=false;
  #define START(P0,P1) do{ const float rm=rowmax(P0,P1); resc=false; \
    { const float dl=__builtin_fmaxf(rm,0.f);     aq=fsub_s(aq,dl); \
      _Pragma("unroll") for(int r=0;r<16;++r){P0[r]=fsub_s(P0[r],dl);P1[r]=fsub_s(P1[r],dl);} } \
    _Pragma("unroll") for(int r=0;r<16;++r)P0[r]=__builtin_amdgcn_exp2f(P0[r]); }while(0)
  #define RESC() do{ if(resc){ asm volatile("s_waitcnt lgkmcnt(0)":::"memory"); \
      _Pragma("unroll") for(int d_=0;d_<2;++d_) _Pragma("unroll") for(int r=0;r<16;++r)o[d_][r]*=wsf[crow(r,hi)]; } }while(0)
  f32x16 pA0,pA1,pB0,pB1;
  int sl_prev=0,sl_cur=0,sl_next=SLOTB;
  #define ROT() do{sl_prev=sl_cur;sl_cur=sl_next;sl_next=(sl_next==(NSLOT-1)*SLOTB)?0:sl_next+SLOTB;}while(0)
  DMA_K(2,2*SLOTB);
  WAIT_BAR(3);
  CINIT(pA0,pA1,0);qkt(pA0,pA1,Kbase,qr,r32,hi);asm volatile("s_nop 15\n\ts_nop 7":"+v"(pA0),"+v"(pA1));CMASK(pA0,pA1,0);
  START(pA0,pA1);
  _Pragma("unroll") for(int r=0;r<16;++r)pA1[r]=__builtin_amdgcn_exp2f(pA1[r]);
  WAIT_BAR(0);
  DMA_K(3,0);DMA_V(1,SLOTB);
  ROT();
  kload8(kf,kp0+sl_cur);
  WAIT_BAR(2);
  s16x4 vlo[8],vhi[8]; u32x4 pw0,pw1,pw2,pw3;
  #define PKW(P,B) cvtpk_s(P[B],P[B+1])
  #define PAF(k) __builtin_bit_cast(bf16x8,pw##k)
  #define VFR(i) (bf16x8){vlo[i][0],vlo[i][1],vlo[i][2],vlo[i][3],vhi[i][0],vhi[i][1],vhi[i][2],vhi[i][3]}
  #define PIN(x) asm volatile("":"+v"(x))
  #define MX3(a,b,c) __builtin_fmaxf(__builtin_fmaxf((a),(b)),(c))
  #define GAPA(MF,A0,A1,A2,A3,W0,W1,PW) do{ MF; sacc+=A0; sacc+=A1; sacc+=A2; sacc+=A3; PIN(sacc); W0; W1; PIN(PW); SBAR(); }while(0)
  #define EX(v) __builtin_amdgcn_exp2f(v)
  #define GAPB(MF,X,B) do{ MF; X[B]=EX(X[B]); X[B+1]=EX(X[B+1]); X[B+2]=EX(X[B+2]); X[B+3]=EX(X[B+3]); PIN(X); SBAR(); }while(0)
  #define VRD(i) do{ vlo[i]=vtr(vp_+(((i)>>2)*4096+((i)&3)*1024)); vhi[i]=vtr(vp_+(((i)>>2)*4096+((i)&3)*1024+512)); }while(0)
  #define KRD(G,j) do{ if(G){ kload2(kf,kp0+sl_next,j); SBAR(); } }while(0)
  #define STEP(C0,C1,P0,P1,t,GK,GV,GL) do{ SBAR(); CINIT(C0,C1,t); SBAR(); \
    const lds_cptr vp_=vp0+sl_prev; \
    VRD(0); SBAR(); float sacc=(P0[0]+P0[1]); \
    GAPA(C0=__builtin_amdgcn_mfma_f32_32x32x16_bf16(kf[0],qr[0],C0,0,0,0), P0[2],P0[3],P0[4],P0[5],     pw0[0]=PKW(P0,0), pw0[1]=PKW(P0,2), pw0); \
    VRD(4); SBAR(); GAPA(C1=__builtin_amdgcn_mfma_f32_32x32x16_bf16(kf[1],qr[0],C1,0,0,0), P0[6],P0[7],P0[8],P0[9],     pw0[2]=PKW(P0,4), pw0[3]=PKW(P0,6), pw0); \
    VRD(1); SBAR(); GAPA(C0=__builtin_amdgcn_mfma_f32_32x32x16_bf16(kf[2],qr[1],C0,0,0,0),   P0[10],P0[11],P0[12],P0[13], pw1[0]=PKW(P0,8), pw1[1]=PKW(P0,10), pw1); \
    VRD(5); SBAR(); GAPA(C1=__builtin_amdgcn_mfma_f32_32x32x16_bf16(kf[3],qr[1],C1,0,0,0),   P0[14],P0[15],P1[0],P1[1],   pw1[2]=PKW(P0,12),pw1[3]=PKW(P0,14), pw1); \
    VRD(2); SBAR(); GAPA(C0=__builtin_amdgcn_mfma_f32_32x32x16_bf16(kf[4],qr[2],C0,0,0,0),   P1[2],P1[3],P1[4],P1[5],     pw2[0]=PKW(P1,0), pw2[1]=PKW(P1,2), pw2); \
    VRD(6); SBAR(); GAPA(C1=__builtin_amdgcn_mfma_f32_32x32x16_bf16(kf[5],qr[2],C1,0,0,0),   P1[6],P1[7],P1[8],P1[9],     pw2[2]=PKW(P1,4), pw2[3]=PKW(P1,6), pw2); \
    VRD(3); SBAR(); GAPA(C0=__builtin_amdgcn_mfma_f32_32x32x16_bf16(kf[6],qr[3],C0,0,0,0),   P1[10],P1[11],P1[12],P1[13], pw3[0]=PKW(P1,8), pw3[1]=PKW(P1,10), pw3); \
    VRD(7); SBAR(); GAPA(C1=__builtin_amdgcn_mfma_f32_32x32x16_bf16(kf[7],qr[3],C1,0,0,0),   P1[14],P1[15],0.f,0.f,       pw3[2]=PKW(P1,12),pw3[3]=PKW(P1,14), pw3); \
    l_reg+=sacc; \
    if(GK){DMA_K((t)+3,sl_cur);} if(GV){DMA_V((t)+1,sl_next);} \
    CMASK(C0,C1,t); \
    { float a=MX3(C0[0],C0[1],C1[0]),b=MX3(C0[2],C0[3],C1[1]); a=MX3(a,C1[2],C1[3]); \
      _Pragma("unroll") for(int r=4;r<16;r+=4){a=MX3(a,C0[r],C0[r+1]);b=MX3(b,C0[r+2],C0[r+3]);a=MX3(a,C1[r],C1[r+1]);b=MX3(b,C1[r+2],C1[r+3]);} \
      float rm=__builtin_fmaxf(a,b); { auto rr=__builtin_amdgcn_permlane32_swap(__float_as_uint(rm),__float_as_uint(rm),false,false); rm=__builtin_fmaxf(__uint_as_float(rr[0]),__uint_as_float(rr[1])); } \
      resc=false; \
      if(__builtin_expect(__any(rm>(float)THRL),0)){ const float dl=__builtin_fmaxf(rm,0.f); aq-=dl; \
        _Pragma("unroll") for(int r=0;r<16;++r){C0[r]-=dl;C1[r]-=dl;} \
        const float f=__builtin_amdgcn_exp2f(-dl); l_reg*=f; if(hi==0)wsf[r32]=f; resc=true; } } \
    SBAR(); \
    GAPB(o[0]=__builtin_amdgcn_mfma_f32_32x32x16_bf16(PAF(0),VFR(0),o[0],0,0,0), C0,0); \
    GAPB(o[1]=__builtin_amdgcn_mfma_f32_32x32x16_bf16(PAF(0),VFR(4),o[1],0,0,0), C0,4); \
    KRD(GL,0); GAPB(o[0]=__builtin_amdgcn_mfma_f32_32x32x16_bf16(PAF(1),VFR(1),o[0],0,0,0), C0,8); \
    KRD(GL,1); GAPB(o[1]=__builtin_amdgcn_mfma_f32_32x32x16_bf16(PAF(1),VFR(5),o[1],0,0,0), C0,12); \
    KRD(GL,2); GAPB(o[0]=__builtin_amdgcn_mfma_f32_32x32x16_bf16(PAF(2),VFR(2),o[0],0,0,0), C1,0); \
    KRD(GL,3); GAPB(o[1]=__builtin_amdgcn_mfma_f32_32x32x16_bf16(PAF(2),VFR(6),o[1],0,0,0), C1,4); \
    GAPB(o[0]=__builtin_amdgcn_mfma_f32_32x32x16_bf16(PAF(3),VFR(3),o[0],0,0,0), C1,8); \
    GAPB(o[1]=__builtin_amdgcn_mfma_f32_32x32x16_bf16(PAF(3),VFR(7),o[1],0,0,0), C1,12); \
    }while(0)
  int t=1;
  #undef CMASK
  #define CMASK(P0,P1,t) do{}while(0)
  for(;t+5<NT;t+=2){
    STEP(pB0,pB1,pA0,pA1,t,true,true,true);     WAIT_BAR(2); RESC(); ROT();
    STEP(pA0,pA1,pB0,pB1,t+1,true,true,true);   WAIT_BAR(2); RESC(); ROT();
  }
  #undef CMASK
  #define CMASK(P0,P1,t) do{int jb_=(t)-(NT-4); if(jb_>=0)cmask(P0,P1,jb_,qrel,hi);}while(0)
  #define ENDW(tt) do{ if((tt)+3<NT){WAIT_BAR(2);} else if((tt)+2<NT){WAIT_BAR(1);} else {WAIT_BAR(0);} }while(0)
  for(;t+1<NT;t+=2){
    STEP(pB0,pB1,pA0,pA1,t,(t+3<NT),(t+1<NT),(t+1<NT));       ENDW(t);   RESC(); ROT();
    STEP(pA0,pA1,pB0,pB1,t+1,(t+4<NT),(t+2<NT),(t+2<NT));     ENDW(t+1); RESC(); ROT();
  }
  STEP(pB0,pB1,pA0,pA1,NT-1,false,false,false); RESC();
  { float sacc=pB0[0]+pB0[1]; _Pragma("unroll") for(int r=2;r<16;++r)sacc+=pB0[r]; _Pragma("unroll") for(int r=0;r<16;++r)sacc+=pB1[r]; l_reg+=sacc;
    pw0=(u32x4){PKW(pB0,0),PKW(pB0,2),PKW(pB0,4),PKW(pB0,6)};pw1=(u32x4){PKW(pB0,8),PKW(pB0,10),PKW(pB0,12),PKW(pB0,14)};pw2=(u32x4){PKW(pB1,0),PKW(pB1,2),PKW(pB1,4),PKW(pB1,6)};pw3=(u32x4){PKW(pB1,8),PKW(pB1,10),PKW(pB1,12),PKW(pB1,14)};
    SBAR(); pv(o,vb0+sl_cur,PAF(0),PAF(1),PAF(2),PAF(3)); }
  #undef PKW
  #undef PAF
  #undef VFR
  #undef PIN
  #undef MX3
  #undef GAPA
  #undef GAPB
  #undef EX
  #undef VRD
  #undef KRD
  #undef STEP
  #undef ENDW
  {auto rr=__builtin_amdgcn_permlane32_swap(__float_as_uint(l_reg),__float_as_uint(l_reg),false,false);l_reg=__uint_as_float(rr[0])+__uint_as_float(rr[1]);}
  if(hi==0)wsf[32+r32]=l_reg;asm volatile("s_waitcnt lgkmcnt(0)":::"memory");
  float rli[16];
  #pragma unroll
  for(int r=0;r<16;++r)rli[r]=__builtin_amdgcn_rcpf(wsf[32+crow(r,hi)]);
  bf16*Ow=O+(rowbase+q0+wid*QBLK)*OPITCH+h*D;
  { bf16*stg=(bf16*)(shm+LDS_OST)+wid*2048;
    #pragma unroll
    for(int r=0;r<16;++r){const int orow=crow(r,hi);
      #pragma unroll
      for(int d0=0;d0<2;++d0)stg[orow*64+d0*32+r32]=__float2bfloat16(o[d0][r]*rli[r]);}
    asm volatile("s_waitcnt lgkmcnt(0)":::"memory");
    #pragma unroll
    for(int i=0;i<4;++i){const int row=i*8+(lane>>3),ch=lane&7; const u32x4 v=*(const u32x4*)(stg+row*64+ch*8);
      float x[8]; _Pragma("unroll") for(int k=0;k<4;++k){x[2*k]=__uint_as_float(v[k]<<16);x[2*k+1]=__uint_as_float(v[k]&0xffff0000u);}
      float ss=0.f; _Pragma("unroll") for(int k=0;k<8;++k)ss+=x[k]*x[k];
      ss+=__shfl_xor(ss,1);ss+=__shfl_xor(ss,2);ss+=__shfl_xor(ss,4);
      const float rs=1.0f/sqrtf(ss*(1.0f/64.0f)+1e-6f); const f32x4_t g0=*(const f32x4_t*)(gain+h*D+ch*8),g1=*(const f32x4_t*)(gain+h*D+ch*8+4);
      u32x4 w; w[0]=cvtpk_s(x[0]*rs*g0[0],x[1]*rs*g0[1]);w[1]=cvtpk_s(x[2]*rs*g0[2],x[3]*rs*g0[3]);w[2]=cvtpk_s(x[4]*rs*g1[0],x[5]*rs*g1[1]);w[3]=cvtpk_s(x[6]*rs*g1[2],x[7]*rs*g1[3]);
      ATTN_STORE16(Ow+(long)row*OPITCH+ch*8,w);} }
  asm volatile("s_waitcnt lgkmcnt(0)\n\ts_barrier":::"memory");
  #undef DMA_K
  #undef DMA_V
  #undef CMASK
  #undef START
  #undef CINIT
  #undef RESC
  #undef ROT
}
constexpr int ATTN_LDS_BYTES=LDS_BYTES;
#undef SBAR
#undef WAIT_BAR
}
#ifndef MK_MULTI
#define MK_MULTI 0
#endif
constexpr int NWAVES = 8, NTHR = 512;
constexpr int Mrows = 32768, DM_ = 1024, DFF = 2816, SEQL = 4096, DPLE = 256;
constexpr int NPH = 12;
constexpr size_t MiB = 1u << 20;
constexpr size_t WS_W1GU = 2 * MiB, WS_W1D = 14 * MiB, WS_WIN = 20 * MiB, WS_WOUT = 27 * MiB, WS_W2GU = 30 * MiB, WS_W2D = 42 * MiB, WS_WPG = 48 * MiB, WS_WPP = 50 * MiB;
constexpr size_t WS_GATES = 52 * MiB, WS_CL = 54 * MiB, WS_BARR = 55 * MiB, WS_RARR = 55 * MiB + 512 * 1024, WS_NLOC = 56 * MiB, WS_NPREV = 56 * MiB + 512 * 1024;
constexpr size_t WS_GARR = 57 * MiB, WS_MLOC = 57 * MiB + 65536, WS_MPREV = 57 * MiB + 131072;
constexpr size_t WS_SS0 = 58 * MiB, WS_SS1 = 60 * MiB, WS_SS2 = 62 * MiB, WS_SS3 = 64 * MiB, WS_SS4 = 66 * MiB, WS_SSP = 68 * MiB;
constexpr size_t WS_XN = 72 * MiB;
constexpr size_t WS_ACTZ = 136 * MiB;
constexpr size_t WS_YMIX = 328 * MiB;
constexpr size_t WS_UT = 392 * MiB;
constexpr size_t WS_CT = 456 * MiB;
constexpr size_t WS_PB = 488 * MiB;
constexpr size_t WS_END = 504 * MiB;
constexpr int LDS_BYTES = 147456;
constexpr int WIN_ROWS = 3328;

#define LAS __attribute__((address_space(3)))
typedef unsigned short bf16;
typedef unsigned v4u __attribute__((ext_vector_type(4)));
typedef float f32x4 __attribute__((ext_vector_type(4)));
typedef short bf16x8 __attribute__((ext_vector_type(8)));
#define LDS_WAIT() asm volatile("s_waitcnt lgkmcnt(0)" ::: "memory")
__device__ __forceinline__ unsigned f2bf(float f) { unsigned u = __builtin_bit_cast(unsigned, f); return (u + 0x7fffu + ((u >> 16) & 1u)) >> 16; }
__device__ __forceinline__ unsigned pk2(float lo, float hi) { return f2bf(lo) | (f2bf(hi) << 16); }
__device__ __forceinline__ float bf2f(unsigned h) { return __uint_as_float(h << 16); }
__device__ __forceinline__ float logsig_f(float x) { return fminf(x, 0.f) - log1pf(__expf(-fabsf(x))); }
__device__ __forceinline__ float sigm_f(float x) { return 1.0f / (1.0f + __expf(-x)); }

__device__ __forceinline__ int wmap(int map, int n) {
    if (map == 1) return ((n >> 7) << 8) + (n & 127);
    if (map == 2) return ((n >> 7) << 8) + 128 + (n & 127);
    if (map == 3) { if (n < 1536) return n; if (n < 1544) return 3072 + (n - 1536); if (n < 3080) return n - 8; return n; }
    return n;
}
__device__ __forceinline__ void p0_transpose_item(const float* __restrict__ W, int K, int N, bf16* WT, int map, const float* __restrict__ gain, LAS float* scr, int item, int lane) {
    const int nblk = (N + 31) / 32, kb = item / nblk, nb = item % nblk, k0 = 64 * kb, n0 = 32 * nb;
    const int nin = n0 + (lane & 31); const bool ok = nin < N;
    float wv_[32];
#pragma unroll
    for (int i = 0; i < 32; ++i) { const int kk = 2 * i + (lane >> 5); wv_[i] = ok ? W[(size_t)(k0 + kk) * N + nin] : 0.f; }
#pragma unroll
    for (int i = 0; i < 32; ++i) { const int kk = 2 * i + (lane >> 5); float v = wv_[i]; if (gain) v *= gain[k0 + kk]; scr[kk * 33 + (lane & 31)] = v; }
    LDS_WAIT(); asm volatile("" ::: "memory");
    const int c = lane & 7;
#pragma unroll
    for (int j = 0; j < 4; ++j) { const int n = (lane >> 3) + 8 * j; const LAS float* s = scr + (8 * c) * 33 + n;
        v4u o; o.x = pk2(s[0 * 33], s[1 * 33]); o.y = pk2(s[2 * 33], s[3 * 33]); o.z = pk2(s[4 * 33], s[5 * 33]); o.w = pk2(s[6 * 33], s[7 * 33]);
        if (n0 + n < N) *(v4u*)(WT + (size_t)wmap(map, n0 + n) * K + k0 + 8 * c) = o; }
    LDS_WAIT(); asm volatile("" ::: "memory");
}

constexpr int LDS_LD = 72;
__device__ __forceinline__ bf16x8 frag(const LAS bf16* X, int r0, int k0, int lane) { return *(const LAS bf16x8*)(X + (r0 + (lane & 15)) * LDS_LD + k0 + 8 * (lane >> 4)); }
#define MMA16(a, b, c) __builtin_amdgcn_mfma_f32_16x16x32_bf16((a), (b), (c), 0, 0, 0)

struct Ptrs {
    const float* gates; float *barr, *rarr, *nloc, *nprev, *garr, *mloc, *mprev, *ut; bf16 *ct, *qkc, *z, *ymix; const float *conv, *gm;
};

struct LocRegs { v4u zq[2][4]; v4u vv[2]; float ip, fp; };
__device__ __forceinline__ void loc_load(LocRegs& R, int ci, const Ptrs& P) {
    const int tid = threadIdx.x, lane = tid & 63, wid = tid >> 6;
    const int bh = ci >> 6, c = ci & 63, b = bh >> 2, h = bh & 3;
    const size_t row0 = (size_t)b * SEQL + (size_t)c * 64;
    const int cg8 = tid & 15, tl = tid >> 4, isk = cg8 >> 3, zc = isk * 256 + h * 64 + (cg8 & 7) * 8;
#pragma unroll
    for (int p = 0; p < 2; ++p) { const int tpos = c * 64 + tl + 32 * p;
#pragma unroll
        for (int j = 0; j < 4; ++j) { int tp = tpos - 3 + j; tp = tp < 0 ? 0 : tp; R.zq[p][j] = *(const v4u*)(P.z + ((size_t)b * SEQL + tp) * 3072 + zc); }
        R.vv[p] = *(const v4u*)(P.z + (row0 + lane) * 3072 + 512 + h * 128 + wid * 16 + 8 * p); }
    if (wid == 0) { R.ip = P.gates[(row0 + lane) * 16 + h]; R.fp = P.gates[(row0 + lane) * 16 + 4 + h]; } else { R.ip = 0.f; R.fp = 0.f; }
}
__device__ __forceinline__ void loc_compute(const LocRegs& R, int ci, LAS unsigned char* lds, const Ptrs& P) {
    const int tid = threadIdx.x, lane = tid & 63, wid = tid >> 6;
    const int bh = ci >> 6, c = ci & 63, b = bh >> 2, h = bh & 3;
    const size_t row0 = (size_t)b * SEQL + (size_t)c * 64;
    LAS bf16* KwT = (LAS bf16*)lds;
    LAS bf16* VT = (LAS bf16*)(lds + 9216);
    LAS float* wv = (LAS float*)(lds + 9216 + 18432);
    if (wid == 0) {
        float bc = logsig_f(R.fp);
#pragma unroll
        for (int o = 1; o < 64; o <<= 1) { const float t = __shfl_up(bc, o); if (lane >= o) bc += t; }
        const float g = __shfl(bc, 63);
        const float r = R.ip - bc; float rm = r;
#pragma unroll
        for (int o = 1; o < 64; o <<= 1) rm = fmaxf(rm, __shfl_xor(rm, o));
        wv[lane] = __expf(r - rm);
        P.barr[ci * 64 + lane] = bc; P.rarr[ci * 64 + lane] = r; if (lane == 0) { P.garr[ci] = g; P.mloc[ci] = g + rm; }
    }
    const int cg8 = tid & 15, tl = tid >> 4, isk = cg8 >> 3, zc = isk * 256 + h * 64 + (cg8 & 7) * 8;
    float kv[2][8];
    {
        float cw[4][8];
#pragma unroll
        for (int j = 0; j < 4; ++j) { const f32x4 a = *(const f32x4*)(P.conv + j * 512 + zc), d = *(const f32x4*)(P.conv + j * 512 + zc + 4);
#pragma unroll
            for (int i = 0; i < 4; ++i) { cw[j][i] = a[i]; cw[j][4 + i] = d[i]; } }
#pragma unroll
        for (int p = 0; p < 2; ++p) { const int t = tl + 32 * p, tpos = c * 64 + t; float a[8];
#pragma unroll
            for (int i = 0; i < 8; ++i) a[i] = 0.f;
#pragma unroll
            for (int j = 0; j < 4; ++j) { const float ok = (tpos - 3 + j) >= 0 ? 1.0f : 0.0f; const v4u zz = R.zq[p][j];
#pragma unroll
                for (int k = 0; k < 4; ++k) { a[2 * k] += (cw[j][2 * k] * ok) * bf2f(zz[k] & 0xffffu); a[2 * k + 1] += (cw[j][2 * k + 1] * ok) * __uint_as_float(zz[k] & 0xffff0000u); } }
            const float sc = isk ? 1.0f : 0.125f;
#pragma unroll
            for (int i = 0; i < 8; ++i) { a[i] = a[i] * sigm_f(a[i]) * sc; kv[p][i] = a[i]; }
            v4u o; o.x = pk2(a[0], a[1]); o.y = pk2(a[2], a[3]); o.z = pk2(a[4], a[5]); o.w = pk2(a[6], a[7]);
            *(v4u*)(P.qkc + (row0 + t) * 512 + zc) = o; }
    }
#pragma unroll
    for (int p = 0; p < 2; ++p) { const v4u vv = R.vv[p];
#pragma unroll
        for (int k = 0; k < 4; ++k) { VT[(wid * 16 + 8 * p + 2 * k) * LDS_LD + lane] = (bf16)(vv[k] & 0xffffu); VT[(wid * 16 + 8 * p + 2 * k + 1) * LDS_LD + lane] = (bf16)(vv[k] >> 16); } }
    __syncthreads();
    if (isk) {
#pragma unroll
        for (int p = 0; p < 2; ++p) { const int t = tl + 32 * p; const float w = wv[t];
#pragma unroll
            for (int i = 0; i < 8; ++i) KwT[((cg8 & 7) * 8 + i) * LDS_LD + t] = (bf16)f2bf(kv[p][i] * w); }
    }
    __syncthreads();
    {
        f32x4 acc[4];
#pragma unroll
        for (int dj = 0; dj < 4; ++dj) acc[dj] = (f32x4){0.f, 0.f, 0.f, 0.f};
#pragma unroll
        for (int ks = 0; ks < 2; ++ks) { const bf16x8 a = frag(VT, 16 * wid, ks * 32, lane);
#pragma unroll
            for (int dj = 0; dj < 4; ++dj) acc[dj] = MMA16(a, frag(KwT, 16 * dj, ks * 32, lane), acc[dj]); }
        float* up = P.ut + (size_t)ci * 8192;
#pragma unroll
        for (int dj = 0; dj < 4; ++dj)
#pragma unroll
            for (int r = 0; r < 4; ++r) up[(16 * wid + 4 * (lane >> 4) + r) * 64 + 16 * dj + (lane & 15)] = acc[dj][r];
    }
    if (wid == 0) { float s = 0.f;
#pragma unroll 8
        for (int i = 0; i < 64; ++i) s += bf2f(KwT[lane * LDS_LD + i]);
        P.nloc[ci * 64 + lane] = s; }
    __syncthreads();
}
__device__ __forceinline__ void mlstm_local_phase(int first, int step, int n, LAS unsigned char* lds, const Ptrs& P) {
    LocRegs A, B; int it = first;
    if (it < n) loc_load(A, it, P);
    while (it < n) {
        const int n1 = it + step; if (n1 < n) loc_load(B, n1, P);
        loc_compute(A, it, lds, P);
        it = n1; if (it >= n) break;
        const int n2 = it + step; if (n2 < n) loc_load(A, n2, P);
        loc_compute(B, it, lds, P);
        it = n2;
    }
}

struct OutRegs { v4u q, k, ct[2], vv[2], mo[2]; float r, bt, mp, np; };
__device__ __forceinline__ void out_load(OutRegs& R, int ci, const Ptrs& P) {
    const int tid = threadIdx.x, lane = tid & 63, wid = tid >> 6;
    const int bh = ci >> 6, c = ci & 63, b = bh >> 2, h = bh & 3;
    const size_t row0 = (size_t)b * SEQL + (size_t)c * 64;
    const int t8 = tid >> 3, part = tid & 7, cg8 = tid & 15, tl = tid >> 4;
    R.q = *(const v4u*)(P.qkc + (row0 + t8) * 512 + h * 64 + part * 8);
    R.k = *(const v4u*)(P.qkc + (row0 + t8) * 512 + 256 + h * 64 + part * 8);
#pragma unroll
    for (int p = 0; p < 2; ++p) { const int idx = tid + 512 * p, e = idx >> 3, pp = idx & 7; R.ct[p] = *(const v4u*)(P.ct + (size_t)ci * 8192 + e * 64 + pp * 8);
        R.vv[p] = *(const v4u*)(P.z + (row0 + lane) * 3072 + 512 + h * 128 + wid * 16 + 8 * p);
        R.mo[p] = *(const v4u*)(P.z + (row0 + t8) * 3072 + 1024 + h * 128 + part * 16 + 8 * p); }
    if (wid == 0) { R.r = P.rarr[ci * 64 + lane]; R.bt = P.barr[ci * 64 + lane]; R.mp = P.mprev[ci]; R.np = P.nprev[ci * 64 + lane]; } else { R.r = 0.f; R.bt = 0.f; R.mp = 0.f; R.np = 0.f; }
}
__device__ __forceinline__ void out_compute(const OutRegs& R, int ci, LAS unsigned char* lds, const Ptrs& P) {
    const int tid = threadIdx.x, lane = tid & 63, wid = tid >> 6;
    const int bh = ci >> 6, c = ci & 63, b = bh >> 2, h = bh & 3;
    const size_t row0 = (size_t)b * SEQL + (size_t)c * 64;
    LAS bf16* Qs = (LAS bf16*)lds; LAS bf16* Qw = (LAS bf16*)(lds + 9216); LAS bf16* Ks = (LAS bf16*)(lds + 18432); LAS bf16* Ps = (LAS bf16*)(lds + 27648);
    LAS bf16* VT = (LAS bf16*)(lds + 36864); LAS bf16* CTs = (LAS bf16*)(lds + 55296); LAS float* NUM = (LAS float*)(lds + 73728);
    LAS float* rvec = (LAS float*)(lds + 107520); LAS float* Mt = rvec + 64; LAS float* wint = rvec + 128; LAS float* emt = rvec + 192; LAS float* npv = rvec + 256; LAS float* denom = rvec + 320;
    if (wid == 0) {
        float cm = R.r;
#pragma unroll
        for (int o = 1; o < 64; o <<= 1) { const float t = __shfl_up(cm, o); if (lane >= o) cm = fmaxf(cm, t); }
        const float M = fmaxf(R.mp, cm);
        rvec[lane] = R.r; Mt[lane] = M; wint[lane] = __expf(R.mp - M); emt[lane] = __expf(-R.bt - M); npv[lane] = R.np;
    }
    const int t8 = tid >> 3, part = tid & 7;
    *(LAS v4u*)(Qs + t8 * LDS_LD + part * 8) = R.q; *(LAS v4u*)(Ks + t8 * LDS_LD + part * 8) = R.k;
#pragma unroll
    for (int p = 0; p < 2; ++p) { const int idx = tid + 512 * p, e = idx >> 3, pp = idx & 7; *(LAS v4u*)(CTs + e * LDS_LD + pp * 8) = R.ct[p]; }
    {
#pragma unroll
      for (int p = 0; p < 2; ++p) { const v4u vv = R.vv[p];
#pragma unroll
        for (int k = 0; k < 4; ++k) { VT[(wid * 16 + 8 * p + 2 * k) * LDS_LD + lane] = (bf16)(vv[k] & 0xffffu); VT[(wid * 16 + 8 * p + 2 * k + 1) * LDS_LD + lane] = (bf16)(vv[k] >> 16); } } }
    __syncthreads();
    { const float w = wint[t8]; const v4u q = R.q; v4u o;
#pragma unroll
      for (int k = 0; k < 4; ++k) o[k] = pk2(bf2f(q[k] & 0xffffu) * w, __uint_as_float(q[k] & 0xffff0000u) * w);
      *(LAS v4u*)(Qw + t8 * LDS_LD + part * 8) = o; }
    {
        const int ti = wid >> 1;
#pragma unroll
        for (int jj = 0; jj < 2; ++jj) { const int sj = 2 * (wid & 1) + jj; f32x4 acc = (f32x4){0.f, 0.f, 0.f, 0.f};
            if (sj <= ti) {
#pragma unroll
                for (int ks = 0; ks < 2; ++ks) acc = MMA16(frag(Qs, 16 * ti, ks * 32, lane), frag(Ks, 16 * sj, ks * 32, lane), acc);
            }
            const int s = 16 * sj + (lane & 15); const float rs = rvec[s];
#pragma unroll
            for (int r = 0; r < 4; ++r) { const int t = 16 * ti + 4 * (lane >> 4) + r; const float pv = (s <= t) ? __expf(rs - Mt[t]) * acc[r] : 0.f; Ps[t * LDS_LD + s] = (bf16)f2bf(pv); } }
    }
    __syncthreads();
    {
        const v4u q = R.q, pp = *(const LAS v4u*)(Ps + t8 * LDS_LD + part * 8); float dot = 0.f, ps = 0.f;
#pragma unroll
        for (int k = 0; k < 4; ++k) { dot += bf2f(q[k] & 0xffffu) * npv[part * 8 + 2 * k] + __uint_as_float(q[k] & 0xffff0000u) * npv[part * 8 + 2 * k + 1]; ps += bf2f(pp[k] & 0xffffu) + __uint_as_float(pp[k] & 0xffff0000u); }
        float v = wint[t8] * dot + ps; v += __shfl_xor(v, 1); v += __shfl_xor(v, 2); v += __shfl_xor(v, 4);
        if (part == 0) denom[t8] = fmaxf(fabsf(v), emt[t8]);
    }
    {
        const int ti = wid >> 1, eh = wid & 1; f32x4 acc[4];
#pragma unroll
        for (int ej = 0; ej < 4; ++ej) acc[ej] = (f32x4){0.f, 0.f, 0.f, 0.f};
#pragma unroll
        for (int ks = 0; ks < 2; ++ks) { const bf16x8 a = frag(Qw, 16 * ti, ks * 32, lane);
#pragma unroll
            for (int ej = 0; ej < 4; ++ej) acc[ej] = MMA16(a, frag(CTs, 64 * eh + 16 * ej, ks * 32, lane), acc[ej]); }
#pragma unroll
        for (int ks = 0; ks < 2; ++ks) { const bf16x8 a = frag(Ps, 16 * ti, ks * 32, lane);
#pragma unroll
            for (int ej = 0; ej < 4; ++ej) acc[ej] = MMA16(a, frag(VT, 64 * eh + 16 * ej, ks * 32, lane), acc[ej]); }
#pragma unroll
        for (int ej = 0; ej < 4; ++ej)
#pragma unroll
            for (int r = 0; r < 4; ++r) NUM[(16 * ti + 4 * (lane >> 4) + r) * 132 + 64 * eh + 16 * ej + (lane & 15)] = acc[ej][r];
    }
    __syncthreads();
    {
        const float rd = 1.0f / denom[t8]; float hv[16]; float ss = 0.f;
#pragma unroll
        for (int i = 0; i < 4; ++i) { const f32x4 x = *(const LAS f32x4*)(NUM + t8 * 132 + part * 16 + 4 * i);
#pragma unroll
            for (int k = 0; k < 4; ++k) { hv[4 * i + k] = x[k] * rd; ss += hv[4 * i + k] * hv[4 * i + k]; } }
        ss += __shfl_xor(ss, 1); ss += __shfl_xor(ss, 2); ss += __shfl_xor(ss, 4);
        const float rs = 1.0f / sqrtf(ss * (1.0f / 128.0f) + 1e-6f);
        const float* gmp = P.gm + h * 128 + part * 16; bf16* yo = P.ymix + (row0 + t8) * 1024 + h * 128 + part * 16;
#pragma unroll
        for (int hh = 0; hh < 2; ++hh) { const v4u mv = R.mo[hh]; const f32x4 g0 = *(const f32x4*)(gmp + 8 * hh), g1 = *(const f32x4*)(gmp + 8 * hh + 4); float y[8];
#pragma unroll
            for (int k = 0; k < 4; ++k) { const float m0 = bf2f(mv[k] & 0xffffu), m1 = __uint_as_float(mv[k] & 0xffff0000u); const float ga = k < 2 ? g0[2 * k] : g1[2 * k - 4], gb = k < 2 ? g0[2 * k + 1] : g1[2 * k - 3];
                y[2 * k] = hv[8 * hh + 2 * k] * rs * ga * sigm_f(m0); y[2 * k + 1] = hv[8 * hh + 2 * k + 1] * rs * gb * sigm_f(m1); }
            v4u o; o.x = pk2(y[0], y[1]); o.y = pk2(y[2], y[3]); o.z = pk2(y[4], y[5]); o.w = pk2(y[6], y[7]);
            *(v4u*)(yo + 8 * hh) = o; }
    }
    __syncthreads();
}
__device__ __forceinline__ void mlstm_out_phase(int first, int step, int n, LAS unsigned char* lds, const Ptrs& P) {
    OutRegs A, B; int it = first;
    if (it < n) out_load(A, it & 2047, P);
    while (it < n) {
        const int n1 = it + step; if (n1 < n) out_load(B, n1 & 2047, P);
        out_compute(A, it & 2047, lds, P);
        it = n1; if (it >= n) break;
        const int n2 = it + step; if (n2 < n) out_load(A, n2 & 2047, P);
        out_compute(B, it & 2047, lds, P);
        it = n2;
    }
}

typedef unsigned u32;
#define RLX_AGENT __ATOMIC_RELAXED, __HIP_MEMORY_SCOPE_AGENT
#define XB_TMO      128
#define XB_XCNT(j)  (256  + 64 * (j))
#define XB_XSUB(j)  (1280 + 64 * (j))
#define XB_XGEN(j)  (2304 + 64 * (j))
#define XB_TOP      3328
#define XB_TOPGEN   3392
#define XCD_BAR_WORDS 3456
#define XB_SPIN_CAP (1u << 18)

__device__ __forceinline__ unsigned xb_ld(unsigned* p)              { return __hip_atomic_load(p, __ATOMIC_RELAXED, __HIP_MEMORY_SCOPE_AGENT); }
__device__ __forceinline__ unsigned xb_add(unsigned* p, unsigned v) { return __hip_atomic_fetch_add(p, v, __ATOMIC_RELAXED, __HIP_MEMORY_SCOPE_AGENT); }
__device__ __forceinline__ unsigned xb_xcc_id() { return (unsigned)__builtin_amdgcn_s_getreg((3 << 11) | 20) & 0xFu; }
#define XB_SPIN(cond, bar) do { unsigned _sp = 0; while (cond) { __builtin_amdgcn_s_sleep(1); \
    if ((++_sp & 255u) == 0u) { if (xb_ld(&(bar)[XB_TMO])) break; if (_sp > XB_SPIN_CAP) { atomicAdd(&(bar)[XB_TMO], 1u); break; } } } } while (0)

struct XcdBarrier {
    unsigned* bar; unsigned x;
    volatile LAS unsigned* st;
};

__device__ __forceinline__ XcdBarrier xcd_barrier_post(unsigned* bar, volatile LAS unsigned* st) {
    XcdBarrier b; b.bar = bar; b.x = xb_xcc_id(); b.st = st;
    if (threadIdx.x == 0) (void)xb_add(&bar[XB_XCNT(b.x)], 1u);
    return b;
}
__device__ __forceinline__ void xcd_barrier_complete(unsigned* bar, unsigned x, unsigned& nloc, unsigned& nx) {
    const unsigned G = gridDim.x * gridDim.y * gridDim.z;
    unsigned sum, cnt, mine, sp = 0u;
    for (;;) {
        sum = 0u; cnt = 0u; mine = 0u;
#pragma unroll
        for (unsigned j = 0; j < 16; ++j) { const unsigned c = xb_ld(&bar[XB_XCNT(j)]); sum += c; cnt += (c > 0u) ? 1u : 0u; mine = (j == x) ? c : mine; }
        if (sum == G) break;
        __builtin_amdgcn_s_sleep(1);
        if ((++sp & 255u) == 0u) { if (xb_ld(&bar[XB_TMO])) break; if (sp > XB_SPIN_CAP) { atomicAdd(&bar[XB_TMO], 1u); break; } }
    }
    nloc = mine > 0u ? mine : 1u; nx = cnt > 0u ? cnt : 1u;
}

__device__ __forceinline__ void xcd_barrier(const XcdBarrier& b) {
    asm volatile("s_waitcnt vmcnt(0)" ::: "memory");
    __syncthreads();
    if (threadIdx.x == 0) {
        unsigned* bar = b.bar;
        __builtin_amdgcn_s_waitcnt(0);
        unsigned nloc = b.st[0], nx = b.st[1];
        if (nloc == 0u) { xcd_barrier_complete(bar, b.x, nloc, nx); b.st[0] = nloc; b.st[1] = nx; }
        const unsigned old = xb_add(&bar[XB_XSUB(b.x)], 1u);
        const unsigned gen = old / nloc;
        if (old + 1u == (gen + 1u) * nloc) {
            __builtin_amdgcn_fence(__ATOMIC_RELEASE, "agent");
            asm volatile("s_waitcnt vmcnt(0)" ::: "memory");
            const unsigned og = xb_add(&bar[XB_TOP], 1u);
            const unsigned tg = og / nx;
            if (og + 1u == (tg + 1u) * nx) xb_add(&bar[XB_TOPGEN], 1u);
            else XB_SPIN(xb_ld(&bar[XB_TOPGEN]) == tg, bar);
            __builtin_amdgcn_fence(__ATOMIC_ACQUIRE, "agent");
            xb_add(&bar[XB_XGEN(b.x)], 1u);
            asm volatile("s_waitcnt vmcnt(0)" ::: "memory");
        } else {
            XB_SPIN(xb_ld(&bar[XB_XGEN(b.x)]) == gen, bar);
            __builtin_amdgcn_fence(__ATOMIC_ACQUIRE, "agent");
            asm volatile("s_waitcnt vmcnt(0)" ::: "memory");
        }
    }
    __syncthreads();
}

struct Args { const float* in[23]; float* out; unsigned char* ws; int ph_lo, ph_hi; };
__global__ void __launch_bounds__(NTHR, 2) hymba_fwd(Args args) {
    extern __shared__ __attribute__((aligned(16))) unsigned char lds_raw[];
    LAS unsigned char* lds = (LAS unsigned char*)lds_raw;
    cg::grid_group grid = cg::this_grid();
    const int tid = threadIdx.x, lane = tid & 63, wave = __builtin_amdgcn_readfirstlane(tid >> 6);
    const int G = gridDim.x; const int bx = blockIdx.x; const int vcu = (G % 8 == 0) ? (bx % 8) * (G / 8) + bx / 8 : bx;
#define H (args.out)
#define W1GU ((bf16*)(args.ws + WS_W1GU))
#define W1D ((bf16*)(args.ws + WS_W1D))
#define WIN ((bf16*)(args.ws + WS_WIN))
#define WOUT ((bf16*)(args.ws + WS_WOUT))
#define W2GU ((bf16*)(args.ws + WS_W2GU))
#define W2D ((bf16*)(args.ws + WS_W2D))
#define WPG ((bf16*)(args.ws + WS_WPG))
#define WPP ((bf16*)(args.ws + WS_WPP))
#define GATES ((float*)(args.ws + WS_GATES))
#define CLG ((float*)(args.ws + WS_CL))
#define SEGT ((float*)(args.ws + WS_MPREV + 65536))
#define SS0 ((float*)(args.ws + WS_SS0))
#define SS1 ((float*)(args.ws + WS_SS1))
#define SS2 ((float*)(args.ws + WS_SS2))
#define SS3 ((float*)(args.ws + WS_SS3))
#define SS4 ((float*)(args.ws + WS_SS4))
#define SSP ((float*)(args.ws + WS_SSP))
#define XN ((bf16*)(args.ws + WS_XN))
#define ACT ((bf16*)(args.ws + WS_ACTZ))
#define Z ((bf16*)(args.ws + WS_ACTZ))
#define YMIX ((bf16*)(args.ws + WS_YMIX))
#define PROJ ((bf16*)(args.ws + WS_YMIX))
#define PB ((bf16*)(args.ws + WS_PB))
#define MKPTRS() Ptrs P; { unsigned char* ws_ = args.ws; P.gates = (const float*)(ws_ + WS_GATES); P.barr = (float*)(ws_ + WS_BARR); P.rarr = (float*)(ws_ + WS_RARR); P.nloc = (float*)(ws_ + WS_NLOC); P.nprev = (float*)(ws_ + WS_NPREV); \
    P.garr = (float*)(ws_ + WS_GARR); P.mloc = (float*)(ws_ + WS_MLOC); P.mprev = (float*)(ws_ + WS_MPREV); P.ut = (float*)(ws_ + WS_UT); P.ct = (bf16*)(ws_ + WS_CT); \
    P.qkc = (bf16*)(ws_ + WS_XN); P.z = (bf16*)(ws_ + WS_ACTZ); P.ymix = (bf16*)(ws_ + WS_YMIX); P.conv = args.in[8]; P.gm = args.in[11]; }
    const int lo = args.ph_lo, hi = args.ph_hi;
#ifndef PH_MASK
#define PH_MASK 0xFFF
#endif
#ifndef PROBE_REP
#define PROBE_REP 0
#endif
#define IN(k) (((PH_MASK >> (k)) & 1) && lo <= (k) && (k) < hi)
#define REPS(k) _Pragma("unroll") for (int rep_ = 0; rep_ < 1 + ((PROBE_REP >> (k)) & 1); ++rep_)
#define SEAM(k) do { if (IN(k) && IN((k) + 1)) { if ((k) == 0) grid.sync(); else xcd_barrier(bar); } } while (0)
    const int gw = vcu * NWAVES + wave, NGW = G * NWAVES;
    if (tid < 8) ((LAS unsigned*)(lds + 131072))[tid] = 0u;
    __syncthreads();
    XcdBarrier bar; bar.bar = (unsigned*)args.ws; bar.x = 0; bar.st = nullptr;
    if (hi - lo > 1) bar = xcd_barrier_post((unsigned*)args.ws, (volatile LAS unsigned*)(lds + 131072));

    if (IN(0)) REPS(0) { if (rep_) xcd_barrier(bar);
        LAS float* scr = (LAS float*)(lds + wave * 16384);
        constexpr int I_GU = 16 * 88, I_D = 44 * 32, I_IN = 16 * 97, I_O = 16 * 32, I_PP = 4 * 32;
        constexpr int NITEMS = 4 * I_GU + 2 * I_D + I_IN + 2 * I_O + I_PP;
        for (int it = gw; it < NITEMS; it += NGW) {
            int r = it, wi, gi = -1, K = DM_, N = DFF, map = 0; size_t wso;
            if (r < I_GU) { wi = 3; gi = 2; wso = WS_W1GU; map = 1; }
            else if ((r -= I_GU) < I_GU) { wi = 4; gi = 2; wso = WS_W1GU; map = 2; }
            else if ((r -= I_GU) < I_D) { wi = 5; wso = WS_W1D; K = DFF; N = DM_; }
            else if ((r -= I_D) < I_IN) { wi = 7; gi = 6; wso = WS_WIN; N = 3088; map = 3; }
            else if ((r -= I_IN) < I_O) { wi = 13; wso = WS_WOUT; N = DM_; }
            else if ((r -= I_O) < I_GU) { wi = 15; gi = 14; wso = WS_W2GU; map = 1; }
            else if ((r -= I_GU) < I_GU) { wi = 16; gi = 14; wso = WS_W2GU; map = 2; }
            else if ((r -= I_GU) < I_D) { wi = 17; wso = WS_W2D; K = DFF; N = DM_; }
            else if ((r -= I_D) < I_O) { wi = 19; gi = 18; wso = WS_WPG; N = DM_; }
            else { r -= I_O; wi = 20; wso = WS_WPP; K = DPLE; N = DM_; }
            p0_transpose_item(args.in[wi], K, N, (bf16*)(args.ws + wso), map, gi >= 0 ? args.in[gi] : nullptr, scr, r, lane);
        }
        { v4u* zp = (v4u*)(WIN + (size_t)3088 * 1024); const int nz = (WIN_ROWS - 3088) * 1024 * 2 / 16;
          for (int i = bx * NTHR + tid; i < nz; i += G * NTHR) zp[i] = (v4u){0u, 0u, 0u, 0u}; }
        for (int m0 = 2 * gw; m0 < Mrows; m0 += 2 * NGW) {
            f32x4 v[2][4]; float sq[2];
#pragma unroll
            for (int rr = 0; rr < 2; ++rr) { const f32x4* xr = (const f32x4*)(args.in[0] + (size_t)(m0 + rr) * 1024) + lane;
#pragma unroll
                for (int j = 0; j < 4; ++j) v[rr][j] = xr[64 * j]; }
#pragma unroll
            for (int rr = 0; rr < 2; ++rr) { float s = 0.f;
#pragma unroll
                for (int j = 0; j < 4; ++j) s += (v[rr][j][0] * v[rr][j][0] + v[rr][j][1] * v[rr][j][1]) + (v[rr][j][2] * v[rr][j][2] + v[rr][j][3] * v[rr][j][3]);
#pragma unroll
                for (int o = 1; o < 64; o <<= 1) s += __shfl_xor(s, o);
                sq[rr] = s; }
#pragma unroll
            for (int rr = 0; rr < 2; ++rr) { unsigned long long* o8 = (unsigned long long*)(XN + (size_t)(m0 + rr) * 1024) + lane;
#pragma unroll
                for (int j = 0; j < 4; ++j) o8[64 * j] = (unsigned long long)pk2(v[rr][j][0], v[rr][j][1]) | ((unsigned long long)pk2(v[rr][j][2], v[rr][j][3]) << 32);
                if (lane < 16) SS0[(size_t)(m0 + rr) * 16 + lane] = lane == 0 ? sq[rr] : 0.f; }
        }
        { const f32x4* pp = (const f32x4*)args.in[1]; unsigned long long* po = (unsigned long long*)PB; const int n4 = Mrows * DPLE / 4;
          for (int i = bx * NTHR + tid; i < n4; i += G * NTHR) { const f32x4 v = pp[i]; po[i] = (unsigned long long)pk2(v[0], v[1]) | ((unsigned long long)pk2(v[2], v[3]) << 32); } }
    }
    SEAM(0);
    if (IN(1)) REPS(1) { if (rep_) xcd_barrier(bar); pg8::Gemm g{XN, W1GU, Mrows, 2 * DFF, DM_}; pg8::StaticOrder S; S.init(Mrows, 2 * DFF, G, bx);
        pg8::EpiSwiGLU E{ACT, SS0, DFF}; pg8::gemm_phase<pg8::EpiSwiGLU, pg8::StaticOrder, true, true>(lds, g, S, E); }
    SEAM(1);
    if (IN(2)) REPS(2) { if (rep_) xcd_barrier(bar); pg8::Gemm g{ACT, W1D, Mrows, DM_, DFF}; pg8::StaticOrder S; S.init(Mrows, DM_, G, bx);
        pg8::EpiResid E{args.in[0], H, XN, SS1, 0.5f}; pg8::gemm_phase<pg8::EpiResid, pg8::StaticOrder, true, true>(lds, g, S, E); }
    SEAM(2);
    if (IN(3)) REPS(3) { if (rep_) xcd_barrier(bar); pg8::Gemm g{XN, WIN, Mrows, WIN_ROWS, DM_}; pg8::StaticOrder S; S.init(Mrows, WIN_ROWS, G, bx);
        pg8::EpiZ E{Z, GATES, SS1, args.in[9], args.in[10], 0.125f * 1.4426950408889634f}; pg8::gemm_phase<pg8::EpiZ, pg8::StaticOrder, true, true>(lds, g, S, E); }
    SEAM(3);
    if (IN(4)) REPS(4) { if (rep_) xcd_barrier(bar);
        for (int task = wave * G + vcu; task < 1024; task += NGW) {
            const int bhf = task >> 4, seg = task & 15, b = bhf >> 3, h = bhf & 7; const int t0 = seg * 256 + 4 * lane;
            const float* gp = GATES + ((size_t)b * SEQL + t0) * 16 + 8 + h;
            const float v0 = logsig_f(gp[0]), v1 = v0 + logsig_f(gp[16]), v2 = v1 + logsig_f(gp[32]), v3 = v2 + logsig_f(gp[48]);
            float inc = v3;
#pragma unroll
            for (int o = 1; o < 64; o <<= 1) { const float t = __shfl_up(inc, o); if (lane >= o) inc += t; }
            const float ex = inc - v3;
            *(f32x4*)(CLG + (size_t)bhf * SEQL + t0) = (f32x4){ex + v0, ex + v1, ex + v2, ex + v3};
            if (lane == 63) SEGT[task] = inc;
        }
        MKPTRS();
        mlstm_local_phase(vcu, G, 2048, lds, P);
    }
    SEAM(4);
    if (IN(5)) REPS(5) { if (rep_) xcd_barrier(bar);
        MKPTRS();
        const float* __restrict__ ut = P.ut; bf16* __restrict__ ct = P.ct;
        for (int e2 = bx * NTHR + tid; e2 < 32 * 4096; e2 += G * NTHR) {
            const int bh = e2 >> 12, idx = (e2 & 4095) * 2; float C0 = 0.f, C1 = 0.f, m = 0.f;
            for (int c0 = 0; c0 < 64; c0 += 16) { pg8::f32x2 u[16];
#pragma unroll
                for (int j = 0; j < 16; ++j) u[j] = *(const pg8::f32x2*)(ut + ((size_t)(bh * 64 + c0 + j) << 13) + idx);
#pragma unroll
                for (int j = 0; j < 16; ++j) { const int ci = bh * 64 + c0 + j; const float g = P.garr[ci], ml = P.mloc[ci]; const float mn = fmaxf(g + m, ml);
                    *(unsigned*)(ct + ((size_t)ci << 13) + idx) = pk2(C0, C1); if (idx == 0) P.mprev[ci] = m;
                    const float dec = __expf(g + m - mn), wu = __expf(ml - mn); C0 = dec * C0 + wu * u[j].x; C1 = dec * C1 + wu * u[j].y; m = mn; } }
        }
        for (int eid = bx * NTHR + tid; eid < 32 * 64; eid += G * NTHR) {
            const int bh = eid >> 6, d = eid & 63; float n = 0.f, m = 0.f;
            for (int c = 0; c < 64; ++c) { const int ci = bh * 64 + c; const float g = P.garr[ci], ml = P.mloc[ci]; const float mn = fmaxf(g + m, ml);
                P.nprev[ci * 64 + d] = n; n = __expf(g + m - mn) * n + __expf(ml - mn) * P.nloc[ci * 64 + d]; m = mn; }
        }
    }
    SEAM(5);
    if (IN(6)) { constexpr int R6 = 1 + ((PROBE_REP >> 6) & 1), R6A = 1 + ((PROBE_REP >> 7) & 1);
        { MKPTRS();
        mlstm_out_phase(vcu, G, 2048 * R6, lds, P); }
        __syncthreads();
        LAS float* cl = (LAS float*)(lds + 86016); int cur_bh = -1;
        const int nu = (1024 + G - 1) / G;
        for (int i2 = 0; i2 < nu * R6A; ++i2) { const int i = i2 % nu;
            int bh, qb;
            if (G == 256) { const int s = vcu & 3; bh = vcu >> 2; qb = (i == 0) ? s : (i == 1) ? 7 - s : (i == 2) ? 8 + s : 15 - s; }
            else { const int idx = i * G + vcu; if (idx >= 1024) break; bh = idx >> 4; qb = idx & 15; }
            if (bh != cur_bh) { __syncthreads();
                for (int k = tid; k < SEQL / 4; k += NTHR) { const int sg = k >> 6; float off = 0.f;
#pragma unroll
                    for (int q = 0; q < 15; ++q) { const float sv = SEGT[bh * 16 + q]; off += q < sg ? sv : 0.f; }
                    const f32x4 v = *(const f32x4*)(CLG + (size_t)bh * SEQL + 4 * k); *(LAS f32x4*)(cl + 4 * k) = (v + off) * 1.4426950408889634f; }
                cur_bh = bh; __syncthreads(); }
            attn_body::attn_unit<8>(bh >> 3, bh & 7, qb, (const attn_body::bf16*)(Z + 1536), (const attn_body::bf16*)(Z + 2048), (const attn_body::bf16*)(Z + 2560), (attn_body::bf16*)(YMIX + 512), (char*)lds_raw, (attn_body::lds_fptr)cl, args.in[12]);
        }
    }
    SEAM(6);
    if (IN(7)) { pg8::Gemm g{YMIX, WOUT, Mrows, DM_, DM_}; pg8::StaticOrder S; S.init(Mrows, DM_, G, bx);
        pg8::EpiResid E{H, H, XN, SS2, 1.0f}; pg8::gemm_phase<pg8::EpiResid, pg8::StaticOrder, true, true>(lds, g, S, E); }
    SEAM(7);
    if (IN(8)) REPS(8) { if (rep_) xcd_barrier(bar); pg8::Gemm g{XN, W2GU, Mrows, 2 * DFF, DM_}; pg8::StaticOrder S; S.init(Mrows, 2 * DFF, G, bx);
        pg8::EpiSwiGLU E{ACT, SS2, DFF}; pg8::gemm_phase<pg8::EpiSwiGLU, pg8::StaticOrder, true, true>(lds, g, S, E); }
    SEAM(8);
    if (IN(9)) {
        { pg8::Gemm g{ACT, W2D, Mrows, DM_, DFF}; pg8::StaticOrder S; S.init(Mrows, DM_, G, bx);
          pg8::EpiResid E{H, H, XN, SS3, 0.5f}; pg8::gemm_phase<pg8::EpiResid, pg8::StaticOrder, true, true>(lds, g, S, E); }
        { pg8::Gemm g{PB, WPP, Mrows, DM_, DPLE}; pg8::StaticOrder S; S.init(Mrows, DM_, G, bx);
          pg8::EpiProj E{PROJ, SSP}; pg8::gemm_phase<pg8::EpiProj, pg8::StaticOrder, true, true>(lds, g, S, E); }
    }
    SEAM(9);
    if (IN(10)) { pg8::Gemm g{XN, WPG, Mrows, DM_, DM_}; pg8::StaticOrder S; S.init(Mrows, DM_, G, bx);
        pg8::EpiPle E{H, PROJ, SS3, SSP, args.in[21], SS4}; pg8::gemm_phase<pg8::EpiPle, pg8::StaticOrder, true, true>(lds, g, S, E); }
    SEAM(10);
    if (IN(11)) {
        const f32x4* gf = (const f32x4*)args.in[22];
        for (int m0 = 2 * gw; m0 < Mrows; m0 += 2 * NGW) { f32x4 v[2][4]; float rs[2];
#pragma unroll
            for (int rr = 0; rr < 2; ++rr) { rs[rr] = pg8::row_rstd(SS4, m0 + rr); const f32x4* hp = (const f32x4*)(H + (size_t)(m0 + rr) * 1024) + lane;
#pragma unroll
                for (int j = 0; j < 4; ++j) v[rr][j] = hp[64 * j]; }
#pragma unroll
            for (int rr = 0; rr < 2; ++rr) { f32x4* hp = (f32x4*)(H + (size_t)(m0 + rr) * 1024) + lane;
#pragma unroll
                for (int j = 0; j < 4; ++j) hp[64 * j] = v[rr][j] * rs[rr] * gf[64 * j + lane]; } }
    }
#undef IN
#undef SEAM
}

extern "C" void kernel_launch(void* const* d_in, const int* in_sizes, int n_in, void* d_out, int out_size, void* d_ws, size_t ws_size, hipStream_t stream) {
    static int grid = 0;
    if (grid == 0) {
        if (n_in != 23 || out_size != Mrows * DM_ || ws_size < WS_END) { fprintf(stderr, "kernel_launch: unexpected shapes (n_in %d out %d ws %zu)\n", n_in, out_size, ws_size); grid = -1; return; }
        int dev = 0, cus = 0, per_cu = 0;
        hipGetDevice(&dev); hipDeviceGetAttribute(&cus, hipDeviceAttributeMultiprocessorCount, dev);
        if (hipFuncSetAttribute((const void*)hymba_fwd, hipFuncAttributeMaxDynamicSharedMemorySize, LDS_BYTES) != hipSuccess) { fprintf(stderr, "kernel_launch: hipFuncSetAttribute failed\n"); grid = -1; return; }
        if (hipOccupancyMaxActiveBlocksPerMultiprocessor(&per_cu, (const void*)hymba_fwd, NTHR, LDS_BYTES) != hipSuccess || per_cu < 1) { fprintf(stderr, "kernel_launch: occupancy query says %d\n", per_cu); per_cu = 1; }
        (void)hipGetLastError();
        grid = cus * (per_cu > 1 ? 1 : per_cu);
    }
    if (grid < 0) return;
    if (hipMemsetAsync(d_ws, 0, 65536, stream) != hipSuccess) { fprintf(stderr, "kernel_launch: memset failed\n"); return; }
    Args a{};
    for (int i = 0; i < 23; ++i) a.in[i] = (const float*)d_in[i];
    a.out = (float*)d_out; a.ws = (unsigned char*)d_ws;
#if MK_MULTI
    for (int ph = 0; ph < NPH; ++ph) { a.ph_lo = ph; a.ph_hi = ph + 1; hipLaunchKernelGGL(hymba_fwd, dim3(grid), dim3(NTHR), LDS_BYTES, stream, a); }
#else
    a.ph_lo = 0; a.ph_hi = NPH; void* kargs[] = {&a};
    hipError_t e = hipLaunchCooperativeKernel((void*)hymba_fwd, dim3(grid), dim3(NTHR), kargs, LDS_BYTES, stream);
    if (e != hipSuccess) fprintf(stderr, "cooperative launch failed: %s (grid %d)\n", hipGetErrorString(e), grid);
#endif
}
```

```cpp
#include <hip/hip_runtime.h>
#include <hip/hip_cooperative_groups.h>
#include <hip/hip_bf16.h>
#include <cstdio>
#include <cstdint>
#include <cmath>
namespace cg = cooperative_groups;
namespace pg8 {
#define PG8_LAS __attribute__((address_space(3)))
typedef unsigned short bf16_t;
typedef short bf16x8 __attribute__((ext_vector_type(8)));
typedef float f32x4 __attribute__((ext_vector_type(4)));
typedef unsigned u32x4 __attribute__((ext_vector_type(4)));
constexpr int BM = 256, BK = 64, HALF = 128, HTB = HALF * BK * 2  , STAGE_BYTES = 8 * HTB, NXCD = 8, WGM = 8;

__host__ __device__ __forceinline__ int lds_byte(int r, int c) { const int st = (r >> 4) * 2 + (c >> 5), rr = r & 15, cc = c & 31, ob = rr * 64 + cc * 2; return st * 1024 + (ob ^ (((ob >> 9) & 1) << 5)); }
__host__ __device__ __forceinline__ void stage_rc(int b, int& R, int& C) { const int st = b / 1024, sb = b % 1024, swz = sb ^ (((sb >> 9) & 1) << 5); R = (st >> 1) * 16 + swz / 64; C = (st & 1) * 32 + (swz % 64) / 2; }
__host__ __device__ __forceinline__ int perm32(int rho) { const int n = rho >> 4, i = rho & 15; return 8 * (i >> 2) + 4 * n + (i & 3); }

struct Unit { int pm, pn; };
struct Gemm { const bf16_t* A; const bf16_t* Bt; int M, N, K; };

struct StaticOrder {
    int nM, nN, nwg, G, c;
    __host__ __device__ void init(int M, int N, int G_, int c_) { nM = M / BM; nN = N / BM; nwg = nM * nN; G = G_; c = c_; }
    __host__ __device__ bool next(int i, Unit& u) const {
        const long L = (long)i * G + c; if (L >= nwg) return false;
        int wgid = (int)L; { const int q = nwg / NXCD, r = nwg % NXCD, xcd = wgid % NXCD, off = wgid / NXCD; wgid = (xcd < r ? xcd * (q + 1) : r * (q + 1) + (xcd - r) * q) + off; }
        const int nig = WGM * nN, gid = wgid / nig, fm = gid * WGM, gsz = (nM - fm) < WGM ? (nM - fm) : WGM;
        u.pm = fm + ((wgid % nig) % gsz); u.pn = (wgid % nig) / gsz; return true;
    }
    __device__ __forceinline__ void a_ready(const Unit&) const {}
    __device__ __forceinline__ void done(const Unit&) const {}
};

__device__ __forceinline__ unsigned cvt_pk_bf16(float lo, float hi) { unsigned r; asm volatile("v_cvt_pk_bf16_f32 %0, %1, %2" : "=v"(r) : "v"(lo), "v"(hi)); return r; }
typedef float f32x2 __attribute__((ext_vector_type(2)));
typedef unsigned u32x2 __attribute__((ext_vector_type(2)));
constexpr float RMS_EPS = 1e-6f;
__device__ __forceinline__ float row_rstd(const float* __restrict__ ss, int row) {
    const f32x4* p = (const f32x4*)(ss + (size_t)row * 16);
    const f32x4 a = p[0], b = p[1], c = p[2], d = p[3];
    const float s = (((a[0] + a[1]) + (a[2] + a[3])) + ((b[0] + b[1]) + (b[2] + b[3]))) + (((c[0] + c[1]) + (c[2] + c[3])) + ((d[0] + d[1]) + (d[2] + d[3])));
    return 1.0f / sqrtf(s * (1.0f / 1024.0f) + RMS_EPS);
}
__device__ __forceinline__ float sigmoid_f(float x) { return __builtin_amdgcn_rcpf(1.0f + __builtin_amdgcn_exp2f(-1.4426950408889634f * x)); }
__device__ __forceinline__ float silu_f(float x) { return x * sigmoid_f(x); }

template <bool PRENORM> struct EpiSwiGLU {
    static constexpr bool PERM = true, AFTER_DRAIN = false;
    bf16_t* O; const float* ss; int ldo;
    __device__ __forceinline__ void operator()(const f32x4 (&acc)[2][2][4][2], const Unit& u, int wr, int wc, int fr, int fq) const {
        const int row0 = u.pm * BM + wr * 64 + fr, col0 = u.pn * 128 + wc * 32 + 8 * fq;
#pragma unroll
        for (int ai = 0; ai < 2; ++ai)
#pragma unroll
            for (int m = 0; m < 4; ++m) { const int row = row0 + ai * HALF + m * 16; const float rs = PRENORM ? 1.0f : row_rstd(ss, row);
                const f32x4 g0 = acc[ai][0][m][0] * rs, g1 = acc[ai][0][m][1] * rs, u0 = acc[ai][1][m][0] * rs, u1 = acc[ai][1][m][1] * rs;
                u32x4 w; w.x = cvt_pk_bf16(silu_f(g0[0]) * u0[0], silu_f(g0[1]) * u0[1]); w.y = cvt_pk_bf16(silu_f(g0[2]) * u0[2], silu_f(g0[3]) * u0[3]);
                w.z = cvt_pk_bf16(silu_f(g1[0]) * u1[0], silu_f(g1[1]) * u1[1]); w.w = cvt_pk_bf16(silu_f(g1[2]) * u1[2], silu_f(g1[3]) * u1[3]);
                *(u32x4*)(O + (size_t)row * ldo + col0) = w; }
    }
};
struct EpiResid {
    static constexpr bool PERM = false, AFTER_DRAIN = false;
    const float* base; float* out; bf16_t* xn; float* sso; float coef;
    __device__ __forceinline__ void operator()(const f32x4 (&acc)[2][2][4][2], const Unit& u, int wr, int wc, int fr, int fq) const {
        const int col0 = u.pn * BM + wc * 32 + 4 * fq;
#pragma unroll
        for (int ai = 0; ai < 2; ++ai)
#pragma unroll
            for (int m = 0; m < 4; ++m) { const int row = u.pm * BM + ai * HALF + wr * 64 + m * 16 + fr; const size_t off = (size_t)row * 1024 + col0; float q = 0.f;
#pragma unroll
                for (int bj = 0; bj < 2; ++bj)
#pragma unroll
                    for (int n = 0; n < 2; ++n) { const f32x4 bs = *(const f32x4*)(base + off + bj * HALF + n * 16); const f32x4 o = bs + acc[ai][bj][m][n] * coef;
                        *(f32x4*)(out + off + bj * HALF + n * 16) = o; q += (o[0] * o[0] + o[1] * o[1]) + (o[2] * o[2] + o[3] * o[3]);
                        u32x2 w; w.x = cvt_pk_bf16(o[0], o[1]); w.y = cvt_pk_bf16(o[2], o[3]); *(u32x2*)(xn + off + bj * HALF + n * 16) = w; }
                q += __shfl_xor(q, 16); q += __shfl_xor(q, 32);
                if (fq == 0) sso[(size_t)row * 16 + u.pn * 4 + wc] = q; }
    }
};
struct EpiZ {
    static constexpr bool PERM = true, AFTER_DRAIN = false;
    bf16_t* Z; float* gates; const float* ss; const float* bm; const float* bf; float qscale;
    __device__ __forceinline__ void operator()(const f32x4 (&acc)[2][2][4][2], const Unit& u, int wr, int wc, int fr, int fq) const {
        const int row0 = u.pm * BM + wr * 64 + fr;
        if (u.pn < 12) {
            const float sc = (u.pn == 6 || u.pn == 7) ? qscale : 1.0f; const int col0 = u.pn * BM + wc * 32 + 8 * fq;
#pragma unroll
            for (int ai = 0; ai < 2; ++ai)
#pragma unroll
                for (int m = 0; m < 4; ++m) { const int row = row0 + ai * HALF + m * 16; const float rs = row_rstd(ss, row) * sc;
#pragma unroll
                    for (int bj = 0; bj < 2; ++bj) { const f32x4 v0 = acc[ai][bj][m][0] * rs, v1 = acc[ai][bj][m][1] * rs;
                        u32x4 w; w.x = cvt_pk_bf16(v0[0], v0[1]); w.y = cvt_pk_bf16(v0[2], v0[3]); w.z = cvt_pk_bf16(v1[0], v1[1]); w.w = cvt_pk_bf16(v1[2], v1[3]);
                        *(u32x4*)(Z + (size_t)row * 3072 + col0 + bj * HALF) = w; } }
        } else if (wc == 0 && fq < 2) {
            const float* bp = fq == 0 ? bm : bf; const f32x4 b0 = *(const f32x4*)bp, b1 = *(const f32x4*)(bp + 4);
#pragma unroll
            for (int ai = 0; ai < 2; ++ai)
#pragma unroll
                for (int m = 0; m < 4; ++m) { const int row = row0 + ai * HALF + m * 16; const float rs = row_rstd(ss, row);
                    *(f32x4*)(gates + (size_t)row * 16 + 8 * fq) = acc[ai][0][m][0] * rs + b0; *(f32x4*)(gates + (size_t)row * 16 + 8 * fq + 4) = acc[ai][0][m][1] * rs + b1; }
        }
    }
};
struct EpiProj {
    static constexpr bool PERM = true, AFTER_DRAIN = false;
    bf16_t* O; float* sso;
    __device__ __forceinline__ void operator()(const f32x4 (&acc)[2][2][4][2], const Unit& u, int wr, int wc, int fr, int fq) const {
        const int row0 = u.pm * BM + wr * 64 + fr, col0 = u.pn * BM + wc * 32 + 8 * fq;
#pragma unroll
        for (int ai = 0; ai < 2; ++ai)
#pragma unroll
            for (int m = 0; m < 4; ++m) { const int row = row0 + ai * HALF + m * 16; float q = 0.f;
#pragma unroll
                for (int bj = 0; bj < 2; ++bj) { const f32x4 v0 = acc[ai][bj][m][0], v1 = acc[ai][bj][m][1];
                    q += ((v0[0] * v0[0] + v0[1] * v0[1]) + (v0[2] * v0[2] + v0[3] * v0[3])) + ((v1[0] * v1[0] + v1[1] * v1[1]) + (v1[2] * v1[2] + v1[3] * v1[3]));
                    u32x4 w; w.x = cvt_pk_bf16(v0[0], v0[1]); w.y = cvt_pk_bf16(v0[2], v0[3]); w.z = cvt_pk_bf16(v1[0], v1[1]); w.w = cvt_pk_bf16(v1[2], v1[3]);
                    *(u32x4*)(O + (size_t)row * 1024 + col0 + bj * HALF) = w; }
                q += __shfl_xor(q, 16); q += __shfl_xor(q, 32);
                if (fq == 0) sso[(size_t)row * 16 + u.pn * 4 + wc] = q; }
    }
};
struct EpiPle {
    static constexpr bool PERM = false, AFTER_DRAIN = false;
    float* H; const bf16_t* proj; const float* ss3; const float* ssp; const float* gp; float* sso;
    __device__ __forceinline__ void operator()(const f32x4 (&acc)[2][2][4][2], const Unit& u, int wr, int wc, int fr, int fq) const {
        const int col0 = u.pn * BM + wc * 32 + 4 * fq;
#pragma unroll
        for (int ai = 0; ai < 2; ++ai)
#pragma unroll
            for (int m = 0; m < 4; ++m) { const int row = u.pm * BM + ai * HALF + wr * 64 + m * 16 + fr; const size_t off = (size_t)row * 1024 + col0; float q = 0.f;
                const float rs3 = row_rstd(ss3, row), rsp = row_rstd(ssp, row);
#pragma unroll
                for (int bj = 0; bj < 2; ++bj)
#pragma unroll
                    for (int n = 0; n < 2; ++n) { const int co = bj * HALF + n * 16; const f32x4 hb = *(const f32x4*)(H + off + co); const u32x2 pw = *(const u32x2*)(proj + off + co);
                        const f32x4 g = *(const f32x4*)(gp + col0 + co); const f32x4 a = acc[ai][bj][m][n] * rs3;
                        f32x4 pr; pr[0] = __uint_as_float(pw.x << 16); pr[1] = __uint_as_float(pw.x & 0xffff0000u); pr[2] = __uint_as_float(pw.y << 16); pr[3] = __uint_as_float(pw.y & 0xffff0000u);
                        f32x4 o;
#pragma unroll
                        for (int i = 0; i < 4; ++i) o[i] = hb[i] + sigmoid_f(a[i]) * (pr[i] * rsp * g[i]);
                        *(f32x4*)(H + off + co) = o; q += (o[0] * o[0] + o[1] * o[1]) + (o[2] * o[2] + o[3] * o[3]); }
                q += __shfl_xor(q, 16); q += __shfl_xor(q, 32);
                if (fq == 0) sso[(size_t)row * 16 + u.pn * 4 + wc] = q; }
    }
};

template <class Epi, class Sched, bool ALIGN_EPI = false, bool SP2 = false>
__device__ __forceinline__ void gemm_phase(PG8_LAS unsigned char* lds, const Gemm g, const Sched& S, const Epi& E) {
    const int tid = threadIdx.x, wid = __builtin_amdgcn_readfirstlane(tid >> 6), lane = tid & 63, wr = wid >> 2, wc = wid & 3, fr = lane & 15, fq = lane >> 4;
    const int K = g.K, nt = K / BK;
    unsigned voffA[2], voffB[2];
#pragma unroll
    for (int i = 0; i < 2; ++i) { int R, C; stage_rc(tid * 16 + i * 8192, R, C); const int Rb = Epi::PERM ? ((R & ~31) + perm32(R & 31)) : R;
        voffA[i] = (unsigned)(R * K + C) * 2u; voffB[i] = (unsigned)(Rb * K + C) * 2u; }
    const size_t kstep = (size_t)(BK * 2);
    const size_t hstep = (size_t)HALF * K * 2;
    const size_t tstep = 2 * hstep;
    const unsigned ldsw = (unsigned)wid * 1024u;
    const int aoff = lds_byte(wr * 64 + fr, fq * 8), boff = lds_byte(wc * 32 + fr, fq * 8);
#define PG8_SA(b, h) (((b) * 2 + (h)) * HTB)
#define PG8_SB(b, h) ((4 + (b) * 2 + (h)) * HTB)
#define PG8_STAGE(bufoff, gbase, voff) do { _Pragma("unroll") for (int _i = 0; _i < 2; ++_i) \
        __builtin_amdgcn_global_load_lds((const unsigned*)((const char*)(gbase) + (voff)[_i]), (PG8_LAS unsigned*)(lds + (bufoff) + ldsw + _i * 8192), 16, 0, 0); } while (0)
#define PG8_LDA(dst, b, h) do { _Pragma("unroll") for (int m = 0; m < 4; ++m) _Pragma("unroll") for (int k = 0; k < 2; ++k) dst[m][k] = *(const PG8_LAS bf16x8*)(lds + PG8_SA(b, h) + aoff + m * 2048 + k * 1024); } while (0)
#define PG8_LDB(dst, b, h) do { _Pragma("unroll") for (int n = 0; n < 2; ++n) _Pragma("unroll") for (int k = 0; k < 2; ++k) dst[n][k] = *(const PG8_LAS bf16x8*)(lds + PG8_SB(b, h) + boff + n * 2048 + k * 1024); } while (0)
#define PG8_MMA(ai, bj, At, Bt) do { __builtin_amdgcn_s_setprio(1); _Pragma("unroll") for (int m = 0; m < 4; ++m) _Pragma("unroll") for (int n = 0; n < 2; ++n) _Pragma("unroll") for (int k = 0; k < 2; ++k) \
        acc[ai][bj][m][n] = __builtin_amdgcn_mfma_f32_16x16x32_bf16(Bt[n][k], At[m][k], acc[ai][bj][m][n], 0, 0, 0); __builtin_amdgcn_s_setprio(0); } while (0)
#define PG8_WAIT_V(n) asm volatile("s_waitcnt vmcnt(" #n ")" ::: "memory")
#define PG8_WAIT_L(n) asm volatile("s_waitcnt lgkmcnt(" #n ")" ::: "memory")
#define PG8_BAR __builtin_amdgcn_s_barrier()
#define PG8_SCHED __builtin_amdgcn_sched_barrier(0)
    Unit cur, nxt; int ui = 0;
    if (!S.next(0, cur)) return;
    f32x4 acc[2][2][4][2];
#pragma unroll
    for (int a = 0; a < 2; ++a)
#pragma unroll
        for (int b = 0; b < 2; ++b)
#pragma unroll
            for (int m = 0; m < 4; ++m)
#pragma unroll
                for (int n = 0; n < 2; ++n) acc[a][b][m][n] = (f32x4){0.f, 0.f, 0.f, 0.f};
    bf16x8 At[4][2], B0[2][2], B1[2][2];
    const char* cA = (const char*)g.A + (size_t)cur.pm * tstep; const char* cB = (const char*)g.Bt + (size_t)cur.pn * tstep;
    S.a_ready(cur);
    if constexpr (SP2) {
        PG8_STAGE(PG8_SB(0, 0), cB, voffB); PG8_STAGE(PG8_SB(0, 1), cB + hstep, voffB); PG8_STAGE(PG8_SA(0, 0), cA, voffA); PG8_STAGE(PG8_SA(0, 1), cA + hstep, voffA);
        if (wr == 1) PG8_BAR;
        PG8_WAIT_V(2); PG8_BAR;
        PG8_STAGE(PG8_SB(1, 0), cB + kstep, voffB); PG8_STAGE(PG8_SA(1, 0), cA + kstep, voffA); PG8_STAGE(PG8_SB(1, 1), cB + hstep + kstep, voffB);
        PG8_WAIT_V(6); PG8_BAR;
    } else {
        PG8_STAGE(PG8_SB(0, 0), cB, voffB); PG8_STAGE(PG8_SA(0, 0), cA, voffA); PG8_STAGE(PG8_SB(0, 1), cB + hstep, voffB); PG8_STAGE(PG8_SA(0, 1), cA + hstep, voffA);
        if (wr == 1) PG8_BAR;
        PG8_WAIT_V(4); PG8_BAR;
        PG8_STAGE(PG8_SB(1, 0), cB + kstep, voffB); PG8_STAGE(PG8_SA(1, 0), cA + kstep, voffA); PG8_STAGE(PG8_SB(1, 1), cB + hstep + kstep, voffB);
        PG8_WAIT_V(6); PG8_BAR;
    }
    for (;;) {
        const bool has_next = S.next(ui + 1, nxt);
        const char* nA = has_next ? (const char*)g.A + (size_t)nxt.pm * tstep : cA; const char* nB = has_next ? (const char*)g.Bt + (size_t)nxt.pn * tstep : cB;
        for (int t = 0; t < nt; t += 2) {
            const bool last = (t == nt - 2);
            const char* a1 = cA + (size_t)(t + 1) * kstep;
            const char* a2 = last ? nA : cA + (size_t)(t + 2) * kstep; const char* b2 = last ? nB : cB + (size_t)(t + 2) * kstep;
            const char* a3 = a2 + kstep; const char* b3 = b2 + kstep;
            if (last && has_next) S.a_ready(nxt);
            if constexpr (SP2) {
            PG8_LDB(B0, 0, 0); PG8_LDB(B1, 0, 1); PG8_SCHED; PG8_LDA(At, 0, 0); PG8_STAGE(PG8_SA(1, 1), a1 + hstep, voffA);
            PG8_WAIT_V(8); PG8_WAIT_L(0); PG8_BAR; PG8_MMA(0, 0, At, B0); PG8_MMA(0, 1, At, B1); PG8_BAR; PG8_SCHED;
            PG8_LDA(At, 0, 1); PG8_STAGE(PG8_SB(0, 0), b2, voffB); PG8_STAGE(PG8_SB(0, 1), b2 + hstep, voffB); PG8_STAGE(PG8_SA(0, 0), a2, voffA);
            PG8_WAIT_V(8); PG8_WAIT_L(0); PG8_BAR; PG8_MMA(1, 0, At, B0); PG8_MMA(1, 1, At, B1); PG8_BAR; PG8_SCHED;
            PG8_LDB(B0, 1, 0); PG8_LDB(B1, 1, 1); PG8_SCHED; PG8_LDA(At, 1, 0); PG8_STAGE(PG8_SA(0, 1), a2 + hstep, voffA);
            PG8_WAIT_V(8); PG8_WAIT_L(0); PG8_BAR; PG8_MMA(0, 0, At, B0); PG8_MMA(0, 1, At, B1); PG8_BAR; PG8_SCHED;
            PG8_LDA(At, 1, 1); PG8_STAGE(PG8_SB(1, 0), b3, voffB); PG8_STAGE(PG8_SB(1, 1), b3 + hstep, voffB); PG8_STAGE(PG8_SA(1, 0), a3, voffA);
            PG8_WAIT_V(8); PG8_WAIT_L(0); PG8_BAR; PG8_MMA(1, 0, At, B0); PG8_MMA(1, 1, At, B1); PG8_BAR; PG8_SCHED;
            } else {
            PG8_LDB(B0, 0, 0); PG8_SCHED; PG8_LDA(At, 0, 0); PG8_STAGE(PG8_SA(1, 1), a1 + hstep, voffA);
            PG8_WAIT_L(8); PG8_BAR; PG8_WAIT_L(0); PG8_MMA(0, 0, At, B0); PG8_BAR; PG8_SCHED;
            PG8_LDB(B1, 0, 1); PG8_STAGE(PG8_SB(0, 0), b2, voffB);
            PG8_BAR; PG8_WAIT_L(0); PG8_MMA(0, 1, At, B1); PG8_BAR;
            PG8_LDA(At, 0, 1); PG8_STAGE(PG8_SA(0, 0), a2, voffA);
            PG8_BAR; PG8_WAIT_L(0); PG8_MMA(1, 0, At, B0); PG8_BAR; PG8_SCHED;
            PG8_STAGE(PG8_SB(0, 1), b2 + hstep, voffB);
            PG8_WAIT_V(6); PG8_BAR; PG8_MMA(1, 1, At, B1); PG8_BAR;
            PG8_LDB(B0, 1, 0); PG8_SCHED; PG8_LDA(At, 1, 0); PG8_STAGE(PG8_SA(0, 1), a2 + hstep, voffA);
            PG8_WAIT_L(8); PG8_BAR; PG8_WAIT_L(0); PG8_MMA(0, 0, At, B0); PG8_BAR; PG8_SCHED;
            PG8_LDB(B1, 1, 1); PG8_STAGE(PG8_SB(1, 0), b3, voffB);
            PG8_BAR; PG8_WAIT_L(0); PG8_MMA(0, 1, At, B1); PG8_BAR;
            PG8_LDA(At, 1, 1); PG8_STAGE(PG8_SA(1, 0), a3, voffA);
            PG8_BAR; PG8_WAIT_L(0); PG8_MMA(1, 0, At, B0); PG8_BAR; PG8_SCHED;
            PG8_STAGE(PG8_SB(1, 1), b3 + hstep, voffB);
            PG8_WAIT_V(6); PG8_BAR; PG8_MMA(1, 1, At, B1); PG8_BAR;
            }
        }
        if constexpr (ALIGN_EPI) { if (wr == 0) PG8_BAR; }
        if constexpr (!Epi::AFTER_DRAIN) { E(acc, cur, wr, wc, fr, fq); S.done(cur); }
        if (!has_next) break;
#pragma unroll
        for (int a = 0; a < 2; ++a)
#pragma unroll
            for (int b = 0; b < 2; ++b)
#pragma unroll
                for (int m = 0; m < 4; ++m)
#pragma unroll
                    for (int n = 0; n < 2; ++n) acc[a][b][m][n] = (f32x4){0.f, 0.f, 0.f, 0.f};
        cur = nxt; cA = nA; cB = nB; ++ui;
        if constexpr (ALIGN_EPI) { if (wr == 1) PG8_BAR; }
    }
    PG8_WAIT_V(0);
    if constexpr (!ALIGN_EPI) { if (wr == 0) PG8_BAR; }
    PG8_BAR;
    if constexpr (Epi::AFTER_DRAIN) { E.fused(acc, cur, wr, wc, fr, fq, lds, wid, lane); S.done(cur); }
#undef PG8_SA
#undef PG8_SB
#undef PG8_STAGE
#undef PG8_LDA
#undef PG8_LDB
#undef PG8_MMA
#undef PG8_WAIT_V
#undef PG8_WAIT_L
#undef PG8_BAR
#undef PG8_SCHED
}
}

#ifndef PG8_SP2
#define PG8_SP2 true
#endif
#include <hip/hip_bf16.h>
#include <cmath>
namespace attn_body {
using bf16=__hip_bfloat16;
using bf16x8=__attribute__((ext_vector_type(8)))short;
using s16x4=__attribute__((ext_vector_type(4)))short;
using f32x16=__attribute__((ext_vector_type(16)))float;
using u32x4=__attribute__((ext_vector_type(4)))unsigned;
constexpr int BATCH=8,NHEAD=8,SEQ=4096,D=64,DM=3072,OPITCH=1024;
constexpr int NW=8,QBLK=32,QB=QBLK*NW,KVBLK=64,NQB=SEQ/QB;
constexpr int ATTN_PITCH=DM, ATTN_UNIT_ROWS=QB;
__device__ __forceinline__ int crow(int r,int hi){return (r&3)+8*(r>>2)+4*hi;}
#define SBAR() __builtin_amdgcn_sched_barrier(0)
__device__ __forceinline__ void cmask(f32x16&p0,f32x16&p1,int jb,int qrel,int hi){
  const float NEG=-INFINITY; int kb=64*jb+4*hi;
  #pragma unroll
  for(int r=0;r<16;++r){int kv=kb+(r&3)+8*(r>>2); if(kv>qrel)p0[r]=NEG; if(kv+32>qrel)p1[r]=NEG;}
}

constexpr int NSLOT=3, SLOTB=8192;
constexpr int LDS_K=0, LDS_V=NSLOT*SLOTB, LDS_WS=2*NSLOT*SLOTB, LDS_OST=LDS_WS+NW*64*4, LDS_BYTES=LDS_OST+NW*4096;
constexpr float C2=0.125f*1.4426950408889634f;
__device__ __forceinline__ void glds16(const void*gsrc,unsigned lds_dst){unsigned keep;
  asm volatile("s_mov_b32 %0, m0\n\ts_mov_b32 m0, %2\n\ts_nop 0\n\tglobal_load_lds_dwordx4 %1, off\n\ts_mov_b32 m0, %0":"=&s"(keep):"v"(gsrc),"s"(lds_dst):"memory");}
__device__ __forceinline__ float max3f(float a,float b,float c){float r;asm("v_max3_f32 %0, %1, %2, %3":"=v"(r):"v"(a),"v"(b),"v"(c));return r;}
__device__ __forceinline__ float max2f(float a,float b){float r;asm("v_max_f32_e32 %0, %1, %2":"=v"(r):"v"(a),"v"(b));return r;}
__device__ __forceinline__ float fadd_s(float a,float b){float r;asm("v_add_f32_e32 %0, %1, %2":"=v"(r):"v"(a),"v"(b));return r;}
__device__ __forceinline__ float fsub_s(float a,float b){float r;asm("v_sub_f32_e32 %0, %1, %2":"=v"(r):"v"(a),"v"(b));return r;}
typedef float f32x2_t __attribute__((ext_vector_type(2))); typedef float f32x4_t __attribute__((ext_vector_type(4))); typedef __bf16 bf16x2_t __attribute__((ext_vector_type(2)));
__device__ __forceinline__ unsigned cvtpk_s(float lo,float hi){f32x2_t v={lo,hi};bf16x2_t b=__builtin_convertvector(v,bf16x2_t);return __builtin_bit_cast(unsigned,b);}
#define WAIT_BAR(N) asm volatile("s_waitcnt vmcnt(" #N ") lgkmcnt(0)\n\ts_barrier":::"memory")

__device__ __forceinline__ void qkt(f32x16&p0,f32x16&p1,const char*Kslot,const bf16x8*qr,int r32,int hi){
  const char*kb=Kslot+hi*1024+r32*16;
  #pragma unroll
  for(int d0=0;d0<4;++d0){
    const bf16x8 b0=*reinterpret_cast<const bf16x8*>(kb+d0*2048);
    const bf16x8 b1=*reinterpret_cast<const bf16x8*>(kb+d0*2048+512);
    p0=__builtin_amdgcn_mfma_f32_32x32x16_bf16(b0,qr[d0],p0,0,0,0);p1=__builtin_amdgcn_mfma_f32_32x32x16_bf16(b1,qr[d0],p1,0,0,0);}
}
typedef __attribute__((address_space(3))) const char* lds_cptr;
typedef short v4i16_t __attribute__((ext_vector_type(4)));
__device__ __forceinline__ void kload8(bf16x8*kf,lds_cptr kp){
  kf[0]=*(const __attribute__((address_space(3))) bf16x8*)(kp);      kf[1]=*(const __attribute__((address_space(3))) bf16x8*)(kp+512);
  kf[2]=*(const __attribute__((address_space(3))) bf16x8*)(kp+2048); kf[3]=*(const __attribute__((address_space(3))) bf16x8*)(kp+2560);
  kf[4]=*(const __attribute__((address_space(3))) bf16x8*)(kp+4096); kf[5]=*(const __attribute__((address_space(3))) bf16x8*)(kp+4608);
  kf[6]=*(const __attribute__((address_space(3))) bf16x8*)(kp+6144); kf[7]=*(const __attribute__((address_space(3))) bf16x8*)(kp+6656);
}
__device__ __forceinline__ void kload2(bf16x8*kf,lds_cptr kp,int j){ kf[2*j]=*(const __attribute__((address_space(3))) bf16x8*)(kp+j*2048); kf[2*j+1]=*(const __attribute__((address_space(3))) bf16x8*)(kp+j*2048+512); }
__device__ __forceinline__ s16x4 vtr(lds_cptr p){ return __builtin_bit_cast(s16x4,__builtin_amdgcn_ds_read_tr16_b64_v4i16((__attribute__((address_space(3))) v4i16_t*)p)); }
__device__ __forceinline__ float rowmax(const f32x16&p0,const f32x16&p1){
  float a=max3f(p0[0],p0[1],p1[0]),b=max3f(p0[2],p0[3],p1[1]);a=max3f(a,p1[2],p1[3]);
  #pragma unroll
  for(int r=4;r<16;r+=4){a=max3f(a,p0[r],p0[r+1]);b=max3f(b,p0[r+2],p0[r+3]);a=max3f(a,p1[r],p1[r+1]);b=max3f(b,p1[r+2],p1[r+3]);}
  const float m=max2f(a,b);
  auto rr=__builtin_amdgcn_permlane32_swap(__float_as_uint(m),__float_as_uint(m),false,false);
  return max2f(__uint_as_float(rr[0]),__uint_as_float(rr[1]));
}
__device__ __forceinline__ void pv(f32x16*o,int vb,bf16x8 pa0,bf16x8 pa1,bf16x8 pa2,bf16x8 pa3){
  #pragma unroll
  for(int d0=0;d0<2;++d0){s16x4 lo[4],hi[4];
    #pragma unroll
    for(int ks=0;ks<4;++ks){
      asm volatile("ds_read_b64_tr_b16 %0,%1 offset:%c2":"=&v"(lo[ks]):"v"(vb),"i"(d0*4096+ks*1024):"memory");
      asm volatile("ds_read_b64_tr_b16 %0,%1 offset:%c2":"=&v"(hi[ks]):"v"(vb),"i"(d0*4096+ks*1024+512):"memory");}
    asm volatile("s_waitcnt lgkmcnt(0)":::"memory");SBAR();
    #define PK(k) (bf16x8){lo[k][0],lo[k][1],lo[k][2],lo[k][3],hi[k][0],hi[k][1],hi[k][2],hi[k][3]}
    o[d0]=__builtin_amdgcn_mfma_f32_32x32x16_bf16(pa0,PK(0),o[d0],0,0,0);
    o[d0]=__builtin_amdgcn_mfma_f32_32x32x16_bf16(pa1,PK(1),o[d0],0,0,0);
    o[d0]=__builtin_amdgcn_mfma_f32_32x32x16_bf16(pa2,PK(2),o[d0],0,0,0);
    o[d0]=__builtin_amdgcn_mfma_f32_32x32x16_bf16(pa3,PK(3),o[d0],0,0,0);
    #undef PK
  }
}

#ifndef ATTN_STORE16
#define ATTN_STORE16(p,v) (*(u32x4*)(p)=(v))
#endif
typedef __attribute__((address_space(3))) const float* lds_fptr; typedef __attribute__((address_space(3))) const f32x4_t* lds_f4ptr;
template<int THRL> __device__ __forceinline__ void attn_unit(int b,int h,int qb,const bf16*Q,const bf16*__restrict__ K,const bf16*__restrict__ V,bf16*O,char*shm,lds_fptr cl,const float*__restrict__ gain){
  const int tid=threadIdx.x,lane=tid&63,r32=lane&31,hi=lane>>5; const int wid=__builtin_amdgcn_readfirstlane(tid>>6);
  const long rowbase=(long)b*SEQ; const int q0=qb*QB;
  const bf16*Qw=Q+(rowbase+q0+wid*QBLK)*DM+h*D;
  const bf16*Kh=K+rowbase*DM+h*D,*Vh=V+rowbase*DM+h*D;
  const unsigned lds0=(unsigned)(uintptr_t)shm;
  float*wsf=(float*)(shm+LDS_WS)+wid*64;
  const bf16*ksrc=Kh+(long)lane*DM+wid*8;
  const bf16*vsrc=Vh+(long)(16*(wid&3)+(lane>>2))*DM+(wid>>2)*32+(lane&3)*8;
  const unsigned kdst=lds0+LDS_K+wid*1024, vdst=lds0+LDS_V+wid*1024;
  #define DMA_K(t,slot) glds16(ksrc+(long)(t)*KVBLK*DM,(unsigned)__builtin_amdgcn_readfirstlane(kdst+(slot)))
  #define DMA_V(t,slot) glds16(vsrc+(long)(t)*KVBLK*DM,(unsigned)__builtin_amdgcn_readfirstlane(vdst+(slot)))
  const int vb0=(int)(lds0+LDS_V)+((lane>>4)&1)*32+(lane&3)*8+(4*hi+((lane&15)>>2))*64;
  const char*Kbase=shm+LDS_K; bf16x8 kf[8];
  const lds_cptr shm3=(lds_cptr)shm; const lds_cptr kp0=shm3+LDS_K+hi*1024+r32*16; const lds_cptr vp0=shm3+LDS_V+((lane>>4)&1)*32+(lane&3)*8+(4*hi+((lane&15)>>2))*64;
  const int NT=(q0+QB)/KVBLK;
  DMA_K(0,0);DMA_V(0,0);DMA_K(1,SLOTB);
  bf16x8 qr[4];
  #pragma unroll
  for(int d0=0;d0<4;++d0)qr[d0]=*reinterpret_cast<const bf16x8*>(&Qw[(long)r32*DM+d0*16+hi*8]);
  float l_reg=0.f;f32x16 o[2];o[0]=f32x16{};o[1]=f32x16{};
  const int qrel=wid*QBLK+r32;
  float aq=cl[q0+qrel];
  #define CINIT(C0,C1,t) do{ const lds_f4ptr cp_=(lds_f4ptr)(cl+64*(t)+4*hi); _Pragma("unroll") for(int j_=0;j_<4;++j_){ const f32x4_t v0_=cp_[2*j_],v1_=cp_[8+2*j_]; _Pragma("unroll") for(int i_=0;i_<4;++i_){ C0[4*j_+i_]=aq-v0_[i_]; C1[4*j_+i_]=aq-v1_[i_]; } } }while(0)
  #define CMASK(P0,P1,t) do{int jb_=(t)-(NT-4); if(jb_>=0)cmask(P0,P1,jb_,qrel,hi);}while(0)
  bool resc=false;
  #define START(P0,P1) do{ const float rm=rowmax(P0,P1); resc=false; \
    { const float dl=__builtin_fmaxf(rm,0.f);     aq=fsub_s(aq,dl); \
      _Pragma("unroll") for(int r=0;r<16;++r){P0[r]=fsub_s(P0[r],dl);P1[r]=fsub_s(P1[r],dl);} } \
    _Pragma("unroll") for(int r=0;r<16;++r)P0[r]=__builtin_amdgcn_exp2f(P0[r]); }while(0)
  #define RESC() do{ if(resc){ asm volatile("s_waitcnt lgkmcnt(0)":::"memory"); \
      _Pragma("unroll") for(int d_=0;d_<2;++d_) _Pragma("unroll") for(int r=0;r<16;++r)o[d_][r]*=wsf[crow(r,hi)]; } }while(0)
  f32x16 pA0,pA1,pB0,pB1;
  int sl_prev=0,sl_cur=0,sl_next=SLOTB;
  #define ROT() do{sl_prev=sl_cur;sl_cur=sl_next;sl_next=(sl_next==(NSLOT-1)*SLOTB)?0:sl_next+SLOTB;}while(0)
  DMA_K(2,2*SLOTB);
  WAIT_BAR(3);
  CINIT(pA0,pA1,0);qkt(pA0,pA1,Kbase,qr,r32,hi);asm volatile("s_nop 15\n\ts_nop 7":"+v"(pA0),"+v"(pA1));CMASK(pA0,pA1,0);
  START(pA0,pA1);
  _Pragma("unroll") for(int r=0;r<16;++r)pA1[r]=__builtin_amdgcn_exp2f(pA1[r]);
  WAIT_BAR(0);
  DMA_K(3,0);DMA_V(1,SLOTB);
  ROT();
  kload8(kf,kp0+sl_cur);
  WAIT_BAR(2);
  s16x4 vlo[8],vhi[8]; u32x4 pw0,pw1,pw2,pw3;
  #define PKW(P,B) cvtpk_s(P[B],P[B+1])
  #define PAF(k) __builtin_bit_cast(bf16x8,pw##k)
  #define VFR(i) (bf16x8){vlo[i][0],vlo[i][1],vlo[i][2],vlo[i][3],vhi[i][0],vhi[i][1],vhi[i][2],vhi[i][3]}
  #define PIN(x) asm volatile("":"+v"(x))
  #define MX3(a,b,c) __builtin_fmaxf(__builtin_fmaxf((a),(b)),(c))
  #define GAPA(MF,A0,A1,A2,A3,W0,W1,PW) do{ MF; sacc+=A0; sacc+=A1; sacc+=A2; sacc+=A3; PIN(sacc); W0; W1; PIN(PW); SBAR(); }while(0)
  #define EX(v) __builtin_amdgcn_exp2f(v)
  #define GAPB(MF,X,B) do{ MF; X[B]=EX(X[B]); X[B+1]=EX(X[B+1]); X[B+2]=EX(X[B+2]); X[B+3]=EX(X[B+3]); PIN(X); SBAR(); }while(0)
  #define VRD(i) do{ vlo[i]=vtr(vp_+(((i)>>2)*4096+((i)&3)*1024)); vhi[i]=vtr(vp_+(((i)>>2)*4096+((i)&3)*1024+512)); }while(0)
  #define KRD(G,j) do{ if(G){ kload2(kf,kp0+sl_next,j); SBAR(); } }while(0)
  #define STEP(C0,C1,P0,P1,t,GK,GV,GL) do{ SBAR(); CINIT(C0,C1,t); SBAR(); \
    const lds_cptr vp_=vp0+sl_prev; \
    VRD(0); SBAR(); float sacc=(P0[0]+P0[1]); \
    GAPA(C0=__builtin_amdgcn_mfma_f32_32x32x16_bf16(kf[0],qr[0],C0,0,0,0), P0[2],P0[3],P0[4],P0[5],     pw0[0]=PKW(P0,0), pw0[1]=PKW(P0,2), pw0); \
    VRD(4); SBAR(); GAPA(C1=__builtin_amdgcn_mfma_f32_32x32x16_bf16(kf[1],qr[0],C1,0,0,0), P0[6],P0[7],P0[8],P0[9],     pw0[2]=PKW(P0,4), pw0[3]=PKW(P0,6), pw0); \
    VRD(1); SBAR(); GAPA(C0=__builtin_amdgcn_mfma_f32_32x32x16_bf16(kf[2],qr[1],C0,0,0,0),   P0[10],P0[11],P0[12],P0[13], pw1[0]=PKW(P0,8), pw1[1]=PKW(P0,10), pw1); \
    VRD(5); SBAR(); GAPA(C1=__builtin_amdgcn_mfma_f32_32x32x16_bf16(kf[3],qr[1],C1,0,0,0),   P0[14],P0[15],P1[0],P1[1],   pw1[2]=PKW(P0,12),pw1[3]=PKW(P0,14), pw1); \
    VRD(2); SBAR(); GAPA(C0=__builtin_amdgcn_mfma_f32_32x32x16_bf16(kf[4],qr[2],C0,0,0,0),   P1[2],P1[3],P1[4],P1[5],     pw2[0]=PKW(P1,0), pw2[1]=PKW(P1,2), pw2); \
    VRD(6); SBAR(); GAPA(C1=__builtin_amdgcn_mfma_f32_32x32x16_bf16(kf[5],qr[2],C1,0,0,0),   P1[6],P1[7],P1[8],P1[9],     pw2[2]=PKW(P1,4), pw2[3]=PKW(P1,6), pw2); \
    VRD(3); SBAR(); GAPA(C0=__builtin_amdgcn_mfma_f32_32x32x16_bf16(kf[6],qr[3],C0,0,0,0),   P1[10],P1[11],P1[12],P1[13], pw3[0]=PKW(P1,8), pw3[1]=PKW(P1,10), pw3); \
    VRD(7); SBAR(); GAPA(C1=__builtin_amdgcn_mfma_f32_32x32x16_bf16(kf[7],qr[3],C1,0,0,0),   P1[14],P1[15],0.f,0.f,       pw3[2]=PKW(P1,12),pw3[3]=PKW(P1,14), pw3); \
    l_reg+=sacc; \
    if(GK){DMA_K((t)+3,sl_cur);} if(GV){DMA_V((t)+1,sl_next);} \
    CMASK(C0,C1,t); \
    { float a=MX3(C0[0],C0[1],C1[0]),b=MX3(C0[2],C0[3],C1[1]); a=MX3(a,C1[2],C1[3]); \
      _Pragma("unroll") for(int r=4;r<16;r+=4){a=MX3(a,C0[r],C0[r+1]);b=MX3(b,C0[r+2],C0[r+3]);a=MX3(a,C1[r],C1[r+1]);b=MX3(b,C1[r+2],C1[r+3]);} \
      float rm=__builtin_fmaxf(a,b); { auto rr=__builtin_amdgcn_permlane32_swap(__float_as_uint(rm),__float_as_uint(rm),false,false); rm=__builtin_fmaxf(__uint_as_float(rr[0]),__uint_as_float(rr[1])); } \
      resc=false; \
      if(__builtin_expect(__any(rm>(float)THRL),0)){ const float dl=__builtin_fmaxf(rm,0.f); aq-=dl; \
        _Pragma("unroll") for(int r=0;r<16;++r){C0[r]-=dl;C1[r]-=dl;} \
        const float f=__builtin_amdgcn_exp2f(-dl); l_reg*=f; if(hi==0)wsf[r32]=f; resc=true; } } \
    SBAR(); \
    GAPB(o[0]=__builtin_amdgcn_mfma_f32_32x32x16_bf16(PAF(0),VFR(0),o[0],0,0,0), C0,0); \
    GAPB(o[1]=__builtin_amdgcn_mfma_f32_32x32x16_bf16(PAF(0),VFR(4),o[1],0,0,0), C0,4); \
    KRD(GL,0); GAPB(o[0]=__builtin_amdgcn_mfma_f32_32x32x16_bf16(PAF(1),VFR(1),o[0],0,0,0), C0,8); \
    KRD(GL,1); GAPB(o[1]=__builtin_amdgcn_mfma_f32_32x32x16_bf16(PAF(1),VFR(5),o[1],0,0,0), C0,12); \
    KRD(GL,2); GAPB(o[0]=__builtin_amdgcn_mfma_f32_32x32x16_bf16(PAF(2),VFR(2),o[0],0,0,0), C1,0); \
    KRD(GL,3); GAPB(o[1]=__builtin_amdgcn_mfma_f32_32x32x16_bf16(PAF(2),VFR(6),o[1],0,0,0), C1,4); \
    GAPB(o[0]=__builtin_amdgcn_mfma_f32_32x32x16_bf16(PAF(3),VFR(3),o[0],0,0,0), C1,8); \
    GAPB(o[1]=__builtin_amdgcn_mfma_f32_32x32x16_bf16(PAF(3),VFR(7),o[1],0,0,0), C1,12); \
    }while(0)
  int t=1;
  #undef CMASK
  #define CMASK(P0,P1,t) do{}while(0)
  for(;t+5<NT;t+=2){
    STEP(pB0,pB1,pA0,pA1,t,true,true,true);     WAIT_BAR(2); RESC(); ROT();
    STEP(pA0,pA1,pB0,pB1,t+1,true,true,true);   WAIT_BAR(2); RESC(); ROT();
  }
  #undef CMASK
  #define CMASK(P0,P1,t) do{int jb_=(t)-(NT-4); if(jb_>=0)cmask(P0,P1,jb_,qrel,hi);}while(0)
  #define ENDW(tt) do{ if((tt)+3<NT){WAIT_BAR(2);} else if((tt)+2<NT){WAIT_BAR(1);} else {WAIT_BAR(0);} }while(0)
  for(;t+1<NT;t+=2){
    STEP(pB0,pB1,pA0,pA1,t,(t+3<NT),(t+1<NT),(t+1<NT));       ENDW(t);   RESC(); ROT();
    STEP(pA0,pA1,pB0,pB1,t+1,(t+4<NT),(t+2<NT),(t+2<NT));     ENDW(t+1); RESC(); ROT();
  }
  STEP(pB0,pB1,pA0,pA1,NT-1,false,false,false); RESC();
  { float sacc=pB0[0]+pB0[1]; _Pragma("unroll") for(int r=2;r<16;++r)sacc+=pB0[r]; _Pragma("unroll") for(int r=0;r<16;++r)sacc+=pB1[r]; l_reg+=sacc;
    pw0=(u32x4){PKW(pB0,0),PKW(pB0,2),PKW(pB0,4),PKW(pB0,6)};pw1=(u32x4){PKW(pB0,8),PKW(pB0,10),PKW(pB0,12),PKW(pB0,14)};pw2=(u32x4){PKW(pB1,0),PKW(pB1,2),PKW(pB1,4),PKW(pB1,6)};pw3=(u32x4){PKW(pB1,8),PKW(pB1,10),PKW(pB1,12),PKW(pB1,14)};
    SBAR(); pv(o,vb0+sl_cur,PAF(0),PAF(1),PAF(2),PAF(3)); }
  #undef PKW
  #undef PAF
  #undef VFR
  #undef PIN
  #undef MX3
  #undef GAPA
  #undef GAPB
  #undef EX
  #undef VRD
  #undef KRD
  #undef STEP
  #undef ENDW
  {auto rr=__builtin_amdgcn_permlane32_swap(__float_as_uint(l_reg),__float_as_uint(l_reg),false,false);l_reg=__uint_as_float(rr[0])+__uint_as_float(rr[1]);}
  if(hi==0)wsf[32+r32]=l_reg;asm volatile("s_waitcnt lgkmcnt(0)":::"memory");
  float rli[16];
  #pragma unroll
  for(int r=0;r<16;++r)rli[r]=__builtin_amdgcn_rcpf(wsf[32+crow(r,hi)]);
  bf16*Ow=O+(rowbase+q0+wid*QBLK)*OPITCH+h*D;
  { bf16*stg=(bf16*)(shm+LDS_OST)+wid*2048;
    #pragma unroll
    for(int r=0;r<16;++r){const int orow=crow(r,hi);
      #pragma unroll
      for(int d0=0;d0<2;++d0)stg[orow*64+d0*32+r32]=__float2bfloat16(o[d0][r]*rli[r]);}
    asm volatile("s_waitcnt lgkmcnt(0)":::"memory");
    #pragma unroll
    for(int i=0;i<4;++i){const int row=i*8+(lane>>3),ch=lane&7; const u32x4 v=*(const u32x4*)(stg+row*64+ch*8);
      float x[8]; _Pragma("unroll") for(int k=0;k<4;++k){x[2*k]=__uint_as_float(v[k]<<16);x[2*k+1]=__uint_as_float(v[k]&0xffff0000u);}
      float ss=0.f; _Pragma("unroll") for(int k=0;k<8;++k)ss+=x[k]*x[k];
      ss+=__shfl_xor(ss,1);ss+=__shfl_xor(ss,2);ss+=__shfl_xor(ss,4);
      const float rs=1.0f/sqrtf(ss*(1.0f/64.0f)+1e-6f); const f32x4_t g0=*(const f32x4_t*)(gain+h*D+ch*8),g1=*(const f32x4_t*)(gain+h*D+ch*8+4);
      u32x4 w; w[0]=cvtpk_s(x[0]*rs*g0[0],x[1]*rs*g0[1]);w[1]=cvtpk_s(x[2]*rs*g0[2],x[3]*rs*g0[3]);w[2]=cvtpk_s(x[4]*rs*g1[0],x[5]*rs*g1[1]);w[3]=cvtpk_s(x[6]*rs*g1[2],x[7]*rs*g1[3]);
      ATTN_STORE16(Ow+(long)row*OPITCH+ch*8,w);} }
  asm volatile("s_waitcnt lgkmcnt(0)\n\ts_barrier":::"memory");
  #undef DMA_K
  #undef DMA_V
  #undef CMASK
  #undef START
  #undef CINIT
  #undef RESC
  #undef ROT
}
constexpr int ATTN_LDS_BYTES=LDS_BYTES;
#undef SBAR
#undef WAIT_BAR
}
#ifndef MK_MULTI
#define MK_MULTI 0
#endif
constexpr int NWAVES = 8, NTHR = 512;
constexpr int Mrows = 32768, DM_ = 1024, DFF = 2816, SEQL = 4096, DPLE = 256;
constexpr int NPH = 12;
constexpr size_t MiB = 1u << 20;
constexpr size_t WS_W1GU = 2 * MiB, WS_W1D = 14 * MiB, WS_WIN = 20 * MiB, WS_WOUT = 27 * MiB, WS_W2GU = 30 * MiB, WS_W2D = 42 * MiB, WS_WPG = 48 * MiB, WS_WPP = 50 * MiB;
constexpr size_t WS_GATES = 52 * MiB, WS_CL = 54 * MiB, WS_BARR = 55 * MiB, WS_RARR = 55 * MiB + 512 * 1024, WS_NLOC = 56 * MiB, WS_NPREV = 56 * MiB + 512 * 1024;
constexpr size_t WS_GARR = 57 * MiB, WS_MLOC = 57 * MiB + 65536, WS_MPREV = 57 * MiB + 131072;
constexpr size_t WS_SS0 = 58 * MiB, WS_SS1 = 60 * MiB, WS_SS2 = 62 * MiB, WS_SS3 = 64 * MiB, WS_SS4 = 66 * MiB, WS_SSP = 68 * MiB;
constexpr size_t WS_XN = 72 * MiB;
constexpr size_t WS_ACTZ = 136 * MiB;
constexpr size_t WS_YMIX = 328 * MiB;
constexpr size_t WS_UT = 392 * MiB;
constexpr size_t WS_CT = 456 * MiB;
constexpr size_t WS_PB = 488 * MiB;
constexpr size_t WS_END = 504 * MiB;
constexpr int LDS_BYTES = 147456;
constexpr int WIN_ROWS = 3328;

#define LAS __attribute__((address_space(3)))
typedef unsigned short bf16;
typedef unsigned v4u __attribute__((ext_vector_type(4)));
typedef float f32x4 __attribute__((ext_vector_type(4)));
typedef short bf16x8 __attribute__((ext_vector_type(8)));
#define LDS_WAIT() asm volatile("s_waitcnt lgkmcnt(0)" ::: "memory")
__device__ __forceinline__ unsigned f2bf(float f) { unsigned u = __builtin_bit_cast(unsigned, f); return (u + 0x7fffu + ((u >> 16) & 1u)) >> 16; }
__device__ __forceinline__ unsigned pk2(float lo, float hi) { return f2bf(lo) | (f2bf(hi) << 16); }
__device__ __forceinline__ float bf2f(unsigned h) { return __uint_as_float(h << 16); }
__device__ __forceinline__ float logsig_f(float x) { return fminf(x, 0.f) - log1pf(__expf(-fabsf(x))); }
__device__ __forceinline__ float sigm_f(float x) { return 1.0f / (1.0f + __expf(-x)); }

__device__ __forceinline__ int wmap(int map, int n) {
    if (map == 1) return ((n >> 7) << 8) + (n & 127);
    if (map == 2) return ((n >> 7) << 8) + 128 + (n & 127);
    if (map == 3) { if (n < 1536) return n; if (n < 1544) return 3072 + (n - 1536); if (n < 3080) return n - 8; return n; }
    return n;
}
__device__ __forceinline__ void p0_transpose_item(const float* __restrict__ W, int K, int N, bf16* WT, int map, const float* __restrict__ gain, LAS float* scr, int item, int lane) {
    const int nblk = (N + 31) / 32, kb = item / nblk, nb = item % nblk, k0 = 64 * kb, n0 = 32 * nb;
    const int nin = n0 + (lane & 31); const bool ok = nin < N;
    float wv_[32];
#pragma unroll
    for (int i = 0; i < 32; ++i) { const int kk = 2 * i + (lane >> 5); wv_[i] = ok ? W[(size_t)(k0 + kk) * N + nin] : 0.f; }
#pragma unroll
    for (int i = 0; i < 32; ++i) { const int kk = 2 * i + (lane >> 5); float v = wv_[i]; if (gain) v *= gain[k0 + kk]; scr[kk * 33 + (lane & 31)] = v; }
    LDS_WAIT(); asm volatile("" ::: "memory");
    const int c = lane & 7;
#pragma unroll
    for (int j = 0; j < 4; ++j) { const int n = (lane >> 3) + 8 * j; const LAS float* s = scr + (8 * c) * 33 + n;
        v4u o; o.x = pk2(s[0 * 33], s[1 * 33]); o.y = pk2(s[2 * 33], s[3 * 33]); o.z = pk2(s[4 * 33], s[5 * 33]); o.w = pk2(s[6 * 33], s[7 * 33]);
        if (n0 + n < N) *(v4u*)(WT + (size_t)wmap(map, n0 + n) * K + k0 + 8 * c) = o; }
    LDS_WAIT(); asm volatile("" ::: "memory");
}

constexpr int LDS_LD = 72;
__device__ __forceinline__ bf16x8 frag(const LAS bf16* X, int r0, int k0, int lane) { return *(const LAS bf16x8*)(X + (r0 + (lane & 15)) * LDS_LD + k0 + 8 * (lane >> 4)); }
#define MMA16(a, b, c) __builtin_amdgcn_mfma_f32_16x16x32_bf16((a), (b), (c), 0, 0, 0)

struct Ptrs {
    const float* gates; float *barr, *rarr, *nloc, *nprev, *garr, *mloc, *mprev, *ut; bf16 *ct, *qkc, *z, *ymix; const float *conv, *gm;
};

struct LocRegs { v4u zq[2][4]; v4u vv[2]; float ip, fp; };
__device__ __forceinline__ void loc_load(LocRegs& R, int ci, const Ptrs& P) {
    const int tid = threadIdx.x, lane = tid & 63, wid = tid >> 6;
    const int bh = ci >> 6, c = ci & 63, b = bh >> 2, h = bh & 3;
    const size_t row0 = (size_t)b * SEQL + (size_t)c * 64;
    const int cg8 = tid & 15, tl = tid >> 4, isk = cg8 >> 3, zc = isk * 256 + h * 64 + (cg8 & 7) * 8;
#pragma unroll
    for (int p = 0; p < 2; ++p) { const int tpos = c * 64 + tl + 32 * p;
#pragma unroll
        for (int j = 0; j < 4; ++j) { int tp = tpos - 3 + j; tp = tp < 0 ? 0 : tp; R.zq[p][j] = *(const v4u*)(P.z + ((size_t)b * SEQL + tp) * 3072 + zc); }
        R.vv[p] = *(const v4u*)(P.z + (row0 + lane) * 3072 + 512 + h * 128 + wid * 16 + 8 * p); }
    if (wid == 0) { R.ip = P.gates[(row0 + lane) * 16 + h]; R.fp = P.gates[(row0 + lane) * 16 + 4 + h]; } else { R.ip = 0.f; R.fp = 0.f; }
}
__device__ __forceinline__ void loc_compute(const LocRegs& R, int ci, LAS unsigned char* lds, const Ptrs& P) {
    const int tid = threadIdx.x, lane = tid & 63, wid = tid >> 6;
    const int bh = ci >> 6, c = ci & 63, b = bh >> 2, h = bh & 3;
    const size_t row0 = (size_t)b * SEQL + (size_t)c * 64;
    LAS bf16* KwT = (LAS bf16*)lds;
    LAS bf16* VT = (LAS bf16*)(lds + 9216);
    LAS float* wv = (LAS float*)(lds + 9216 + 18432);
    if (wid == 0) {
        float bc = logsig_f(R.fp);
#pragma unroll
        for (int o = 1; o < 64; o <<= 1) { const float t = __shfl_up(bc, o); if (lane >= o) bc += t; }
        const float g = __shfl(bc, 63);
        const float r = R.ip - bc; float rm = r;
#pragma unroll
        for (int o = 1; o < 64; o <<= 1) rm = fmaxf(rm, __shfl_xor(rm, o));
        wv[lane] = __expf(r - rm);
        P.barr[ci * 64 + lane] = bc; P.rarr[ci * 64 + lane] = r; if (lane == 0) { P.garr[ci] = g; P.mloc[ci] = g + rm; }
    }
    const int cg8 = tid & 15, tl = tid >> 4, isk = cg8 >> 3, zc = isk * 256 + h * 64 + (cg8 & 7) * 8;
    float kv[2][8];
    {
        float cw[4][8];
#pragma unroll
        for (int j = 0; j < 4; ++j) { const f32x4 a = *(const f32x4*)(P.conv + j * 512 + zc), d = *(const f32x4*)(P.conv + j * 512 + zc + 4);
#pragma unroll
            for (int i = 0; i < 4; ++i) { cw[j][i] = a[i]; cw[j][4 + i] = d[i]; } }
#pragma unroll
        for (int p = 0; p < 2; ++p) { const int t = tl + 32 * p, tpos = c * 64 + t; float a[8];
#pragma unroll
            for (int i = 0; i < 8; ++i) a[i] = 0.f;
#pragma unroll
            for (int j = 0; j < 4; ++j) { const float ok = (tpos - 3 + j) >= 0 ? 1.0f : 0.0f; const v4u zz = R.zq[p][j];
#pragma unroll
                for (int k = 0; k < 4; ++k) { a[2 * k] += (cw[j][2 * k] * ok) * bf2f(zz[k] & 0xffffu); a[2 * k + 1] += (cw[j][2 * k + 1] * ok) * __uint_as_float(zz[k] & 0xffff0000u); } }
            const float sc = isk ? 1.0f : 0.125f;
#pragma unroll
            for (int i = 0; i < 8; ++i) { a[i] = a[i] * sigm_f(a[i]) * sc; kv[p][i] = a[i]; }
            v4u o; o.x = pk2(a[0], a[1]); o.y = pk2(a[2], a[3]); o.z = pk2(a[4], a[5]); o.w = pk2(a[6], a[7]);
            *(v4u*)(P.qkc + (row0 + t) * 512 + zc) = o; }
    }
#pragma unroll
    for (int p = 0; p < 2; ++p) { const v4u vv = R.vv[p];
#pragma unroll
        for (int k = 0; k < 4; ++k) { VT[(wid * 16 + 8 * p + 2 * k) * LDS_LD + lane] = (bf16)(vv[k] & 0xffffu); VT[(wid * 16 + 8 * p + 2 * k + 1) * LDS_LD + lane] = (bf16)(vv[k] >> 16); } }
    __syncthreads();
    if (isk) {
#pragma unroll
        for (int p = 0; p < 2; ++p) { const int t = tl + 32 * p; const float w = wv[t];
#pragma unroll
            for (int i = 0; i < 8; ++i) KwT[((cg8 & 7) * 8 + i) * LDS_LD + t] = (bf16)f2bf(kv[p][i] * w); }
    }
    __syncthreads();
    {
        f32x4 acc[4];
#pragma unroll
        for (int dj = 0; dj < 4; ++dj) acc[dj] = (f32x4){0.f, 0.f, 0.f, 0.f};
#pragma unroll
        for (int ks = 0; ks < 2; ++ks) { const bf16x8 a = frag(VT, 16 * wid, ks * 32, lane);
#pragma unroll
            for (int dj = 0; dj < 4; ++dj) acc[dj] = MMA16(a, frag(KwT, 16 * dj, ks * 32, lane), acc[dj]); }
        float* up = P.ut + (size_t)ci * 8192;
#pragma unroll
        for (int dj = 0; dj < 4; ++dj)
#pragma unroll
            for (int r = 0; r < 4; ++r) up[(16 * wid + 4 * (lane >> 4) + r) * 64 + 16 * dj + (lane & 15)] = acc[dj][r];
    }
    if (wid == 0) { float s = 0.f;
#pragma unroll 8
        for (int i = 0; i < 64; ++i) s += bf2f(KwT[lane * LDS_LD + i]);
        P.nloc[ci * 64 + lane] = s; }
    __syncthreads();
}
__device__ __forceinline__ void mlstm_local_phase(int first, int step, int n, LAS unsigned char* lds, const Ptrs& P) {
    LocRegs A, B; int it = first;
    if (it < n) loc_load(A, it, P);
    while (it < n) {
        const int n1 = it + step; if (n1 < n) loc_load(B, n1, P);
        loc_compute(A, it, lds, P);
        it = n1; if (it >= n) break;
        const int n2 = it + step; if (n2 < n) loc_load(A, n2, P);
        loc_compute(B, it, lds, P);
        it = n2;
    }
}

struct OutRegs { v4u q, k, ct[2], vv[2], mo[2]; float r, bt, mp, np; };
__device__ __forceinline__ void out_load(OutRegs& R, int ci, const Ptrs& P) {
    const int tid = threadIdx.x, lane = tid & 63, wid = tid >> 6;
    const int bh = ci >> 6, c = ci & 63, b = bh >> 2, h = bh & 3;
    const size_t row0 = (size_t)b * SEQL + (size_t)c * 64;
    const int t8 = tid >> 3, part = tid & 7, cg8 = tid & 15, tl = tid >> 4;
    R.q = *(const v4u*)(P.qkc + (row0 + t8) * 512 + h * 64 + part * 8);
    R.k = *(const v4u*)(P.qkc + (row0 + t8) * 512 + 256 + h * 64 + part * 8);
#pragma unroll
    for (int p = 0; p < 2; ++p) { const int idx = tid + 512 * p, e = idx >> 3, pp = idx & 7; R.ct[p] = *(const v4u*)(P.ct + (size_t)ci * 8192 + e * 64 + pp * 8);
        R.vv[p] = *(const v4u*)(P.z + (row0 + lane) * 3072 + 512 + h * 128 + wid * 16 + 8 * p);
        R.mo[p] = *(const v4u*)(P.z + (row0 + t8) * 3072 + 1024 + h * 128 + part * 16 + 8 * p); }
    if (wid == 0) { R.r = P.rarr[ci * 64 + lane]; R.bt = P.barr[ci * 64 + lane]; R.mp = P.mprev[ci]; R.np = P.nprev[ci * 64 + lane]; } else { R.r = 0.f; R.bt = 0.f; R.mp = 0.f; R.np = 0.f; }
}
__device__ __forceinline__ void out_compute(const OutRegs& R, int ci, LAS unsigned char* lds, const Ptrs& P) {
    const int tid = threadIdx.x, lane = tid & 63, wid = tid >> 6;
    const int bh = ci >> 6, c = ci & 63, b = bh >> 2, h = bh & 3;
    const size_t row0 = (size_t)b * SEQL + (size_t)c * 64;
    LAS bf16* Qs = (LAS bf16*)lds; LAS bf16* Qw = (LAS bf16*)(lds + 9216); LAS bf16* Ks = (LAS bf16*)(lds + 18432); LAS bf16* Ps = (LAS bf16*)(lds + 27648);
    LAS bf16* VT = (LAS bf16*)(lds + 36864); LAS bf16* CTs = (LAS bf16*)(lds + 55296); LAS float* NUM = (LAS float*)(lds + 73728);
    LAS float* rvec = (LAS float*)(lds + 107520); LAS float* Mt = rvec + 64; LAS float* wint = rvec + 128; LAS float* emt = rvec + 192; LAS float* npv = rvec + 256; LAS float* denom = rvec + 320;
    if (wid == 0) {
        float cm = R.r;
#pragma unroll
        for (int o = 1; o < 64; o <<= 1) { const float t = __shfl_up(cm, o); if (lane >= o) cm = fmaxf(cm, t); }
        const float M = fmaxf(R.mp, cm);
        rvec[lane] = R.r; Mt[lane] = M; wint[lane] = __expf(R.mp - M); emt[lane] = __expf(-R.bt - M); npv[lane] = R.np;
    }
    const int t8 = tid >> 3, part = tid & 7;
    *(LAS v4u*)(Qs + t8 * LDS_LD + part * 8) = R.q; *(LAS v4u*)(Ks + t8 * LDS_LD + part * 8) = R.k;
#pragma unroll
    for (int p = 0; p < 2; ++p) { const int idx = tid + 512 * p, e = idx >> 3, pp = idx & 7; *(LAS v4u*)(CTs + e * LDS_LD + pp * 8) = R.ct[p]; }
    {
#pragma unroll
      for (int p = 0; p < 2; ++p) { const v4u vv = R.vv[p];
#pragma unroll
        for (int k = 0; k < 4; ++k) { VT[(wid * 16 + 8 * p + 2 * k) * LDS_LD + lane] = (bf16)(vv[k] & 0xffffu); VT[(wid * 16 + 8 * p + 2 * k + 1) * LDS_LD + lane] = (bf16)(vv[k] >> 16); } } }
    __syncthreads();
    { const float w = wint[t8]; const v4u q = R.q; v4u o;
#pragma unroll
      for (int k = 0; k < 4; ++k) o[k] = pk2(bf2f(q[k] & 0xffffu) * w, __uint_as_float(q[k] & 0xffff0000u) * w);
      *(LAS v4u*)(Qw + t8 * LDS_LD + part * 8) = o; }
    {
        const int ti = wid >> 1;
#pragma unroll
        for (int jj = 0; jj < 2; ++jj) { const int sj = 2 * (wid & 1) + jj; f32x4 acc = (f32x4){0.f, 0.f, 0.f, 0.f};
            if (sj <= ti) {
#pragma unroll
                for (int ks = 0; ks < 2; ++ks) acc = MMA16(frag(Qs, 16 * ti, ks * 32, lane), frag(Ks, 16 * sj, ks * 32, lane), acc);
            }
            const int s = 16 * sj + (lane & 15); const float rs = rvec[s];
#pragma unroll
            for (int r = 0; r < 4; ++r) { const int t = 16 * ti + 4 * (lane >> 4) + r; const float pv = (s <= t) ? __expf(rs - Mt[t]) * acc[r] : 0.f; Ps[t * LDS_LD + s] = (bf16)f2bf(pv); } }
    }
    __syncthreads();
    {
        const v4u q = R.q, pp = *(const LAS v4u*)(Ps + t8 * LDS_LD + part * 8); float dot = 0.f, ps = 0.f;
#pragma unroll
        for (int k = 0; k < 4; ++k) { dot += bf2f(q[k] & 0xffffu) * npv[part * 8 + 2 * k] + __uint_as_float(q[k] & 0xffff0000u) * npv[part * 8 + 2 * k + 1]; ps += bf2f(pp[k] & 0xffffu) + __uint_as_float(pp[k] & 0xffff0000u); }
        float v = wint[t8] * dot + ps; v += __shfl_xor(v, 1); v += __shfl_xor(v, 2); v += __shfl_xor(v, 4);
        if (part == 0) denom[t8] = fmaxf(fabsf(v), emt[t8]);
    }
    {
        const int ti = wid >> 1, eh = wid & 1; f32x4 acc[4];
#pragma unroll
        for (int ej = 0; ej < 4; ++ej) acc[ej] = (f32x4){0.f, 0.f, 0.f, 0.f};
#pragma unroll
        for (int ks = 0; ks < 2; ++ks) { const bf16x8 a = frag(Qw, 16 * ti, ks * 32, lane);
#pragma unroll
            for (int ej = 0; ej < 4; ++ej) acc[ej] = MMA16(a, frag(CTs, 64 * eh + 16 * ej, ks * 32, lane), acc[ej]); }
#pragma unroll
        for (int ks = 0; ks < 2; ++ks) { const bf16x8 a = frag(Ps, 16 * ti, ks * 32, lane);
#pragma unroll
            for (int ej = 0; ej < 4; ++ej) acc[ej] = MMA16(a, frag(VT, 64 * eh + 16 * ej, ks * 32, lane), acc[ej]); }
#pragma unroll
        for (int ej = 0; ej < 4; ++ej)
#pragma unroll
            for (int r = 0; r < 4; ++r) NUM[(16 * ti + 4 * (lane >> 4) + r) * 132 + 64 * eh + 16 * ej + (lane & 15)] = acc[ej][r];
    }
    __syncthreads();
    {
        const float rd = 1.0f / denom[t8]; float hv[16]; float ss = 0.f;
#pragma unroll
        for (int i = 0; i < 4; ++i) { const f32x4 x = *(const LAS f32x4*)(NUM + t8 * 132 + part * 16 + 4 * i);
#pragma unroll
            for (int k = 0; k < 4; ++k) { hv[4 * i + k] = x[k] * rd; ss += hv[4 * i + k] * hv[4 * i + k]; } }
        ss += __shfl_xor(ss, 1); ss += __shfl_xor(ss, 2); ss += __shfl_xor(ss, 4);
        const float rs = 1.0f / sqrtf(ss * (1.0f / 128.0f) + 1e-6f);
        const float* gmp = P.gm + h * 128 + part * 16; bf16* yo = P.ymix + (row0 + t8) * 1024 + h * 128 + part * 16;
#pragma unroll
        for (int hh = 0; hh < 2; ++hh) { const v4u mv = R.mo[hh]; const f32x4 g0 = *(const f32x4*)(gmp + 8 * hh), g1 = *(const f32x4*)(gmp + 8 * hh + 4); float y[8];
#pragma unroll
            for (int k = 0; k < 4; ++k) { const float m0 = bf2f(mv[k] & 0xffffu), m1 = __uint_as_float(mv[k] & 0xffff0000u); const float ga = k < 2 ? g0[2 * k] : g1[2 * k - 4], gb = k < 2 ? g0[2 * k + 1] : g1[2 * k - 3];
                y[2 * k] = hv[8 * hh + 2 * k] * rs * ga * sigm_f(m0); y[2 * k + 1] = hv[8 * hh + 2 * k + 1] * rs * gb * sigm_f(m1); }
            v4u o; o.x = pk2(y[0], y[1]); o.y = pk2(y[2], y[3]); o.z = pk2(y[4], y[5]); o.w = pk2(y[6], y[7]);
            *(v4u*)(yo + 8 * hh) = o; }
    }
    __syncthreads();
}
__device__ __forceinline__ void mlstm_out_phase(int first, int step, int n, LAS unsigned char* lds, const Ptrs& P) {
    OutRegs A, B; int it = first;
    if (it < n) out_load(A, it & 2047, P);
    while (it < n) {
        const int n1 = it + step; if (n1 < n) out_load(B, n1 & 2047, P);
        out_compute(A, it & 2047, lds, P);
        it = n1; if (it >= n) break;
        const int n2 = it + step; if (n2 < n) out_load(A, n2 & 2047, P);
        out_compute(B, it & 2047, lds, P);
        it = n2;
    }
}

typedef unsigned u32;
#define RLX_AGENT __ATOMIC_RELAXED, __HIP_MEMORY_SCOPE_AGENT
#define XB_TMO      128
#define XB_XCNT(j)  (256  + 64 * (j))
#define XB_XSUB(j)  (1280 + 64 * (j))
#define XB_XGEN(j)  (2304 + 64 * (j))
#define XB_TOP      3328
#define XB_TOPGEN   3392
#define XCD_BAR_WORDS 3456
#define XB_SPIN_CAP (1u << 18)

__device__ __forceinline__ unsigned xb_ld(unsigned* p)              { return __hip_atomic_load(p, __ATOMIC_RELAXED, __HIP_MEMORY_SCOPE_AGENT); }
__device__ __forceinline__ unsigned xb_add(unsigned* p, unsigned v) { return __hip_atomic_fetch_add(p, v, __ATOMIC_RELAXED, __HIP_MEMORY_SCOPE_AGENT); }
__device__ __forceinline__ unsigned xb_xcc_id() { return (unsigned)__builtin_amdgcn_s_getreg((3 << 11) | 20) & 0xFu; }
#define XB_SPIN(cond, bar) do { unsigned _sp = 0; while (cond) { __builtin_amdgcn_s_sleep(1); \
    if ((++_sp & 255u) == 0u) { if (xb_ld(&(bar)[XB_TMO])) break; if (_sp > XB_SPIN_CAP) { atomicAdd(&(bar)[XB_TMO], 1u); break; } } } } while (0)

struct XcdBarrier {
    unsigned* bar; unsigned x;
    volatile LAS unsigned* st;
};

__device__ __forceinline__ XcdBarrier xcd_barrier_post(unsigned* bar, volatile LAS unsigned* st) {
    XcdBarrier b; b.bar = bar; b.x = xb_xcc_id(); b.st = st;
    if (threadIdx.x == 0) (void)xb_add(&bar[XB_XCNT(b.x)], 1u);
    return b;
}
__device__ __forceinline__ void xcd_barrier_complete(unsigned* bar, unsigned x, unsigned& nloc, unsigned& nx) {
    const unsigned G = gridDim.x * gridDim.y * gridDim.z;
    unsigned sum, cnt, mine, sp = 0u;
    for (;;) {
        sum = 0u; cnt = 0u; mine = 0u;
#pragma unroll
        for (unsigned j = 0; j < 16; ++j) { const unsigned c = xb_ld(&bar[XB_XCNT(j)]); sum += c; cnt += (c > 0u) ? 1u : 0u; mine = (j == x) ? c : mine; }
        if (sum == G) break;
        __builtin_amdgcn_s_sleep(1);
        if ((++sp & 255u) == 0u) { if (xb_ld(&bar[XB_TMO])) break; if (sp > XB_SPIN_CAP) { atomicAdd(&bar[XB_TMO], 1u); break; } }
    }
    nloc = mine > 0u ? mine : 1u; nx = cnt > 0u ? cnt : 1u;
}

__device__ __forceinline__ void xcd_barrier(const XcdBarrier& b) {
    asm volatile("s_waitcnt vmcnt(0)" ::: "memory");
    __syncthreads();
    if (threadIdx.x == 0) {
        unsigned* bar = b.bar;
        __builtin_amdgcn_s_waitcnt(0);
        unsigned nloc = b.st[0], nx = b.st[1];
        if (nloc == 0u) { xcd_barrier_complete(bar, b.x, nloc, nx); b.st[0] = nloc; b.st[1] = nx; }
        const unsigned old = xb_add(&bar[XB_XSUB(b.x)], 1u);
        const unsigned gen = old / nloc;
        if (old + 1u == (gen + 1u) * nloc) {
            __builtin_amdgcn_fence(__ATOMIC_RELEASE, "agent");
            asm volatile("s_waitcnt vmcnt(0)" ::: "memory");
            const unsigned og = xb_add(&bar[XB_TOP], 1u);
            const unsigned tg = og / nx;
            if (og + 1u == (tg + 1u) * nx) xb_add(&bar[XB_TOPGEN], 1u);
            else XB_SPIN(xb_ld(&bar[XB_TOPGEN]) == tg, bar);
            __builtin_amdgcn_fence(__ATOMIC_ACQUIRE, "agent");
            xb_add(&bar[XB_XGEN(b.x)], 1u);
            asm volatile("s_waitcnt vmcnt(0)" ::: "memory");
        } else {
            XB_SPIN(xb_ld(&bar[XB_XGEN(b.x)]) == gen, bar);
            __builtin_amdgcn_fence(__ATOMIC_ACQUIRE, "agent");
            asm volatile("s_waitcnt vmcnt(0)" ::: "memory");
        }
    }
    __syncthreads();
}

struct Args { const float* in[23]; float* out; unsigned char* ws; int ph_lo, ph_hi; };
__global__ void __launch_bounds__(NTHR, 2) hymba_fwd(Args args) {
    extern __shared__ __attribute__((aligned(16))) unsigned char lds_raw[];
    LAS unsigned char* lds = (LAS unsigned char*)lds_raw;
    cg::grid_group grid = cg::this_grid();
    const int tid = threadIdx.x, lane = tid & 63, wave = __builtin_amdgcn_readfirstlane(tid >> 6);
    const int G = gridDim.x; const int bx = blockIdx.x; const int vcu = (G % 8 == 0) ? (bx % 8) * (G / 8) + bx / 8 : bx;
#define H (args.out)
#define W1GU ((bf16*)(args.ws + WS_W1GU))
#define W1D ((bf16*)(args.ws + WS_W1D))
#define WIN ((bf16*)(args.ws + WS_WIN))
#define WOUT ((bf16*)(args.ws + WS_WOUT))
#define W2GU ((bf16*)(args.ws + WS_W2GU))
#define W2D ((bf16*)(args.ws + WS_W2D))
#define WPG ((bf16*)(args.ws + WS_WPG))
#define WPP ((bf16*)(args.ws + WS_WPP))
#define GATES ((float*)(args.ws + WS_GATES))
#define CLG ((float*)(args.ws + WS_CL))
#define SEGT ((float*)(args.ws + WS_MPREV + 65536))
#define SS0 ((float*)(args.ws + WS_SS0))
#define SS1 ((float*)(args.ws + WS_SS1))
#define SS2 ((float*)(args.ws + WS_SS2))
#define SS3 ((float*)(args.ws + WS_SS3))
#define SS4 ((float*)(args.ws + WS_SS4))
#define SSP ((float*)(args.ws + WS_SSP))
#define XN ((bf16*)(args.ws + WS_XN))
#define ACT ((bf16*)(args.ws + WS_ACTZ))
#define Z ((bf16*)(args.ws + WS_ACTZ))
#define YMIX ((bf16*)(args.ws + WS_YMIX))
#define PROJ ((bf16*)(args.ws + WS_YMIX))
#define PB ((bf16*)(args.ws + WS_PB))
#define MKPTRS() Ptrs P; { unsigned char* ws_ = args.ws; P.gates = (const float*)(ws_ + WS_GATES); P.barr = (float*)(ws_ + WS_BARR); P.rarr = (float*)(ws_ + WS_RARR); P.nloc = (float*)(ws_ + WS_NLOC); P.nprev = (float*)(ws_ + WS_NPREV); \
    P.garr = (float*)(ws_ + WS_GARR); P.mloc = (float*)(ws_ + WS_MLOC); P.mprev = (float*)(ws_ + WS_MPREV); P.ut = (float*)(ws_ + WS_UT); P.ct = (bf16*)(ws_ + WS_CT); \
    P.qkc = (bf16*)(ws_ + WS_XN); P.z = (bf16*)(ws_ + WS_ACTZ); P.ymix = (bf16*)(ws_ + WS_YMIX); P.conv = args.in[8]; P.gm = args.in[11]; }
    const int lo = args.ph_lo, hi = args.ph_hi;
#ifndef PH_MASK
#define PH_MASK 0xFFF
#endif
#ifndef PROBE_REP
#define PROBE_REP 0
#endif
#define IN(k) (((PH_MASK >> (k)) & 1) && lo <= (k) && (k) < hi)
#define REPS(k) _Pragma("unroll") for (int rep_ = 0; rep_ < 1 + ((PROBE_REP >> (k)) & 1); ++rep_)
#define SEAM(k) do { if (IN(k) && IN((k) + 1)) { if ((k) == 0) grid.sync(); else xcd_barrier(bar); } } while (0)
    const int gw = vcu * NWAVES + wave, NGW = G * NWAVES;
    if (tid < 8) ((LAS unsigned*)(lds + 131072))[tid] = 0u;
    __syncthreads();
    XcdBarrier bar; bar.bar = (unsigned*)args.ws; bar.x = 0; bar.st = nullptr;
    if (hi - lo > 1) bar = xcd_barrier_post((unsigned*)args.ws, (volatile LAS unsigned*)(lds + 131072));

    if (IN(0)) REPS(0) { if (rep_) xcd_barrier(bar);
        LAS float* scr = (LAS float*)(lds + wave * 16384);
        constexpr int I_GU = 16 * 88, I_D = 44 * 32, I_IN = 16 * 97, I_O = 16 * 32, I_PP = 4 * 32;
        constexpr int NITEMS = 4 * I_GU + 2 * I_D + I_IN + 2 * I_O + I_PP;
        for (int it = gw; it < NITEMS; it += NGW) {
            int r = it, wi, gi = -1, K = DM_, N = DFF, map = 0; size_t wso;
            if (r < I_GU) { wi = 3; gi = 2; wso = WS_W1GU; map = 1; }
            else if ((r -= I_GU) < I_GU) { wi = 4; gi = 2; wso = WS_W1GU; map = 2; }
            else if ((r -= I_GU) < I_D) { wi = 5; wso = WS_W1D; K = DFF; N = DM_; }
            else if ((r -= I_D) < I_IN) { wi = 7; gi = 6; wso = WS_WIN; N = 3088; map = 3; }
            else if ((r -= I_IN) < I_O) { wi = 13; wso = WS_WOUT; N = DM_; }
            else if ((r -= I_O) < I_GU) { wi = 15; gi = 14; wso = WS_W2GU; map = 1; }
            else if ((r -= I_GU) < I_GU) { wi = 16; gi = 14; wso = WS_W2GU; map = 2; }
            else if ((r -= I_GU) < I_D) { wi = 17; wso = WS_W2D; K = DFF; N = DM_; }
            else if ((r -= I_D) < I_O) { wi = 19; gi = 18; wso = WS_WPG; N = DM_; }
            else { r -= I_O; wi = 20; wso = WS_WPP; K = DPLE; N = DM_; }
            p0_transpose_item(args.in[wi], K, N, (bf16*)(args.ws + wso), map, gi >= 0 ? args.in[gi] : nullptr, scr, r, lane);
        }
        { v4u* zp = (v4u*)(WIN + (size_t)3088 * 1024); const int nz = (WIN_ROWS - 3088) * 1024 * 2 / 16;
          for (int i = bx * NTHR + tid; i < nz; i += G * NTHR) zp[i] = (v4u){0u, 0u, 0u, 0u}; }
        for (int m0 = 2 * gw; m0 < Mrows; m0 += 2 * NGW) {
            f32x4 v[2][4]; float sq[2];
#pragma unroll
            for (int rr = 0; rr < 2; ++rr) { const f32x4* xr = (const f32x4*)(args.in[0] + (size_t)(m0 + rr) * 1024) + lane;
#pragma unroll
                for (int j = 0; j < 4; ++j) v[rr][j] = xr[64 * j]; }
#pragma unroll
            for (int rr = 0; rr < 2; ++rr) { float s = 0.f;
#pragma unroll
                for (int j = 0; j < 4; ++j) s += (v[rr][j][0] * v[rr][j][0] + v[rr][j][1] * v[rr][j][1]) + (v[rr][j][2] * v[rr][j][2] + v[rr][j][3] * v[rr][j][3]);
#pragma unroll
                for (int o = 1; o < 64; o <<= 1) s += __shfl_xor(s, o);
                sq[rr] = 1.0f / sqrtf(s * (1.0f / 1024.0f) + 1e-6f); }
#pragma unroll
            for (int rr = 0; rr < 2; ++rr) { unsigned long long* o8 = (unsigned long long*)(XN + (size_t)(m0 + rr) * 1024) + lane;
#pragma unroll
                for (int j = 0; j < 4; ++j) { const f32x4 w = v[rr][j] * sq[rr]; o8[64 * j] = (unsigned long long)pk2(w[0], w[1]) | ((unsigned long long)pk2(w[2], w[3]) << 32); } }
        }
        { const f32x4* pp = (const f32x4*)args.in[1]; unsigned long long* po = (unsigned long long*)PB; const int n4 = Mrows * DPLE / 4;
          for (int i = bx * NTHR + tid; i < n4; i += G * NTHR) { const f32x4 v = pp[i]; po[i] = (unsigned long long)pk2(v[0], v[1]) | ((unsigned long long)pk2(v[2], v[3]) << 32); } }
    }
    SEAM(0);
    if (IN(1)) REPS(1) { if (rep_) xcd_barrier(bar); pg8::Gemm g{XN, W1GU, Mrows, 2 * DFF, DM_}; pg8::StaticOrder S; S.init(Mrows, 2 * DFF, G, bx);
        pg8::EpiSwiGLU<true> E{ACT, nullptr, DFF}; pg8::gemm_phase<pg8::EpiSwiGLU<true>, pg8::StaticOrder, true, true>(lds, g, S, E); }
    SEAM(1);
    if (IN(2)) REPS(2) { if (rep_) xcd_barrier(bar); pg8::Gemm g{ACT, W1D, Mrows, DM_, DFF}; pg8::StaticOrder S; S.init(Mrows, DM_, G, bx);
        pg8::EpiResid E{args.in[0], H, XN, SS1, 0.5f}; pg8::gemm_phase<pg8::EpiResid, pg8::StaticOrder, true, true>(lds, g, S, E); }
    SEAM(2);
    if (IN(3)) REPS(3) { if (rep_) xcd_barrier(bar);
        { pg8::Gemm g{XN, WIN, Mrows, 3072, DM_}; pg8::StaticOrder S; S.init(Mrows, 3072, G, bx);
          pg8::EpiZ E{Z, GATES, SS1, args.in[9], args.in[10], 0.125f * 1.4426950408889634f}; pg8::gemm_phase<pg8::EpiZ, pg8::StaticOrder, true, true>(lds, g, S, E); }
        for (int r0 = gw * 16; r0 < Mrows; r0 += NGW * 16) { f32x4 acc = (f32x4){0.f, 0.f, 0.f, 0.f};
            const bf16* ap = XN + (size_t)(r0 + (lane & 15)) * 1024 + 8 * (lane >> 4); const bf16* bp = WIN + (size_t)(3072 + (lane & 15)) * 1024 + 8 * (lane >> 4);
#pragma unroll 8
            for (int ks = 0; ks < 32; ++ks) acc = MMA16(*(const bf16x8*)(ap + ks * 32), *(const bf16x8*)(bp + ks * 32), acc);
            const int col = lane & 15; const float bias = col < 8 ? args.in[9][col] : args.in[10][col - 8];
#pragma unroll
            for (int r = 0; r < 4; ++r) { const int row = r0 + 4 * (lane >> 4) + r; GATES[(size_t)row * 16 + col] = acc[r] * pg8::row_rstd(SS1, row) + bias; } }
    }
    SEAM(3);
    if (IN(4)) REPS(4) { if (rep_) xcd_barrier(bar);
        for (int task = wave * G + vcu; task < 1024; task += NGW) {
            const int bhf = task >> 4, seg = task & 15, b = bhf >> 3, h = bhf & 7; const int t0 = seg * 256 + 4 * lane;
            const float* gp = GATES + ((size_t)b * SEQL + t0) * 16 + 8 + h;
            const float v0 = logsig_f(gp[0]), v1 = v0 + logsig_f(gp[16]), v2 = v1 + logsig_f(gp[32]), v3 = v2 + logsig_f(gp[48]);
            float inc = v3;
#pragma unroll
            for (int o = 1; o < 64; o <<= 1) { const float t = __shfl_up(inc, o); if (lane >= o) inc += t; }
            const float ex = inc - v3;
            *(f32x4*)(CLG + (size_t)bhf * SEQL + t0) = (f32x4){ex + v0, ex + v1, ex + v2, ex + v3};
            if (lane == 63) SEGT[task] = inc;
        }
        MKPTRS();
        mlstm_local_phase(vcu, G, 2048, lds, P);
    }
    SEAM(4);
    if (IN(5)) REPS(5) { if (rep_) xcd_barrier(bar);
        MKPTRS();
        const float* __restrict__ ut = P.ut; bf16* __restrict__ ct = P.ct;
        for (int e2 = bx * NTHR + tid; e2 < 32 * 4096; e2 += G * NTHR) {
            const int bh = e2 >> 12, idx = (e2 & 4095) * 2; float C0 = 0.f, C1 = 0.f, m = 0.f;
            for (int c0 = 0; c0 < 64; c0 += 16) { pg8::f32x2 u[16];
#pragma unroll
                for (int j = 0; j < 16; ++j) u[j] = *(const pg8::f32x2*)(ut + ((size_t)(bh * 64 + c0 + j) << 13) + idx);
#pragma unroll
                for (int j = 0; j < 16; ++j) { const int ci = bh * 64 + c0 + j; const float g = P.garr[ci], ml = P.mloc[ci]; const float mn = fmaxf(g + m, ml);
                    *(unsigned*)(ct + ((size_t)ci << 13) + idx) = pk2(C0, C1); if (idx == 0) P.mprev[ci] = m;
                    const float dec = __expf(g + m - mn), wu = __expf(ml - mn); C0 = dec * C0 + wu * u[j].x; C1 = dec * C1 + wu * u[j].y; m = mn; } }
        }
        for (int eid = bx * NTHR + tid; eid < 32 * 64; eid += G * NTHR) {
            const int bh = eid >> 6, d = eid & 63; float n = 0.f, m = 0.f;
            for (int c = 0; c < 64; ++c) { const int ci = bh * 64 + c; const float g = P.garr[ci], ml = P.mloc[ci]; const float mn = fmaxf(g + m, ml);
                P.nprev[ci * 64 + d] = n; n = __expf(g + m - mn) * n + __expf(ml - mn) * P.nloc[ci * 64 + d]; m = mn; }
        }
    }
    SEAM(5);
    if (IN(6)) { constexpr int R6 = 1 + ((PROBE_REP >> 6) & 1), R6A = 1 + ((PROBE_REP >> 7) & 1);
        { MKPTRS();
        mlstm_out_phase(vcu, G, 2048 * R6, lds, P); }
        __syncthreads();
        LAS float* cl = (LAS float*)(lds + 86016); int cur_bh = -1;
        const int nu = (1024 + G - 1) / G;
        for (int i2 = 0; i2 < nu * R6A; ++i2) { const int i = i2 % nu;
            int bh, qb;
            if (G == 256) { const int s = vcu & 3; bh = vcu >> 2; qb = (i == 0) ? s : (i == 1) ? 7 - s : (i == 2) ? 8 + s : 15 - s; }
            else { const int idx = i * G + vcu; if (idx >= 1024) break; bh = idx >> 4; qb = idx & 15; }
            if (bh != cur_bh) { __syncthreads();
                for (int k = tid; k < SEQL / 4; k += NTHR) { const int sg = k >> 6; float off = 0.f;
#pragma unroll
                    for (int q = 0; q < 15; ++q) { const float sv = SEGT[bh * 16 + q]; off += q < sg ? sv : 0.f; }
                    const f32x4 v = *(const f32x4*)(CLG + (size_t)bh * SEQL + 4 * k); *(LAS f32x4*)(cl + 4 * k) = (v + off) * 1.4426950408889634f; }
                cur_bh = bh; __syncthreads(); }
            attn_body::attn_unit<8>(bh >> 3, bh & 7, qb, (const attn_body::bf16*)(Z + 1536), (const attn_body::bf16*)(Z + 2048), (const attn_body::bf16*)(Z + 2560), (attn_body::bf16*)(YMIX + 512), (char*)lds_raw, (attn_body::lds_fptr)cl, args.in[12]);
        }
    }
    SEAM(6);
    if (IN(7)) { pg8::Gemm g{YMIX, WOUT, Mrows, DM_, DM_}; pg8::StaticOrder S; S.init(Mrows, DM_, G, bx);
        pg8::EpiResid E{H, H, XN, SS2, 1.0f}; pg8::gemm_phase<pg8::EpiResid, pg8::StaticOrder, true, true>(lds, g, S, E); }
    SEAM(7);
    if (IN(8)) REPS(8) { if (rep_) xcd_barrier(bar); pg8::Gemm g{XN, W2GU, Mrows, 2 * DFF, DM_}; pg8::StaticOrder S; S.init(Mrows, 2 * DFF, G, bx);
        pg8::EpiSwiGLU<false> E{ACT, SS2, DFF}; pg8::gemm_phase<pg8::EpiSwiGLU<false>, pg8::StaticOrder, true, true>(lds, g, S, E); }
    SEAM(8);
    if (IN(9)) {
        { pg8::Gemm g{ACT, W2D, Mrows, DM_, DFF}; pg8::StaticOrder S; S.init(Mrows, DM_, G, bx);
          pg8::EpiResid E{H, H, XN, SS3, 0.5f}; pg8::gemm_phase<pg8::EpiResid, pg8::StaticOrder, true, true>(lds, g, S, E); }
        { pg8::Gemm g{PB, WPP, Mrows, DM_, DPLE}; pg8::StaticOrder S; S.init(Mrows, DM_, G, bx);
          pg8::EpiProj E{PROJ, SSP}; pg8::gemm_phase<pg8::EpiProj, pg8::StaticOrder, true, true>(lds, g, S, E); }
    }
    SEAM(9);
    if (IN(10)) { pg8::Gemm g{XN, WPG, Mrows, DM_, DM_}; pg8::StaticOrder S; S.init(Mrows, DM_, G, bx);
        pg8::EpiPle E{H, PROJ, SS3, SSP, args.in[21], SS4}; pg8::gemm_phase<pg8::EpiPle, pg8::StaticOrder, true, true>(lds, g, S, E); }
    SEAM(10);
    if (IN(11)) {
        const f32x4* gf = (const f32x4*)args.in[22];
        for (int m0 = 2 * gw; m0 < Mrows; m0 += 2 * NGW) { f32x4 v[2][4]; float rs[2];
#pragma unroll
            for (int rr = 0; rr < 2; ++rr) { rs[rr] = pg8::row_rstd(SS4, m0 + rr); const f32x4* hp = (const f32x4*)(H + (size_t)(m0 + rr) * 1024) + lane;
#pragma unroll
                for (int j = 0; j < 4; ++j) v[rr][j] = hp[64 * j]; }
#pragma unroll
            for (int rr = 0; rr < 2; ++rr) { f32x4* hp = (f32x4*)(H + (size_t)(m0 + rr) * 1024) + lane;
#pragma unroll
                for (int j = 0; j < 4; ++j) hp[64 * j] = v[rr][j] * rs[rr] * gf[64 * j + lane]; } }
    }
#undef IN
#undef SEAM
}

extern "C" void kernel_launch(void* const* d_in, const int* in_sizes, int n_in, void* d_out, int out_size, void* d_ws, size_t ws_size, hipStream_t stream) {
    static int grid = 0;
    if (grid == 0) {
        if (n_in != 23 || out_size != Mrows * DM_ || ws_size < WS_END) { fprintf(stderr, "kernel_launch: unexpected shapes (n_in %d out %d ws %zu)\n", n_in, out_size, ws_size); grid = -1; return; }
        int dev = 0, cus = 0, per_cu = 0;
        hipGetDevice(&dev); hipDeviceGetAttribute(&cus, hipDeviceAttributeMultiprocessorCount, dev);
        if (hipFuncSetAttribute((const void*)hymba_fwd, hipFuncAttributeMaxDynamicSharedMemorySize, LDS_BYTES) != hipSuccess) { fprintf(stderr, "kernel_launch: hipFuncSetAttribute failed\n"); grid = -1; return; }
        if (hipOccupancyMaxActiveBlocksPerMultiprocessor(&per_cu, (const void*)hymba_fwd, NTHR, LDS_BYTES) != hipSuccess || per_cu < 1) { fprintf(stderr, "kernel_launch: occupancy query says %d\n", per_cu); per_cu = 1; }
        (void)hipGetLastError();
        grid = cus * (per_cu > 1 ? 1 : per_cu);
    }
    if (grid < 0) return;
    if (hipMemsetAsync(d_ws, 0, 65536, stream) != hipSuccess) { fprintf(stderr, "kernel_launch: memset failed\n"); return; }
    Args a{};
    for (int i = 0; i < 23; ++i) a.in[i] = (const float*)d_in[i];
    a.out = (float*)d_out; a.ws = (unsigned char*)d_ws;
#if MK_MULTI
    for (int ph = 0; ph < NPH; ++ph) { a.ph_lo = ph; a.ph_hi = ph + 1; hipLaunchKernelGGL(hymba_fwd, dim3(grid), dim3(NTHR), LDS_BYTES, stream, a); }
#else
    a.ph_lo = 0; a.ph_hi = NPH; void* kargs[] = {&a};
    hipError_t e = hipLaunchCooperativeKernel((void*)hymba_fwd, dim3(grid), dim3(NTHR), kargs, LDS_BYTES, stream);
    if (e != hipSuccess) fprintf(stderr, "cooperative launch failed: %s (grid %d)\n", hipGetErrorString(e), grid);
#endif
}
```
